# Optimizing an MI355X kernel written in HIP

```python
import math
import jax, jax.numpy as jnp
from jax import lax
import numpy as np

D_MODEL = 1024
BATCH = 8
SEQ = 4096
DEPTH = 1

D_FF = 2816
DA_HEADS = 4
DA_QK = 64
DA_V = 2 * DA_QK
DA_WIDTH = DA_HEADS * DA_V
Q_BLOCK = 128
RET_HEADS = 4
RET_DK = 128
RET_DV = 128
RET_WIDTH = RET_HEADS * RET_DV
RET_CHUNK = 128
SPLIT_SIZES = (
    DA_HEADS * 2 * DA_QK,
    DA_HEADS * 2 * DA_QK,
    DA_WIDTH,
    RET_HEADS * RET_DK,
    RET_HEADS * RET_DK,
    RET_WIDTH,
    RET_WIDTH,
    D_MODEL,
    D_MODEL,
)
D_IN = sum(SPLIT_SIZES)
NORM_EPS = 1e-6
SUBLN_EPS = 1e-5
NEG_INF = -1e30

kernel_name = "hybrid_diffattn_retnet_macaron"


def rmsnorm(x, g, eps=NORM_EPS):
    xf = x.astype(jnp.float32)
    y = xf * lax.rsqrt(jnp.mean(xf * xf, axis=-1, keepdims=True) + eps)
    return (y * g.astype(jnp.float32)).astype(x.dtype)


def swiglu(h, w_gate, w_up, w_down):
    return (jax.nn.silu(h @ w_gate) * (h @ w_up)) @ w_down


def diff_attention(q, k, v, lq1, lk1, lq2, lk2, subln_g, lambda_init):
    B, T, _ = q.shape
    dtype = q.dtype
    q = q.reshape(B, T, 2 * DA_HEADS, DA_QK)
    k = k.reshape(B, T, 2 * DA_HEADS, DA_QK)
    v = v.reshape(B, T, DA_HEADS, DA_V).astype(jnp.float32)
    lam = (jnp.exp(jnp.sum(lq1.astype(jnp.float32) * lk1.astype(jnp.float32)))
           - jnp.exp(jnp.sum(lq2.astype(jnp.float32) * lk2.astype(jnp.float32)))
           + lambda_init)
    scale = DA_QK ** -0.5
    nb = T // Q_BLOCK
    qb = jnp.moveaxis(q.reshape(B, nb, Q_BLOCK, 2 * DA_HEADS, DA_QK), 1, 0)
    kpos = jnp.arange(T)

    def block(args):
        q_blk, i = args
        qpos = i * Q_BLOCK + jnp.arange(Q_BLOCK)
        mask = kpos[None, :] <= qpos[:, None]
        s = jnp.einsum('bqmd,bkmd->bmqk', q_blk, k).astype(jnp.float32) * scale
        s = jnp.where(mask[None, None], s, NEG_INF)
        p = jax.nn.softmax(s, axis=-1).reshape(B, DA_HEADS, 2, Q_BLOCK, T)
        a = p[:, :, 0] - lam * p[:, :, 1]
        return jnp.einsum('bhqk,bkhe->bqhe', a, v)

    o = lax.map(block, (qb, jnp.arange(nb, dtype=jnp.int32)))
    o = jnp.moveaxis(o, 0, 1).reshape(B, T, DA_HEADS, DA_V)
    o = rmsnorm(o, subln_g, SUBLN_EPS).astype(jnp.float32) * (1.0 - lambda_init)
    return o.reshape(B, T, DA_WIDTH).astype(dtype)


def rotate_every_two(x):
    x1 = x[..., ::2]
    x2 = x[..., 1::2]
    return jnp.stack((-x2, x1), axis=-1).reshape(x.shape)


def retention(q, k, v, gate):
    B, T, _ = q.shape
    dtype = q.dtype
    f32 = jnp.float32
    q = q.astype(f32).reshape(B, T, RET_HEADS, RET_DK)
    k = k.astype(f32).reshape(B, T, RET_HEADS, RET_DK) * (RET_DK ** -0.5)
    v = v.astype(f32).reshape(B, T, RET_HEADS, RET_DV)
    angle = 1.0 / (10000.0 ** jnp.linspace(0.0, 1.0, RET_DK // 2, dtype=f32))
    angle = jnp.repeat(angle, 2)
    ang = jnp.arange(T, dtype=f32)[:, None] * angle[None, :]
    sin = jnp.sin(ang)[:, None, :]
    cos = jnp.cos(ang)[:, None, :]
    q = q * cos + rotate_every_two(q) * sin
    k = k * cos + rotate_every_two(k) * sin

    C = RET_CHUNK
    N = T // C
    qc = q.reshape(B, N, C, RET_HEADS, RET_DK)
    kc = k.reshape(B, N, C, RET_HEADS, RET_DK)
    vc = v.reshape(B, N, C, RET_HEADS, RET_DV)
    log_g = jnp.log(1.0 - 2.0 ** (-5.0 - jnp.arange(RET_HEADS, dtype=f32)))
    idx = jnp.arange(C, dtype=f32)
    diff = idx[:, None] - idx[None, :]
    dmask = jnp.where(diff[None] >= 0,
                      jnp.exp(log_g[:, None, None] * jnp.maximum(diff, 0.0)[None]), 0.0)
    s = jnp.einsum('bnqhd,bnkhd->bnhqk', qc, kc) * dmask
    intra = jnp.einsum('bnhqk,bnkhe->bnqhe', s, vc)
    zeta = jnp.exp(log_g[:, None] * (C - 1.0 - idx)[None, :])
    kv = jnp.einsum('bnkhd,bnkhe,hk->nbhde', kc, vc, zeta)
    chunk_decay = jnp.exp(log_g * C)[None, :, None, None]

    def step(state, kv_n):
        return chunk_decay * state + kv_n, state

    _, prev = lax.scan(step, jnp.zeros((B, RET_HEADS, RET_DK, RET_DV), f32), kv)
    xi = jnp.exp(log_g[:, None] * (idx + 1.0)[None, :])
    inter = jnp.einsum('bnqhd,nbhde,hq->bnqhe', qc, prev, xi)
    y = (intra + inter).reshape(B, T, RET_HEADS, RET_DV)
    y = y * lax.rsqrt(jnp.mean(y * y, axis=-1, keepdims=True) + NORM_EPS)
    y = y.reshape(B, T, RET_WIDTH) * jax.nn.silu(gate.astype(f32))
    return y.astype(dtype)


def setup_inputs(seed: int = 0) -> dict:
    key = jax.random.key(seed)
    ks = jax.random.split(key, 32)
    L, D, F = DEPTH, D_MODEL, D_FF
    nrm = lambda k, shape, fan: jax.random.normal(k, shape, jnp.float32) * fan ** -0.5
    gain = lambda k, n: 1.0 + 0.02 * jax.random.normal(k, (L, n), jnp.float32)
    return {
        "x": jax.random.normal(ks[0], (BATCH, SEQ, D), jnp.float32),
        "ffn1_pre_g": gain(ks[1], D),
        "ffn1_w_gate": nrm(ks[2], (L, D, F), D),
        "ffn1_w_up": nrm(ks[3], (L, D, F), D),
        "ffn1_w_down": nrm(ks[4], (L, F, D), F),
        "ffn1_post_g": gain(ks[5], D),
        "mix_pre_g": gain(ks[6], D),
        "w_in": nrm(ks[7], (L, D, D_IN), D),
        "lambda_q1": 0.1 * jax.random.normal(ks[8], (L, DA_QK), jnp.float32),
        "lambda_k1": 0.1 * jax.random.normal(ks[9], (L, DA_QK), jnp.float32),
        "lambda_q2": 0.1 * jax.random.normal(ks[10], (L, DA_QK), jnp.float32),
        "lambda_k2": 0.1 * jax.random.normal(ks[11], (L, DA_QK), jnp.float32),
        "diff_subln_g": gain(ks[12], DA_V),
        "w_attn_proj": nrm(ks[13], (L, DA_WIDTH, D), DA_WIDTH),
        "w_ret_proj": nrm(ks[14], (L, RET_WIDTH, D), RET_WIDTH),
        "w_out": nrm(ks[15], (L, D, D), D),
        "mix_post_g": gain(ks[16], D),
        "ffn2_pre_g": gain(ks[17], D),
        "ffn2_w_gate": nrm(ks[18], (L, D, F), D),
        "ffn2_w_up": nrm(ks[19], (L, D, F), D),
        "ffn2_w_down": nrm(ks[20], (L, F, D), F),
        "ffn2_post_g": gain(ks[21], D),
    }


def reference(x, ffn1_pre_g, ffn1_w_gate, ffn1_w_up, ffn1_w_down, ffn1_post_g,
              mix_pre_g, w_in, lambda_q1, lambda_k1, lambda_q2, lambda_k2,
              diff_subln_g, w_attn_proj, w_ret_proj, w_out, mix_post_g,
              ffn2_pre_g, ffn2_w_gate, ffn2_w_up, ffn2_w_down, ffn2_post_g):
    cuts = list(np.cumsum(SPLIT_SIZES)[:-1])
    for l in range(DEPTH):
        lambda_init = 0.8 - 0.6 * math.exp(-0.3 * l)
        h = rmsnorm(x, ffn1_pre_g[l])
        x = x + 0.5 * rmsnorm(swiglu(h, ffn1_w_gate[l], ffn1_w_up[l], ffn1_w_down[l]), ffn1_post_g[l])
        h = rmsnorm(x, mix_pre_g[l])
        z = h @ w_in[l]
        dq, dk, dv, rq, rk, rv, rg, ga, gr = jnp.split(z, cuts, axis=-1)
        y_a = diff_attention(dq, dk, dv, lambda_q1[l], lambda_k1[l], lambda_q2[l],
                             lambda_k2[l], diff_subln_g[l], lambda_init) @ w_attn_proj[l]
        y_r = retention(rq, rk, rv, rg) @ w_ret_proj[l]
        merged = jax.nn.sigmoid(ga) * y_a + jax.nn.sigmoid(gr) * y_r
        x = x + rmsnorm(merged @ w_out[l], mix_post_g[l])
        h = rmsnorm(x, ffn2_pre_g[l])
        x = x + 0.5 * rmsnorm(swiglu(h, ffn2_w_gate[l], ffn2_w_up[l], ffn2_w_down[l]), ffn2_post_g[l])
    return x
```

```cpp
#include <hip/hip_runtime.h>
#include <hip/hip_bf16.h>
#include <hip/hip_cooperative_groups.h>
namespace cg = cooperative_groups;
#ifndef BAR_MODE
#define BAR_MODE 0
#endif
#include <cstdio>
#include <cstdint>
#include <cmath>
namespace pg8 {
#define PG8_LAS __attribute__((address_space(3)))
typedef unsigned short bf16_t;
typedef short bf16x8 __attribute__((ext_vector_type(8)));
typedef float f32x4 __attribute__((ext_vector_type(4)));
typedef unsigned u32x4 __attribute__((ext_vector_type(4)));
constexpr int BM = 256, BK = 64, HALF = 128, HTB = HALF * BK * 2  , STAGE_BYTES = 8 * HTB, NXCD = 8, WGM = 8;

__host__ __device__ __forceinline__ int lds_byte(int r, int c) { const int st = (r >> 4) * 2 + (c >> 5), rr = r & 15, cc = c & 31, ob = rr * 64 + cc * 2; return st * 1024 + (ob ^ (((ob >> 9) & 1) << 5)); }
__host__ __device__ __forceinline__ void stage_rc(int b, int& R, int& C) { const int st = b / 1024, sb = b % 1024, swz = sb ^ (((sb >> 9) & 1) << 5); R = (st >> 1) * 16 + swz / 64; C = (st & 1) * 32 + (swz % 64) / 2; }
__host__ __device__ __forceinline__ int perm32(int rho) { const int n = rho >> 4, i = rho & 15; return 8 * (i >> 2) + 4 * n + (i & 3); }

struct Unit { int pm, pn; };
struct Gemm { const bf16_t* A; const bf16_t* Bt; int M, N, K; };

struct StaticOrder {
    int nM, nN, nwg, G, c;
    __host__ __device__ void init(int M, int N, int G_, int c_) { nM = M / BM; nN = N / BM; nwg = nM * nN; G = G_; c = c_; }
    __host__ __device__ bool next(int i, Unit& u) const {
        const long L = (long)i * G + c; if (L >= nwg) return false;
        int wgid = (int)L; { const int q = nwg / NXCD, r = nwg % NXCD, xcd = wgid % NXCD, off = wgid / NXCD; wgid = (xcd < r ? xcd * (q + 1) : r * (q + 1) + (xcd - r) * q) + off; }
        const int nig = WGM * nN, gid = wgid / nig, fm = gid * WGM, gsz = (nM - fm) < WGM ? (nM - fm) : WGM;
        u.pm = fm + ((wgid % nig) % gsz); u.pn = (wgid % nig) / gsz; return true;
    }
    __device__ __forceinline__ void a_ready(const Unit&) const {}
    __device__ __forceinline__ void done(const Unit&) const {}
};

__device__ __forceinline__ unsigned cvt_pk_bf16(float lo, float hi) { unsigned r; asm volatile("v_cvt_pk_bf16_f32 %0, %1, %2" : "=v"(r) : "v"(lo), "v"(hi)); return r; }
typedef float f32x2 __attribute__((ext_vector_type(2)));
__device__ __forceinline__ f32x2 gelu_pk(f32x2 v) {
    const f32x2 av = __builtin_elementwise_abs(v), d = av * 0.2316418882f + 1.0f;
    f32x2 t; t.x = __builtin_amdgcn_rcpf(d.x); t.y = __builtin_amdgcn_rcpf(d.y);
    f32x2 q = t * 0.5307027145f + (-0.7265760135f); q = q * t + 0.7107068705f; q = q * t + (-0.142248368f); q = q * t + 0.127414796f; q = q * t;
    const f32x2 s = (v * v) * (-0.72134752044f);
    f32x2 e; e.x = __builtin_amdgcn_exp2f(s.x); e.y = __builtin_amdgcn_exp2f(s.y);
    const f32x2 m = v * (q * e), r = v - m;
    f32x2 o; o.x = v.x < 0.f ? m.x : r.x; o.y = v.y < 0.f ? m.y : r.y; return o;
}

template <int ACT  > struct EpiBf16 {
    static constexpr bool PERM = true, AFTER_DRAIN = false; static_assert(ACT == 0 || ACT == 1, "EpiBf16: ACT is 0 (none) or 1 (gelu_pk)");
    bf16_t* O; int ldc; const float* bias; int split_cols; size_t split_stride; float scale0;
    __device__ __forceinline__ void operator()(const f32x4 (&acc)[2][2][4][2], const Unit& u, int wr, int wc, int fr, int fq) const {
        const int row0 = u.pm * BM + wr * 64 + fr; int colt = u.pn * BM; bf16_t* base = O;
        float sc = 1.f; if (split_cols) { const int t = colt / split_cols; base += (size_t)t * split_stride; colt -= t * split_cols; if (t == 0) sc = scale0; }
        const int col0 = colt + wc * 32 + 8 * fq, bcol0 = u.pn * BM + wc * 32 + 8 * fq;
        f32x4 bv[2][2];
#pragma unroll
        for (int bj = 0; bj < 2; ++bj)
#pragma unroll
            for (int n = 0; n < 2; ++n) bv[bj][n] = bias ? *(const f32x4*)(bias + bcol0 + bj * HALF + 4 * n) : (f32x4){0.f, 0.f, 0.f, 0.f};
#pragma unroll
        for (int ai = 0; ai < 2; ++ai)
#pragma unroll
            for (int m = 0; m < 4; ++m) { bf16_t* rowp = base + (size_t)(row0 + ai * HALF + m * 16) * ldc + col0;
#pragma unroll
                for (int bj = 0; bj < 2; ++bj) { f32x4 v0 = acc[ai][bj][m][0] + bv[bj][0], v1 = acc[ai][bj][m][1] + bv[bj][1];
                    if (ACT == 1) { f32x2 a = gelu_pk((f32x2){v0[0], v0[1]}), b = gelu_pk((f32x2){v0[2], v0[3]}), c = gelu_pk((f32x2){v1[0], v1[1]}), d = gelu_pk((f32x2){v1[2], v1[3]});
                        v0 = (f32x4){a.x, a.y, b.x, b.y}; v1 = (f32x4){c.x, c.y, d.x, d.y}; }
                    v0 = v0 * sc; v1 = v1 * sc; u32x4 w; w.x = cvt_pk_bf16(v0[0], v0[1]); w.y = cvt_pk_bf16(v0[2], v0[3]); w.z = cvt_pk_bf16(v1[0], v1[1]); w.w = cvt_pk_bf16(v1[2], v1[3]);
                    *(u32x4*)(rowp + bj * HALF) = w; } }
    }
};

template <class Epi, class Sched, bool ALIGN_EPI = false, bool SP2 = false>
__device__ __forceinline__ void gemm_phase(PG8_LAS unsigned char* lds, const Gemm g, const Sched& S, const Epi& E) {
    int tid_ = threadIdx.x; asm volatile("" : "+v"(tid_));
    const int tid = tid_, wid = __builtin_amdgcn_readfirstlane(tid >> 6), lane = tid & 63, wr = wid >> 2, wc = wid & 3, fr = lane & 15, fq = lane >> 4;
    const int K = g.K, nt = K / BK;
    unsigned voffA[2], voffB[2];
#pragma unroll
    for (int i = 0; i < 2; ++i) { int R, C; stage_rc(tid * 16 + i * 8192, R, C); const int Rb = Epi::PERM ? ((R & ~31) + perm32(R & 31)) : R;
        voffA[i] = (unsigned)(R * K + C) * 2u; voffB[i] = (unsigned)(Rb * K + C) * 2u; }
    const size_t kstep = (size_t)(BK * 2);
    const size_t hstep = (size_t)HALF * K * 2;
    const size_t tstep = 2 * hstep;
    const unsigned ldsw = (unsigned)wid * 1024u;
    const int aoff = lds_byte(wr * 64 + fr, fq * 8), boff = lds_byte(wc * 32 + fr, fq * 8);
#define PG8_SA(b, h) (((b) * 2 + (h)) * HTB)
#define PG8_SB(b, h) ((4 + (b) * 2 + (h)) * HTB)
#define PG8_STAGE(bufoff, gbase, voff) do { _Pragma("unroll") for (int _i = 0; _i < 2; ++_i) \
        __builtin_amdgcn_global_load_lds((const unsigned*)((const char*)(gbase) + (voff)[_i]), (PG8_LAS unsigned*)(lds + (bufoff) + ldsw + _i * 8192), 16, 0, 0); } while (0)
#define PG8_LDA(dst, b, h) do { _Pragma("unroll") for (int m = 0; m < 4; ++m) _Pragma("unroll") for (int k = 0; k < 2; ++k) dst[m][k] = *(const PG8_LAS bf16x8*)(lds + PG8_SA(b, h) + aoff + m * 2048 + k * 1024); } while (0)
#define PG8_LDB(dst, b, h) do { _Pragma("unroll") for (int n = 0; n < 2; ++n) _Pragma("unroll") for (int k = 0; k < 2; ++k) dst[n][k] = *(const PG8_LAS bf16x8*)(lds + PG8_SB(b, h) + boff + n * 2048 + k * 1024); } while (0)
#define PG8_MMA(ai, bj, At, Bt) do { __builtin_amdgcn_s_setprio(1); _Pragma("unroll") for (int m = 0; m < 4; ++m) _Pragma("unroll") for (int n = 0; n < 2; ++n) _Pragma("unroll") for (int k = 0; k < 2; ++k) \
        acc[ai][bj][m][n] = __builtin_amdgcn_mfma_f32_16x16x32_bf16(Bt[n][k], At[m][k], acc[ai][bj][m][n], 0, 0, 0); __builtin_amdgcn_s_setprio(0); } while (0)
#define PG8_WAIT_V(n) asm volatile("s_waitcnt vmcnt(" #n ")" ::: "memory")
#define PG8_WAIT_L(n) asm volatile("s_waitcnt lgkmcnt(" #n ")" ::: "memory")
#define PG8_BAR __builtin_amdgcn_s_barrier()
#define PG8_SCHED __builtin_amdgcn_sched_barrier(0)
    Unit cur, nxt; int ui = 0;
    if (!S.next(0, cur)) return;
    f32x4 acc[2][2][4][2];
#pragma unroll
    for (int a = 0; a < 2; ++a)
#pragma unroll
        for (int b = 0; b < 2; ++b)
#pragma unroll
            for (int m = 0; m < 4; ++m)
#pragma unroll
                for (int n = 0; n < 2; ++n) acc[a][b][m][n] = (f32x4){0.f, 0.f, 0.f, 0.f};
    bf16x8 At[4][2], B0[2][2], B1[2][2];
    const char* cA = (const char*)g.A + (size_t)cur.pm * tstep; const char* cB = (const char*)g.Bt + (size_t)cur.pn * tstep;
    S.a_ready(cur);
    if constexpr (SP2) {
        PG8_STAGE(PG8_SB(0, 0), cB, voffB); PG8_STAGE(PG8_SB(0, 1), cB + hstep, voffB); PG8_STAGE(PG8_SA(0, 0), cA, voffA); PG8_STAGE(PG8_SA(0, 1), cA + hstep, voffA);
        if (wr == 1) PG8_BAR;
        PG8_WAIT_V(2); PG8_BAR;
        PG8_STAGE(PG8_SB(1, 0), cB + kstep, voffB); PG8_STAGE(PG8_SA(1, 0), cA + kstep, voffA); PG8_STAGE(PG8_SB(1, 1), cB + hstep + kstep, voffB);
        PG8_WAIT_V(6); PG8_BAR;
    } else {
        PG8_STAGE(PG8_SB(0, 0), cB, voffB); PG8_STAGE(PG8_SA(0, 0), cA, voffA); PG8_STAGE(PG8_SB(0, 1), cB + hstep, voffB); PG8_STAGE(PG8_SA(0, 1), cA + hstep, voffA);
        if (wr == 1) PG8_BAR;
        PG8_WAIT_V(4); PG8_BAR;
        PG8_STAGE(PG8_SB(1, 0), cB + kstep, voffB); PG8_STAGE(PG8_SA(1, 0), cA + kstep, voffA); PG8_STAGE(PG8_SB(1, 1), cB + hstep + kstep, voffB);
        PG8_WAIT_V(6); PG8_BAR;
    }
    for (;;) {
        const bool has_next = S.next(ui + 1, nxt);
        const char* nA = has_next ? (const char*)g.A + (size_t)nxt.pm * tstep : cA; const char* nB = has_next ? (const char*)g.Bt + (size_t)nxt.pn * tstep : cB;
        for (int t = 0; t < nt; t += 2) {
            const bool last = (t == nt - 2);
            const char* a1 = cA + (size_t)(t + 1) * kstep;
            const char* a2 = last ? nA : cA + (size_t)(t + 2) * kstep; const char* b2 = last ? nB : cB + (size_t)(t + 2) * kstep;
            const char* a3 = a2 + kstep; const char* b3 = b2 + kstep;
            if (last && has_next) S.a_ready(nxt);
            if constexpr (SP2) {
            PG8_LDB(B0, 0, 0); PG8_LDB(B1, 0, 1); PG8_SCHED; PG8_LDA(At, 0, 0); PG8_STAGE(PG8_SA(1, 1), a1 + hstep, voffA);
            PG8_WAIT_V(8); PG8_WAIT_L(0); PG8_BAR; PG8_MMA(0, 0, At, B0); PG8_MMA(0, 1, At, B1); PG8_BAR; PG8_SCHED;
            PG8_LDA(At, 0, 1); PG8_STAGE(PG8_SB(0, 0), b2, voffB); PG8_STAGE(PG8_SB(0, 1), b2 + hstep, voffB); PG8_STAGE(PG8_SA(0, 0), a2, voffA);
            PG8_WAIT_V(8); PG8_WAIT_L(0); PG8_BAR; PG8_MMA(1, 0, At, B0); PG8_MMA(1, 1, At, B1); PG8_BAR; PG8_SCHED;
            PG8_LDB(B0, 1, 0); PG8_LDB(B1, 1, 1); PG8_SCHED; PG8_LDA(At, 1, 0); PG8_STAGE(PG8_SA(0, 1), a2 + hstep, voffA);
            PG8_WAIT_V(8); PG8_WAIT_L(0); PG8_BAR; PG8_MMA(0, 0, At, B0); PG8_MMA(0, 1, At, B1); PG8_BAR; PG8_SCHED;
            PG8_LDA(At, 1, 1); PG8_STAGE(PG8_SB(1, 0), b3, voffB); PG8_STAGE(PG8_SB(1, 1), b3 + hstep, voffB); PG8_STAGE(PG8_SA(1, 0), a3, voffA);
            PG8_WAIT_V(8); PG8_WAIT_L(0); PG8_BAR; PG8_MMA(1, 0, At, B0); PG8_MMA(1, 1, At, B1); PG8_BAR; PG8_SCHED;
            } else {
            PG8_LDB(B0, 0, 0); PG8_SCHED; PG8_LDA(At, 0, 0); PG8_STAGE(PG8_SA(1, 1), a1 + hstep, voffA);
            PG8_WAIT_L(8); PG8_BAR; PG8_WAIT_L(0); PG8_MMA(0, 0, At, B0); PG8_BAR; PG8_SCHED;
            PG8_LDB(B1, 0, 1); PG8_STAGE(PG8_SB(0, 0), b2, voffB);
            PG8_BAR; PG8_WAIT_L(0); PG8_MMA(0, 1, At, B1); PG8_BAR;
            PG8_LDA(At, 0, 1); PG8_STAGE(PG8_SA(0, 0), a2, voffA);
            PG8_BAR; PG8_WAIT_L(0); PG8_MMA(1, 0, At, B0); PG8_BAR; PG8_SCHED;
            PG8_STAGE(PG8_SB(0, 1), b2 + hstep, voffB);
            PG8_WAIT_V(6); PG8_BAR; PG8_MMA(1, 1, At, B1); PG8_BAR;
            PG8_LDB(B0, 1, 0); PG8_SCHED; PG8_LDA(At, 1, 0); PG8_STAGE(PG8_SA(0, 1), a2 + hstep, voffA);
            PG8_WAIT_L(8); PG8_BAR; PG8_WAIT_L(0); PG8_MMA(0, 0, At, B0); PG8_BAR; PG8_SCHED;
            PG8_LDB(B1, 1, 1); PG8_STAGE(PG8_SB(1, 0), b3, voffB);
            PG8_BAR; PG8_WAIT_L(0); PG8_MMA(0, 1, At, B1); PG8_BAR;
            PG8_LDA(At, 1, 1); PG8_STAGE(PG8_SA(1, 0), a3, voffA);
            PG8_BAR; PG8_WAIT_L(0); PG8_MMA(1, 0, At, B0); PG8_BAR; PG8_SCHED;
            PG8_STAGE(PG8_SB(1, 1), b3 + hstep, voffB);
            PG8_WAIT_V(6); PG8_BAR; PG8_MMA(1, 1, At, B1); PG8_BAR;
            }
        }
        if constexpr (ALIGN_EPI) { if (wr == 0) PG8_BAR; }
        if constexpr (!Epi::AFTER_DRAIN) { E(acc, cur, wr, wc, fr, fq); S.done(cur); }
        if (!has_next) break;
#pragma unroll
        for (int a = 0; a < 2; ++a)
#pragma unroll
            for (int b = 0; b < 2; ++b)
#pragma unroll
                for (int m = 0; m < 4; ++m)
#pragma unroll
                    for (int n = 0; n < 2; ++n) acc[a][b][m][n] = (f32x4){0.f, 0.f, 0.f, 0.f};
        cur = nxt; cA = nA; cB = nB; ++ui;
        if constexpr (ALIGN_EPI) { if (wr == 1) PG8_BAR; }
    }
    PG8_WAIT_V(0);
    if constexpr (!ALIGN_EPI) { if (wr == 0) PG8_BAR; }
    PG8_BAR;
    if constexpr (Epi::AFTER_DRAIN) { E.fused(acc, cur, wr, wc, fr, fq, lds, wid, lane); S.done(cur); }
#undef PG8_SA
#undef PG8_SB
#undef PG8_STAGE
#undef PG8_LDA
#undef PG8_LDB
#undef PG8_MMA
#undef PG8_WAIT_V
#undef PG8_WAIT_L
#undef PG8_BAR
#undef PG8_SCHED
}
}

#ifndef PG8_SP2
#define PG8_SP2 true
#endif
#ifndef PG8_ALIGN
#define PG8_ALIGN true
#endif
namespace pg8 {
__device__ __forceinline__ float bf_lo(unsigned w) { return __uint_as_float(w << 16); }
__device__ __forceinline__ float bf_hi(unsigned w) { return __uint_as_float(w & 0xffff0000u); }
__device__ __forceinline__ float sigmoid_f(float v) { return __builtin_amdgcn_rcpf(1.0f + __builtin_amdgcn_exp2f(-1.4426950408889634f * v)); }
__device__ __forceinline__ u32x4 pack8(const f32x4 v0, const f32x4 v1) { u32x4 w; w.x = cvt_pk_bf16(v0[0], v0[1]); w.y = cvt_pk_bf16(v0[2], v0[3]); w.z = cvt_pk_bf16(v1[0], v1[1]); w.w = cvt_pk_bf16(v1[2], v1[3]); return w; }

struct EpiSwiglu {
    static constexpr bool PERM = true, AFTER_DRAIN = false;
    bf16_t* H; int ldh;
    __device__ __forceinline__ void operator()(const f32x4 (&acc)[2][2][4][2], const Unit& u, int wr, int wc, int fr, int fq) const {
        const int row0 = u.pm * BM + wr * 64 + fr, col0 = u.pn * HALF + wc * 32 + 8 * fq;
#pragma unroll
        for (int ai = 0; ai < 2; ++ai)
#pragma unroll
            for (int m = 0; m < 4; ++m) { bf16_t* rowp = H + (size_t)(row0 + ai * HALF + m * 16) * ldh + col0;
                f32x4 h[2];
#pragma unroll
                for (int n = 0; n < 2; ++n)
#pragma unroll
                    for (int i = 0; i < 4; ++i) { const float g = acc[ai][0][m][n][i], up = acc[ai][1][m][n][i]; h[n][i] = g * sigmoid_f(g) * up; }
                *(u32x4*)rowp = pack8(h[0], h[1]); }
    }
};

struct EpiWin {
    static constexpr bool PERM = true, AFTER_DRAIN = false;
    bf16_t *ZQ, *ZR, *ZG; const float* cs; float c2;
    __device__ __forceinline__ void operator()(const f32x4 (&acc)[2][2][4][2], const Unit& u, int wr, int wc, int fr, int fq) const {
        const int pn = u.pn, row0 = u.pm * BM + wr * 64 + fr;
        bf16_t* base; int ld, colt, mode;
        if (pn < 6) { base = ZQ; ld = 1536; colt = 256 * pn; mode = pn < 2 ? 1 : 0; }
        else if (pn < 14) { base = ZR; ld = 2048; colt = 256 * (pn - 6); mode = pn < 8 ? 2 : pn < 10 ? 3 : pn < 12 ? 0 : 4; }
        else { base = ZG; ld = 2048; colt = 256 * (pn - 14); mode = 5; }
        const int col0 = colt + wc * 32 + 8 * fq;
#pragma unroll
        for (int ai = 0; ai < 2; ++ai)
#pragma unroll
            for (int m = 0; m < 4; ++m) { const int row = row0 + ai * HALF + m * 16; bf16_t* rowp = base + (size_t)row * ld + col0;
                const int t = row & 4095;
                f32x4 cs0 = (f32x4){0.f, 0.f, 0.f, 0.f}, cs1 = cs0;
                if (mode == 2 || mode == 3) { const f32x4* cp = (const f32x4*)(cs + ((size_t)t * 64 + 16 * wc + 4 * fq) * 2); cs0 = cp[0]; cs1 = cp[1]; }
#pragma unroll
                for (int bj = 0; bj < 2; ++bj) { f32x4 v0 = acc[ai][bj][m][0], v1 = acc[ai][bj][m][1];
                    if (mode == 1) { v0 = v0 * c2; v1 = v1 * c2; }
                    else if (mode == 2 || mode == 3) {
                        float sc = 1.f;
                        if (mode == 3) { const int h = 2 * (pn - 8) + bj; const float l2g = __builtin_log2f(1.0f - __builtin_exp2f(-5.0f - (float)h));
                            sc = 0.08838834764831845f * __builtin_exp2f(-(float)(t & 127) * l2g); }
                        f32x4 o0, o1;
                        o0[0] = (v0[0] * cs0[0] - v0[1] * cs0[1]) * sc; o0[1] = (v0[1] * cs0[0] + v0[0] * cs0[1]) * sc;
                        o0[2] = (v0[2] * cs0[2] - v0[3] * cs0[3]) * sc; o0[3] = (v0[3] * cs0[2] + v0[2] * cs0[3]) * sc;
                        o1[0] = (v1[0] * cs1[0] - v1[1] * cs1[1]) * sc; o1[1] = (v1[1] * cs1[0] + v1[0] * cs1[1]) * sc;
                        o1[2] = (v1[2] * cs1[2] - v1[3] * cs1[3]) * sc; o1[3] = (v1[3] * cs1[2] + v1[2] * cs1[3]) * sc;
                        v0 = o0; v1 = o1; }
                    else if (mode == 4) {
#pragma unroll
                        for (int i = 0; i < 4; ++i) { v0[i] = v0[i] * sigmoid_f(v0[i]); v1[i] = v1[i] * sigmoid_f(v1[i]); } }
                    else if (mode == 5) {
#pragma unroll
                        for (int i = 0; i < 4; ++i) { v0[i] = sigmoid_f(v0[i]); v1[i] = sigmoid_f(v1[i]); } }
                    *(u32x4*)(rowp + bj * HALF) = pack8(v0, v1); } }
    }
};

struct EpiGate {
    static constexpr bool PERM = true, AFTER_DRAIN = false;
    bf16_t* O; int ldo; const bf16_t* gate; int ldg; const bf16_t* addend; int lda;
    __device__ __forceinline__ void operator()(const f32x4 (&acc)[2][2][4][2], const Unit& u, int wr, int wc, int fr, int fq) const {
        const int row0 = u.pm * BM + wr * 64 + fr, col0 = u.pn * BM + wc * 32 + 8 * fq;
#pragma unroll
        for (int ai = 0; ai < 2; ++ai)
#pragma unroll
            for (int m = 0; m < 4; ++m) { const size_t row = (size_t)(row0 + ai * HALF + m * 16);
#pragma unroll
                for (int bj = 0; bj < 2; ++bj) { const int c = col0 + bj * HALF;
                    const u32x4 g = *(const u32x4*)(gate + row * ldg + c);
                    f32x4 v0 = acc[ai][bj][m][0], v1 = acc[ai][bj][m][1];
                    v0[0] *= bf_lo(g.x); v0[1] *= bf_hi(g.x); v0[2] *= bf_lo(g.y); v0[3] *= bf_hi(g.y);
                    v1[0] *= bf_lo(g.z); v1[1] *= bf_hi(g.z); v1[2] *= bf_lo(g.w); v1[3] *= bf_hi(g.w);
                    if (addend) { const u32x4 a = *(const u32x4*)(addend + row * lda + c);
                        v0[0] += bf_lo(a.x); v0[1] += bf_hi(a.x); v0[2] += bf_lo(a.y); v0[3] += bf_hi(a.y);
                        v1[0] += bf_lo(a.z); v1[1] += bf_hi(a.z); v1[2] += bf_lo(a.w); v1[3] += bf_hi(a.w); }
                    *(u32x4*)(O + row * ldo + c) = pack8(v0, v1); } }
    }
};
}
#include <hip/hip_bf16.h>
#include <cmath>
namespace attn_body {
using bf16=__hip_bfloat16;
using bf16x8=__attribute__((ext_vector_type(8)))short;
using s16x4=__attribute__((ext_vector_type(4)))short;
using f32x16=__attribute__((ext_vector_type(16)))float;
using u32x4=__attribute__((ext_vector_type(4)))unsigned;
constexpr int BATCH=8,SEQ=4096,D=64,DM=1536,OPITCH=1024;
constexpr int NW=8,QBLK=32,QB=QBLK*NW,KVBLK=64,NQB=SEQ/QB;
constexpr int ATTN_PITCH=DM, ATTN_UNIT_ROWS=QB;
__device__ __forceinline__ int crow(int r,int hi){return (r&3)+8*(r>>2)+4*hi;}
#define SBAR() __builtin_amdgcn_sched_barrier(0)
__device__ __forceinline__ void cmask(f32x16&p0,f32x16&p1,int jb,int qrel,int hi){
  const float NEG=-INFINITY; int kb=64*jb+4*hi;
  #pragma unroll
  for(int r=0;r<16;++r){int kv=kb+(r&3)+8*(r>>2); if(kv>qrel)p0[r]=NEG; if(kv+32>qrel)p1[r]=NEG;}
}

constexpr int NSLOT=3, SLOTB=8192;
constexpr int LDS_K=0, LDS_V=NSLOT*SLOTB, LDS_WS=2*NSLOT*SLOTB, LDS_OST=LDS_WS+NW*64*4, LDS_BYTES=LDS_OST+NW*4096;
constexpr float C2=0.125f*1.4426950408889634f;
__device__ __forceinline__ void glds16(const void*gsrc,unsigned lds_dst){unsigned keep;
  asm volatile("s_mov_b32 %0, m0\n\ts_mov_b32 m0, %2\n\ts_nop 0\n\tglobal_load_lds_dwordx4 %1, off\n\ts_mov_b32 m0, %0":"=&s"(keep):"v"(gsrc),"s"(lds_dst):"memory");}
__device__ __forceinline__ float max3f(float a,float b,float c){float r;asm("v_max3_f32 %0, %1, %2, %3":"=v"(r):"v"(a),"v"(b),"v"(c));return r;}
__device__ __forceinline__ float max2f(float a,float b){float r;asm("v_max_f32_e32 %0, %1, %2":"=v"(r):"v"(a),"v"(b));return r;}
__device__ __forceinline__ float fadd_s(float a,float b){float r;asm("v_add_f32_e32 %0, %1, %2":"=v"(r):"v"(a),"v"(b));return r;}
__device__ __forceinline__ float fsub_s(float a,float b){float r;asm("v_sub_f32_e32 %0, %1, %2":"=v"(r):"v"(a),"v"(b));return r;}
typedef float f32x2_t __attribute__((ext_vector_type(2))); typedef __bf16 bf16x2_t __attribute__((ext_vector_type(2)));
__device__ __forceinline__ unsigned cvtpk_s(float lo,float hi){f32x2_t v={lo,hi};bf16x2_t b=__builtin_convertvector(v,bf16x2_t);return __builtin_bit_cast(unsigned,b);}
#define WAIT_BAR(N) asm volatile("s_waitcnt vmcnt(" #N ") lgkmcnt(0)\n\ts_barrier":::"memory")

__device__ __forceinline__ void qkt(f32x16&p0,f32x16&p1,const char*Kslot,const bf16x8*qr,const f32x16&negm,int r32,int hi){
  const char*kb=Kslot+hi*1024+r32*16;
  #pragma unroll
  for(int d0=0;d0<4;++d0){
    const bf16x8 b0=*reinterpret_cast<const bf16x8*>(kb+d0*2048);
    const bf16x8 b1=*reinterpret_cast<const bf16x8*>(kb+d0*2048+512);
    if(d0==0){p0=__builtin_amdgcn_mfma_f32_32x32x16_bf16(b0,qr[0],negm,0,0,0);p1=__builtin_amdgcn_mfma_f32_32x32x16_bf16(b1,qr[0],negm,0,0,0);}
    else{p0=__builtin_amdgcn_mfma_f32_32x32x16_bf16(b0,qr[d0],p0,0,0,0);p1=__builtin_amdgcn_mfma_f32_32x32x16_bf16(b1,qr[d0],p1,0,0,0);}}
}
typedef __attribute__((address_space(3))) const char* lds_cptr;
typedef short v4i16_t __attribute__((ext_vector_type(4)));
__device__ __forceinline__ void kload8(bf16x8*kf,lds_cptr kp){
  kf[0]=*(const __attribute__((address_space(3))) bf16x8*)(kp);      kf[1]=*(const __attribute__((address_space(3))) bf16x8*)(kp+512);
  kf[2]=*(const __attribute__((address_space(3))) bf16x8*)(kp+2048); kf[3]=*(const __attribute__((address_space(3))) bf16x8*)(kp+2560);
  kf[4]=*(const __attribute__((address_space(3))) bf16x8*)(kp+4096); kf[5]=*(const __attribute__((address_space(3))) bf16x8*)(kp+4608);
  kf[6]=*(const __attribute__((address_space(3))) bf16x8*)(kp+6144); kf[7]=*(const __attribute__((address_space(3))) bf16x8*)(kp+6656);
}
__device__ __forceinline__ void kload2(bf16x8*kf,lds_cptr kp,int j){ kf[2*j]=*(const __attribute__((address_space(3))) bf16x8*)(kp+j*2048); kf[2*j+1]=*(const __attribute__((address_space(3))) bf16x8*)(kp+j*2048+512); }
__device__ __forceinline__ s16x4 vtr(lds_cptr p){ return __builtin_bit_cast(s16x4,__builtin_amdgcn_ds_read_tr16_b64_v4i16((__attribute__((address_space(3))) v4i16_t*)p)); }
__device__ __forceinline__ float rowmax(const f32x16&p0,const f32x16&p1){
  float a=max3f(p0[0],p0[1],p1[0]),b=max3f(p0[2],p0[3],p1[1]);a=max3f(a,p1[2],p1[3]);
  #pragma unroll
  for(int r=4;r<16;r+=4){a=max3f(a,p0[r],p0[r+1]);b=max3f(b,p0[r+2],p0[r+3]);a=max3f(a,p1[r],p1[r+1]);b=max3f(b,p1[r+2],p1[r+3]);}
  const float m=max2f(a,b);
  auto rr=__builtin_amdgcn_permlane32_swap(__float_as_uint(m),__float_as_uint(m),false,false);
  return max2f(__uint_as_float(rr[0]),__uint_as_float(rr[1]));
}
__device__ __forceinline__ void pv(f32x16*o,int vb,bf16x8 pa0,bf16x8 pa1,bf16x8 pa2,bf16x8 pa3){
  #pragma unroll
  for(int d0=0;d0<2;++d0){s16x4 lo[4],hi[4];
    #pragma unroll
    for(int ks=0;ks<4;++ks){
      asm volatile("ds_read_b64_tr_b16 %0,%1 offset:%c2":"=&v"(lo[ks]):"v"(vb),"i"(d0*4096+ks*1024):"memory");
      asm volatile("ds_read_b64_tr_b16 %0,%1 offset:%c2":"=&v"(hi[ks]):"v"(vb),"i"(d0*4096+ks*1024+512):"memory");}
    asm volatile("s_waitcnt lgkmcnt(0)":::"memory");SBAR();
    #define PK(k) (bf16x8){lo[k][0],lo[k][1],lo[k][2],lo[k][3],hi[k][0],hi[k][1],hi[k][2],hi[k][3]}
    o[d0]=__builtin_amdgcn_mfma_f32_32x32x16_bf16(pa0,PK(0),o[d0],0,0,0);
    o[d0]=__builtin_amdgcn_mfma_f32_32x32x16_bf16(pa1,PK(1),o[d0],0,0,0);
    o[d0]=__builtin_amdgcn_mfma_f32_32x32x16_bf16(pa2,PK(2),o[d0],0,0,0);
    o[d0]=__builtin_amdgcn_mfma_f32_32x32x16_bf16(pa3,PK(3),o[d0],0,0,0);
    #undef PK
  }
}

#ifndef ATTN_STORE16
#define ATTN_STORE16(p,v) (*(u32x4*)(p)=(v))
#endif
template<int THRL> __device__ __forceinline__ void attn_unit(int b,int h,int qb,const bf16*Q,const bf16*__restrict__ K,const bf16*__restrict__ V,bf16*O,char*shm){
  int tid_=threadIdx.x; asm volatile("":"+v"(tid_)); const int tid=tid_,lane=tid&63,r32=lane&31,hi=lane>>5; const int wid=__builtin_amdgcn_readfirstlane(tid>>6);
  const long rowbase=(long)b*SEQ; const int q0=qb*QB;
  const bf16*Qw=Q+(rowbase+q0+wid*QBLK)*DM+h*D;
  const bf16*Kh=K+rowbase*DM+h*D,*Vh=V+rowbase*DM+h*D;
  const unsigned lds0=(unsigned)(uintptr_t)shm;
  float*wsf=(float*)(shm+LDS_WS)+wid*64;
  const bf16*ksrc=Kh+(long)lane*DM+wid*8;
  const bf16*vsrc=Vh+(long)(16*(wid&3)+(lane>>2))*DM+(wid>>2)*32+(lane&3)*8;
  const unsigned kdst=lds0+LDS_K+wid*1024, vdst=lds0+LDS_V+wid*1024;
  #define DMA_K(t,slot) glds16(ksrc+(long)(t)*KVBLK*DM,(unsigned)__builtin_amdgcn_readfirstlane(kdst+(slot)))
  #define DMA_V(t,slot) glds16(vsrc+(long)(t)*KVBLK*DM,(unsigned)__builtin_amdgcn_readfirstlane(vdst+(slot)))
  const int vb0=(int)(lds0+LDS_V)+((lane>>4)&1)*32+(lane&3)*8+(4*hi+((lane&15)>>2))*64;
  const char*Kbase=shm+LDS_K; bf16x8 kf[8];
  const lds_cptr shm3=(lds_cptr)shm; const lds_cptr kp0=shm3+LDS_K+hi*1024+r32*16; const lds_cptr vp0=shm3+LDS_V+((lane>>4)&1)*32+(lane&3)*8+(4*hi+((lane&15)>>2))*64;
  const int NT=(q0+QB)/KVBLK;
  DMA_K(0,0);DMA_V(0,0);DMA_K(1,SLOTB);
  bf16x8 qr[4];
  #pragma unroll
  for(int d0=0;d0<4;++d0)qr[d0]=*reinterpret_cast<const bf16x8*>(&Qw[(long)r32*DM+d0*16+hi*8]);
  float mhat=0.f,l_reg=0.f;f32x16 o[2];o[0]=f32x16{};o[1]=f32x16{};f32x16 negm=f32x16{};asm volatile("":"+v"(negm));
  const int qrel=wid*QBLK+r32;
  #define CMASK(P0,P1,t) do{int jb_=(t)-(NT-4); if(jb_>=0)cmask(P0,P1,jb_,qrel,hi);}while(0)
  bool resc=false;
  #define START(P0,P1) do{ const float rm=rowmax(P0,P1); resc=false; \
    { const float dl=rm; mhat=fadd_s(mhat,dl); \
      _Pragma("unroll") for(int r=0;r<16;++r){P0[r]=fsub_s(P0[r],dl);P1[r]=fsub_s(P1[r],dl);} \
      _Pragma("unroll") for(int r=0;r<16;++r)negm[r]=-mhat; asm volatile("":"+v"(negm)); } \
    _Pragma("unroll") for(int r=0;r<16;++r)P0[r]=__builtin_amdgcn_exp2f(P0[r]); }while(0)
  #define RESC() do{ if(resc){ asm volatile("s_waitcnt lgkmcnt(0)":::"memory"); \
      _Pragma("unroll") for(int d_=0;d_<2;++d_) _Pragma("unroll") for(int r=0;r<16;++r)o[d_][r]*=wsf[crow(r,hi)]; } }while(0)
  f32x16 pA0,pA1,pB0,pB1;
  int sl_prev=0,sl_cur=0,sl_next=SLOTB;
  #define ROT() do{sl_prev=sl_cur;sl_cur=sl_next;sl_next=(sl_next==(NSLOT-1)*SLOTB)?0:sl_next+SLOTB;}while(0)
  DMA_K(2,2*SLOTB);
  WAIT_BAR(3);
  qkt(pA0,pA1,Kbase,qr,negm,r32,hi);asm volatile("s_nop 15\n\ts_nop 7":"+v"(pA0),"+v"(pA1));CMASK(pA0,pA1,0);
  START(pA0,pA1);
  _Pragma("unroll") for(int r=0;r<16;++r)pA1[r]=__builtin_amdgcn_exp2f(pA1[r]);
  WAIT_BAR(0);
  DMA_K(3,0);DMA_V(1,SLOTB);
  ROT();
  kload8(kf,kp0+sl_cur);
  WAIT_BAR(2);
  s16x4 vlo[8],vhi[8]; u32x4 pw0,pw1,pw2,pw3;
  #define PKW(P,B) cvtpk_s(P[B],P[B+1])
  #define PAF(k) __builtin_bit_cast(bf16x8,pw##k)
  #define VFR(i) (bf16x8){vlo[i][0],vlo[i][1],vlo[i][2],vlo[i][3],vhi[i][0],vhi[i][1],vhi[i][2],vhi[i][3]}
  #define PIN(x) asm volatile("":"+v"(x))
  #define MX3(a,b,c) __builtin_fmaxf(__builtin_fmaxf((a),(b)),(c))
  #define GAPA(MF,A0,A1,A2,A3,W0,W1,PW) do{ MF; sacc+=A0; sacc+=A1; sacc+=A2; sacc+=A3; PIN(sacc); W0; W1; PIN(PW); SBAR(); }while(0)
  #define EX(v) __builtin_amdgcn_exp2f(v)
  #define GAPB(MF,X,B) do{ MF; X[B]=EX(X[B]); X[B+1]=EX(X[B+1]); X[B+2]=EX(X[B+2]); X[B+3]=EX(X[B+3]); PIN(X); SBAR(); }while(0)
  #define VRD(i) do{ vlo[i]=vtr(vp_+(((i)>>2)*4096+((i)&3)*1024)); vhi[i]=vtr(vp_+(((i)>>2)*4096+((i)&3)*1024+512)); }while(0)
  #define KRD(G,j) do{ if(G){ kload2(kf,kp0+sl_next,j); SBAR(); } }while(0)
  #define STEP(C0,C1,P0,P1,t,GK,GV,GL) do{ SBAR(); \
    const lds_cptr vp_=vp0+sl_prev; \
    VRD(0); SBAR(); float sacc=(P0[0]+P0[1]); \
    GAPA(C0=__builtin_amdgcn_mfma_f32_32x32x16_bf16(kf[0],qr[0],negm,0,0,0), P0[2],P0[3],P0[4],P0[5],     pw0[0]=PKW(P0,0), pw0[1]=PKW(P0,2), pw0); \
    VRD(4); SBAR(); GAPA(C1=__builtin_amdgcn_mfma_f32_32x32x16_bf16(kf[1],qr[0],negm,0,0,0), P0[6],P0[7],P0[8],P0[9],     pw0[2]=PKW(P0,4), pw0[3]=PKW(P0,6), pw0); \
    VRD(1); SBAR(); GAPA(C0=__builtin_amdgcn_mfma_f32_32x32x16_bf16(kf[2],qr[1],C0,0,0,0),   P0[10],P0[11],P0[12],P0[13], pw1[0]=PKW(P0,8), pw1[1]=PKW(P0,10), pw1); \
    VRD(5); SBAR(); GAPA(C1=__builtin_amdgcn_mfma_f32_32x32x16_bf16(kf[3],qr[1],C1,0,0,0),   P0[14],P0[15],P1[0],P1[1],   pw1[2]=PKW(P0,12),pw1[3]=PKW(P0,14), pw1); \
    VRD(2); SBAR(); GAPA(C0=__builtin_amdgcn_mfma_f32_32x32x16_bf16(kf[4],qr[2],C0,0,0,0),   P1[2],P1[3],P1[4],P1[5],     pw2[0]=PKW(P1,0), pw2[1]=PKW(P1,2), pw2); \
    VRD(6); SBAR(); GAPA(C1=__builtin_amdgcn_mfma_f32_32x32x16_bf16(kf[5],qr[2],C1,0,0,0),   P1[6],P1[7],P1[8],P1[9],     pw2[2]=PKW(P1,4), pw2[3]=PKW(P1,6), pw2); \
    VRD(3); SBAR(); GAPA(C0=__builtin_amdgcn_mfma_f32_32x32x16_bf16(kf[6],qr[3],C0,0,0,0),   P1[10],P1[11],P1[12],P1[13], pw3[0]=PKW(P1,8), pw3[1]=PKW(P1,10), pw3); \
    VRD(7); SBAR(); GAPA(C1=__builtin_amdgcn_mfma_f32_32x32x16_bf16(kf[7],qr[3],C1,0,0,0),   P1[14],P1[15],0.f,0.f,       pw3[2]=PKW(P1,12),pw3[3]=PKW(P1,14), pw3); \
    l_reg+=sacc; \
    if(GK){DMA_K((t)+3,sl_cur);} if(GV){DMA_V((t)+1,sl_next);} \
    CMASK(C0,C1,t); \
    { float a=MX3(C0[0],C0[1],C1[0]),b=MX3(C0[2],C0[3],C1[1]); a=MX3(a,C1[2],C1[3]); \
      _Pragma("unroll") for(int r=4;r<16;r+=4){a=MX3(a,C0[r],C0[r+1]);b=MX3(b,C0[r+2],C0[r+3]);a=MX3(a,C1[r],C1[r+1]);b=MX3(b,C1[r+2],C1[r+3]);} \
      float rm=__builtin_fmaxf(a,b); { auto rr=__builtin_amdgcn_permlane32_swap(__float_as_uint(rm),__float_as_uint(rm),false,false); rm=__builtin_fmaxf(__uint_as_float(rr[0]),__uint_as_float(rr[1])); } \
      resc=false; \
      if(__builtin_expect(__any(rm>(float)THRL),0)){ const float dl=__builtin_fmaxf(rm,0.f); mhat+=dl; \
        _Pragma("unroll") for(int r=0;r<16;++r){C0[r]-=dl;C1[r]-=dl;} \
        _Pragma("unroll") for(int r=0;r<16;++r)negm[r]=-mhat; asm volatile("":"+v"(negm)); \
        const float f=__builtin_amdgcn_exp2f(-dl); l_reg*=f; if(hi==0)wsf[r32]=f; resc=true; } } \
    SBAR(); \
    GAPB(o[0]=__builtin_amdgcn_mfma_f32_32x32x16_bf16(PAF(0),VFR(0),o[0],0,0,0), C0,0); \
    GAPB(o[1]=__builtin_amdgcn_mfma_f32_32x32x16_bf16(PAF(0),VFR(4),o[1],0,0,0), C0,4); \
    KRD(GL,0); GAPB(o[0]=__builtin_amdgcn_mfma_f32_32x32x16_bf16(PAF(1),VFR(1),o[0],0,0,0), C0,8); \
    KRD(GL,1); GAPB(o[1]=__builtin_amdgcn_mfma_f32_32x32x16_bf16(PAF(1),VFR(5),o[1],0,0,0), C0,12); \
    KRD(GL,2); GAPB(o[0]=__builtin_amdgcn_mfma_f32_32x32x16_bf16(PAF(2),VFR(2),o[0],0,0,0), C1,0); \
    KRD(GL,3); GAPB(o[1]=__builtin_amdgcn_mfma_f32_32x32x16_bf16(PAF(2),VFR(6),o[1],0,0,0), C1,4); \
    GAPB(o[0]=__builtin_amdgcn_mfma_f32_32x32x16_bf16(PAF(3),VFR(3),o[0],0,0,0), C1,8); \
    GAPB(o[1]=__builtin_amdgcn_mfma_f32_32x32x16_bf16(PAF(3),VFR(7),o[1],0,0,0), C1,12); \
    }while(0)
  int t=1;
  #undef CMASK
  #define CMASK(P0,P1,t) do{}while(0)
  for(;t+5<NT;t+=2){
    STEP(pB0,pB1,pA0,pA1,t,true,true,true);     WAIT_BAR(2); RESC(); ROT();
    STEP(pA0,pA1,pB0,pB1,t+1,true,true,true);   WAIT_BAR(2); RESC(); ROT();
  }
  #undef CMASK
  #define CMASK(P0,P1,t) do{int jb_=(t)-(NT-4); if(jb_>=0)cmask(P0,P1,jb_,qrel,hi);}while(0)
  #define ENDW(tt) do{ if((tt)+3<NT){WAIT_BAR(2);} else if((tt)+2<NT){WAIT_BAR(1);} else {WAIT_BAR(0);} }while(0)
  for(;t+1<NT;t+=2){
    STEP(pB0,pB1,pA0,pA1,t,(t+3<NT),(t+1<NT),(t+1<NT));       ENDW(t);   RESC(); ROT();
    STEP(pA0,pA1,pB0,pB1,t+1,(t+4<NT),(t+2<NT),(t+2<NT));     ENDW(t+1); RESC(); ROT();
  }
  STEP(pB0,pB1,pA0,pA1,NT-1,false,false,false); RESC();
  { float sacc=pB0[0]+pB0[1]; _Pragma("unroll") for(int r=2;r<16;++r)sacc+=pB0[r]; _Pragma("unroll") for(int r=0;r<16;++r)sacc+=pB1[r]; l_reg+=sacc;
    pw0=(u32x4){PKW(pB0,0),PKW(pB0,2),PKW(pB0,4),PKW(pB0,6)};pw1=(u32x4){PKW(pB0,8),PKW(pB0,10),PKW(pB0,12),PKW(pB0,14)};pw2=(u32x4){PKW(pB1,0),PKW(pB1,2),PKW(pB1,4),PKW(pB1,6)};pw3=(u32x4){PKW(pB1,8),PKW(pB1,10),PKW(pB1,12),PKW(pB1,14)};
    SBAR(); pv(o,vb0+sl_cur,PAF(0),PAF(1),PAF(2),PAF(3)); }
  #undef PKW
  #undef PAF
  #undef VFR
  #undef PIN
  #undef MX3
  #undef GAPA
  #undef GAPB
  #undef EX
  #undef VRD
  #undef KRD
  #undef STEP
  #undef ENDW
  {auto rr=__builtin_amdgcn_permlane32_swap(__float_as_uint(l_reg),__float_as_uint(l_reg),false,false);l_reg=__uint_as_float(rr[0])+__uint_as_float(rr[1]);}
  if(hi==0)wsf[32+r32]=l_reg;asm volatile("s_waitcnt lgkmcnt(0)":::"memory");
  float rli[16];
  #pragma unroll
  for(int r=0;r<16;++r)rli[r]=__builtin_amdgcn_rcpf(wsf[32+crow(r,hi)]);
  bf16*Ow=O+(rowbase+q0+wid*QBLK)*OPITCH+h*D;
  { bf16*stg=(bf16*)(shm+LDS_OST)+wid*2048;
    #pragma unroll
    for(int r=0;r<16;++r){const int orow=crow(r,hi);
      #pragma unroll
      for(int d0=0;d0<2;++d0)stg[orow*64+d0*32+r32]=__float2bfloat16(o[d0][r]*rli[r]);}
    asm volatile("s_waitcnt lgkmcnt(0)":::"memory");
    #pragma unroll
    for(int i=0;i<4;++i){const int row=i*8+(lane>>3),ch=lane&7; const u32x4 v=*(const u32x4*)(stg+row*64+ch*8); ATTN_STORE16(Ow+(long)row*OPITCH+ch*8,v);} }
  asm volatile("s_waitcnt lgkmcnt(0)\n\ts_barrier":::"memory");
  #undef DMA_K
  #undef DMA_V
  #undef CMASK
  #undef START
  #undef RESC
  #undef ROT
}
constexpr int ATTN_LDS_BYTES=LDS_BYTES;
struct AttnUnit { int b; int vh; int qb; };
struct StaticOrder {
  int vcu, G;
  __device__ __forceinline__ explicit StaticOrder(int grid,int block):vcu((grid%8==0)?((block%8)*(grid/8)+block/8):block),G(grid){}
  __device__ __forceinline__ bool next(int i,AttnUnit&u)const{ const int p=vcu+(i>>1)*G; if(p>=1024)return false; const int s=p&7, bvh=p>>3; u.b=bvh>>4; u.vh=bvh&15; u.qb=(i&1)?s:15-s; return true; }
  __device__ __forceinline__ void a_ready(const AttnUnit&)const{}
  __device__ __forceinline__ void done(const AttnUnit&)const{}
};
struct AttnTensors { const bf16* ZQ; bf16* O; };
template<class Sched,int THRL=8> __device__ __forceinline__ void attn_phase(char*lds,const AttnTensors&T,const Sched&S){
  AttnUnit u;
  for(int i=0;S.next(i,u);++i){ S.a_ready(u); const int m=u.vh>>1, vhalf=u.vh&1;
    attn_unit<THRL>(u.b,0,u.qb,T.ZQ+64*m,T.ZQ+512+64*m,T.ZQ+1024+128*(m>>1)+64*vhalf,T.O+64*u.vh,lds); S.done(u); }
}
#undef SBAR
#undef WAIT_BAR
}
constexpr int NWAVES = 8;
constexpr int BATCH = 8, T = 4096, D = 1024, FF = 2816, DIN = 5632;
constexpr int M = BATCH * T;
constexpr size_t MiB = 1u << 20;
constexpr size_t WS_CTL = 0, CTL_ZERO_BYTES = 1 * MiB;
constexpr size_t WS_CS = 1 * MiB;
constexpr size_t WS_WIN = 4 * MiB, WS_WAP = 15 * MiB, WS_WRP = 16 * MiB, WS_WOUT = 17 * MiB;
constexpr size_t WS_XN = 20 * MiB;
constexpr size_t WS_Y = 84 * MiB;
constexpr size_t WS_R0 = 148 * MiB;
constexpr size_t WS_H = WS_R0, WS_WGU = WS_R0 + 176 * MiB, WS_WD = WS_R0 + 188 * MiB;
constexpr size_t WS_ZQ = WS_R0, WS_ZR = WS_R0 + 96 * MiB, WS_ZG = WS_R0 + 224 * MiB;
constexpr size_t WS_PT = WS_ZQ, WS_RT = WS_ZQ + 32 * MiB, WS_DA = WS_ZQ + 64 * MiB;
constexpr size_t WS_MG = WS_ZR;
constexpr size_t WS_AO = WS_XN, WS_KVT = WS_Y, WS_T1 = WS_Y;
constexpr size_t WS_END = 500 * MiB;
static_assert(WS_WD + (size_t)D * FF * 2 <= WS_R0 + 352 * MiB && WS_ZG + (size_t)M * 2048 * 2 == WS_R0 + 352 * MiB && WS_R0 + 352 * MiB == WS_END, "d_ws map");
static_assert(WS_WIN + (size_t)DIN * D * 2 <= WS_WAP && WS_WOUT + (size_t)D * D * 2 <= WS_XN && WS_XN + (size_t)M * D * 2 == WS_Y && WS_Y + (size_t)M * D * 2 == WS_R0, "d_ws map");
constexpr int CW_BAR = 4096;
constexpr int RING_OFF = 0, RING_BYTES = 131072;
constexpr int LDSCTL_OFF = RING_BYTES, MISC_OFF = LDSCTL_OFF + 320;
constexpr int LDS_BYTES = 147456;
static_assert(MISC_OFF + 128 <= LDS_BYTES, "LDS map");
#define GAS __attribute__((address_space(1)))
#define LAS __attribute__((address_space(3)))
typedef unsigned short bf16;
typedef unsigned v4u __attribute__((ext_vector_type(4)));
typedef float f32x4 __attribute__((ext_vector_type(4)));
typedef short bf16x8 __attribute__((ext_vector_type(8)));
typedef GAS unsigned gu32;
typedef GAS unsigned long long gu64;
#define RLX_AGENT __ATOMIC_RELAXED, __HIP_MEMORY_SCOPE_AGENT
#define LDS_WAIT() asm volatile("s_waitcnt lgkmcnt(0)" ::: "memory")
#define VM_WAIT() asm volatile("s_waitcnt vmcnt(0)" ::: "memory")
__device__ __forceinline__ unsigned long long rt() { return __builtin_amdgcn_s_memrealtime(); }
__device__ __forceinline__ unsigned f2bf(float f) { unsigned u = __builtin_bit_cast(unsigned, f); return (u + 0x7fffu + ((u >> 16) & 1u)) >> 16; }
__device__ __forceinline__ unsigned pk2(float lo, float hi) { return f2bf(lo) | (f2bf(hi) << 16); }

#define XB_TMO      128
#define XB_XCNT(j)  (256  + 64 * (j))
#define XB_XSUB(j)  (1280 + 64 * (j))
#define XB_XGEN(j)  (2304 + 64 * (j))
#define XB_TOP      3328
#define XB_TOPGEN   3392
#define XCD_BAR_WORDS 3456
#define XB_SPIN_CAP (1u << 18)

__device__ __forceinline__ unsigned xb_ld(unsigned* p)              { return __hip_atomic_load(p, __ATOMIC_RELAXED, __HIP_MEMORY_SCOPE_AGENT); }
__device__ __forceinline__ unsigned xb_add(unsigned* p, unsigned v) { return __hip_atomic_fetch_add(p, v, __ATOMIC_RELAXED, __HIP_MEMORY_SCOPE_AGENT); }
__device__ __forceinline__ unsigned xb_xcc_id() { return (unsigned)__builtin_amdgcn_s_getreg((3 << 11) | 20) & 0xFu; }
#define XB_SPIN(cond, bar) do { unsigned _sp = 0; while (cond) { __builtin_amdgcn_s_sleep(1); \
    if ((++_sp & 255u) == 0u) { if (xb_ld(&(bar)[XB_TMO])) break; if (_sp > XB_SPIN_CAP) { atomicAdd(&(bar)[XB_TMO], 1u); break; } } } } while (0)

struct XcdBarrier {
    unsigned* bar; unsigned x;
    volatile LAS unsigned* st;
};

__device__ __forceinline__ XcdBarrier xcd_barrier_post(unsigned* bar, volatile LAS unsigned* st) {
    XcdBarrier b; b.bar = bar; b.x = xb_xcc_id(); b.st = st;
    if (threadIdx.x == 0) (void)xb_add(&bar[XB_XCNT(b.x)], 1u);
    return b;
}
__device__ __forceinline__ void xcd_barrier_complete(unsigned* bar, unsigned x, unsigned& nloc, unsigned& nx) {
    const unsigned G = gridDim.x * gridDim.y * gridDim.z;
    unsigned sum, cnt, mine, sp = 0u;
    for (;;) {
        sum = 0u; cnt = 0u; mine = 0u;
#pragma unroll
        for (unsigned j = 0; j < 16; ++j) { const unsigned c = xb_ld(&bar[XB_XCNT(j)]); sum += c; cnt += (c > 0u) ? 1u : 0u; mine = (j == x) ? c : mine; }
        if (sum == G) break;
        __builtin_amdgcn_s_sleep(1);
        if ((++sp & 255u) == 0u) { if (xb_ld(&bar[XB_TMO])) break; if (sp > XB_SPIN_CAP) { atomicAdd(&bar[XB_TMO], 1u); break; } }
    }
    nloc = mine > 0u ? mine : 1u; nx = cnt > 0u ? cnt : 1u;
}

__device__ __forceinline__ void xcd_barrier(const XcdBarrier& b) {
    asm volatile("s_waitcnt vmcnt(0)" ::: "memory");
    __syncthreads();
    if (threadIdx.x == 0) {
        unsigned* bar = b.bar;
        __builtin_amdgcn_s_waitcnt(0);
        unsigned nloc = b.st[0], nx = b.st[1];
        if (nloc == 0u) { xcd_barrier_complete(bar, b.x, nloc, nx); b.st[0] = nloc; b.st[1] = nx; }
        const unsigned old = xb_add(&bar[XB_XSUB(b.x)], 1u);
        const unsigned gen = old / nloc;
        if (old + 1u == (gen + 1u) * nloc) {
            __builtin_amdgcn_fence(__ATOMIC_RELEASE, "agent");
            asm volatile("s_waitcnt vmcnt(0)" ::: "memory");
            const unsigned og = xb_add(&bar[XB_TOP], 1u);
            const unsigned tg = og / nx;
            if (og + 1u == (tg + 1u) * nx) xb_add(&bar[XB_TOPGEN], 1u);
            else XB_SPIN(xb_ld(&bar[XB_TOPGEN]) == tg, bar);
            __builtin_amdgcn_fence(__ATOMIC_ACQUIRE, "agent");
            xb_add(&bar[XB_XGEN(b.x)], 1u);
            asm volatile("s_waitcnt vmcnt(0)" ::: "memory");
        } else {
            XB_SPIN(xb_ld(&bar[XB_XGEN(b.x)]) == gen, bar);
            __builtin_amdgcn_fence(__ATOMIC_ACQUIRE, "agent");
            asm volatile("s_waitcnt vmcnt(0)" ::: "memory");
        }
    }
    __syncthreads();
}
struct Frame {
    LAS unsigned char* lds;
    volatile LAS unsigned* MISC;
    gu32* ctl;
    int tid, lane, wave;
    int vcu, G;
};

__device__ __forceinline__ float wave_sum(float v) {
#pragma unroll
    for (int o = 1; o < 64; o <<= 1) v += __shfl_xor(v, o);
    return v;
}
__device__ __forceinline__ float bfl(unsigned w) { return __uint_as_float(w << 16); }
__device__ __forceinline__ float bfh(unsigned w) { return __uint_as_float(w & 0xffff0000u); }

__device__ __forceinline__ void transpose_item(const float* W, int K, int N, bf16* WT, int mode, LAS float* scr, int item, int lane) {
    const int nblk = N / 32, kb = item / nblk, nb = item % nblk, k0 = 64 * kb, n0 = 32 * nb;
    const int rbase = (mode == 0) ? n0 : (256 * (n0 >> 7) + (n0 & 127) + (mode == 2 ? 128 : 0));
#pragma unroll 8
    for (int i = 0; i < 32; ++i) { const int kk = 2 * i + (lane >> 5); scr[kk * 33 + (lane & 31)] = W[(size_t)(k0 + kk) * N + n0 + (lane & 31)]; }
    LDS_WAIT(); asm volatile("" ::: "memory");
    const int c = lane & 7;
#pragma unroll
    for (int j = 0; j < 4; ++j) { const int n = (lane >> 3) + 8 * j; const LAS float* s = scr + (8 * c) * 33 + n;
        v4u o; o.x = pk2(s[0 * 33], s[1 * 33]); o.y = pk2(s[2 * 33], s[3 * 33]); o.z = pk2(s[4 * 33], s[5 * 33]); o.w = pk2(s[6 * 33], s[7 * 33]);
        *(GAS v4u*)(WT + (size_t)(rbase + n) * K + k0 + 8 * c) = o; }
    LDS_WAIT(); asm volatile("" ::: "memory");
}

template <bool HAS_Y, bool HAS_NEXT>
__device__ __forceinline__ void row_phase(Frame& F, const float* xin, const bf16* y, const float* gpost, float scale, float* xout, const float* gnext, bf16* xn) {
    const int gw = F.vcu * NWAVES + F.wave, NGW = F.G * NWAVES;
    f32x4 gp[4], gn[4];
#pragma unroll
    for (int j = 0; j < 4; ++j) { gp[j] = HAS_Y ? *(const f32x4*)(gpost + 256 * j + 4 * F.lane) : (f32x4){0.f, 0.f, 0.f, 0.f};
                                  gn[j] = HAS_NEXT ? *(const f32x4*)(gnext + 256 * j + 4 * F.lane) : (f32x4){0.f, 0.f, 0.f, 0.f}; }
    for (int m = gw; m < M; m += NGW) {
        const GAS f32x4* xr = (const GAS f32x4*)(xin + (size_t)m * D) + F.lane;
        f32x4 v[4];
#pragma unroll
        for (int j = 0; j < 4; ++j) v[j] = xr[64 * j];
        if (HAS_Y) {
            const GAS unsigned long long* yr = (const GAS unsigned long long*)(y + (size_t)m * D) + F.lane;
            f32x4 yv[4]; float s = 0.f;
#pragma unroll
            for (int j = 0; j < 4; ++j) { const unsigned long long w = yr[64 * j]; const unsigned lo = (unsigned)w, hi = (unsigned)(w >> 32);
                yv[j] = (f32x4){bfl(lo), bfh(lo), bfl(hi), bfh(hi)}; s += (yv[j].x * yv[j].x + yv[j].y * yv[j].y) + (yv[j].z * yv[j].z + yv[j].w * yv[j].w); }
            const float ry = scale / sqrtf(wave_sum(s) * (1.f / D) + 1e-6f);
            GAS f32x4* xo = (GAS f32x4*)(xout + (size_t)m * D) + F.lane;
#pragma unroll
            for (int j = 0; j < 4; ++j) { v[j] = v[j] + yv[j] * ry * gp[j]; xo[64 * j] = v[j]; }
        }
        if (HAS_NEXT) {
            float s2 = 0.f;
#pragma unroll
            for (int j = 0; j < 4; ++j) s2 += (v[j].x * v[j].x + v[j].y * v[j].y) + (v[j].z * v[j].z + v[j].w * v[j].w);
            const float rx = 1.f / sqrtf(wave_sum(s2) * (1.f / D) + 1e-6f);
            GAS unsigned long long* o8 = (GAS unsigned long long*)(xn + (size_t)m * D) + F.lane;
#pragma unroll
            for (int j = 0; j < 4; ++j) { const f32x4 o = v[j] * rx * gn[j]; o8[64 * j] = (unsigned long long)pk2(o.x, o.y) | ((unsigned long long)pk2(o.z, o.w) << 32); }
        }
    }
}

namespace ret {
typedef short bf16x8 __attribute__((ext_vector_type(8)));
typedef short s16x4 __attribute__((ext_vector_type(4)));
typedef float f32x16 __attribute__((ext_vector_type(16)));
typedef __attribute__((address_space(3))) const char* lds_cptr;
#define RET_MFMA(a, b, c) __builtin_amdgcn_mfma_f32_32x32x16_bf16(a, b, c, 0, 0, 0)
__device__ __forceinline__ int crow(int r, int hi) { return (r & 3) + 8 * (r >> 2) + 4 * hi; }
__device__ __forceinline__ s16x4 vtr(lds_cptr p) { return __builtin_bit_cast(s16x4, __builtin_amdgcn_ds_read_tr16_b64_v4i16((__attribute__((address_space(3))) s16x4*)p)); }
typedef float f32x2_t __attribute__((ext_vector_type(2))); typedef __bf16 bf16x2_t __attribute__((ext_vector_type(2)));
__device__ __forceinline__ unsigned cvtpk(float lo, float hi) { f32x2_t v = {lo, hi}; bf16x2_t b = __builtin_convertvector(v, bf16x2_t); return __builtin_bit_cast(unsigned, b); }
__device__ __forceinline__ bf16x8 trfrag(lds_cptr img, int cb, int kg, int lane) {
    lds_cptr p = img + (cb * 8 + kg) * 1024 + ((lane >> 4) & 1) * 32 + (lane & 3) * 8 + (4 * (lane >> 5) + ((lane & 15) >> 2)) * 64;
    const s16x4 lo = vtr(p), h = vtr(p + 512);
    return (bf16x8){lo[0], lo[1], lo[2], lo[3], h[0], h[1], h[2], h[3]};
}
__device__ __forceinline__ void load_tr_image(LAS unsigned char* img, const bf16* src, int pitch, int wid, int lane) {
#pragma unroll
    for (int i = 0; i < 4; ++i) { const int p = wid * 4 + i, cb = p >> 3, kg = p & 7, row = 16 * kg + (lane >> 2), col = 32 * cb + (lane & 3) * 8;
        const v4u v = *(const GAS v4u*)(src + (size_t)row * pitch + col); *(LAS v4u*)(img + p * 1024 + lane * 16) = v; }
}
__device__ __forceinline__ float log2_decay(int h) { return __builtin_log2f(1.0f - __builtin_exp2f(-5.0f - (float)h)); }

__device__ __forceinline__ void r1_unit(LAS unsigned char* lds, const bf16* ZR, float* KVT, int u, int wid, int lane) {
    const int bh = u >> 5, n = u & 31, b = bh >> 2, h = bh & 3;
    const bf16* Zrow = ZR + (size_t)(b * T + 128 * n) * 2048;
    load_tr_image(lds, Zrow + 1024 + 128 * h, 2048, wid, lane);
    load_tr_image(lds + 32768, Zrow + 512 + 128 * h, 2048, wid, lane);
    __syncthreads();
    const lds_cptr imgV = (lds_cptr)lds, imgK = (lds_cptr)(lds + 32768);
    const int eblk = wid & 3, dh = wid >> 2, r32 = lane & 31, hi = lane >> 5;
    f32x16 acc0 = f32x16{}, acc1 = f32x16{};
#pragma unroll
    for (int kg = 0; kg < 8; ++kg) { const bf16x8 a = trfrag(imgV, eblk, kg, lane), b0 = trfrag(imgK, 2 * dh, kg, lane), b1 = trfrag(imgK, 2 * dh + 1, kg, lane);
        acc0 = RET_MFMA(a, b0, acc0); acc1 = RET_MFMA(a, b1, acc1); }
    const float gc1 = __builtin_exp2f(127.0f * log2_decay(h));
    float* out = KVT + (size_t)u * 16384 + 64 * dh + r32;
#pragma unroll
    for (int r = 0; r < 16; ++r) { const int e = 32 * eblk + crow(r, hi); out[e * 128] = acc0[r] * gc1; out[e * 128 + 32] = acc1[r] * gc1; }
    __syncthreads();
}

__device__ __forceinline__ void r3_unit(LAS unsigned char* lds, const bf16* ZR, const bf16* PT, bf16* RT, int u, int wid, int lane) {
    const int bh = u >> 5, n = u & 31, b = bh >> 2, h = bh & 3, rowbase = b * T + 128 * n;
    const bf16* Zrow = ZR + (size_t)rowbase * 2048;
    load_tr_image(lds, Zrow + 1024 + 128 * h, 2048, wid, lane);
    const lds_cptr imgV = (lds_cptr)lds;
    const int qb = wid & 3, eh = wid >> 2, r32 = lane & 31, hi = lane >> 5;
    bf16x8 qf[8];
    { const bf16* qp = Zrow + (size_t)(32 * qb + r32) * 2048 + 128 * h + 8 * hi;
#pragma unroll
      for (int ds = 0; ds < 8; ++ds) qf[ds] = *(const GAS bf16x8*)(qp + 16 * ds); }
    __syncthreads();
    f32x16 acc0 = f32x16{}, acc1 = f32x16{};
    for (int kb = 0; kb <= qb; ++kb) {
        const bf16* kp = Zrow + (size_t)(32 * kb + r32) * 2048 + 512 + 128 * h + 8 * hi;
        f32x16 S = f32x16{};
#pragma unroll
        for (int ds = 0; ds < 8; ++ds) { const bf16x8 kf = *(const GAS bf16x8*)(kp + 16 * ds); S = RET_MFMA(kf, qf[ds], S); }
        if (kb == qb) {
#pragma unroll
            for (int r = 0; r < 16; ++r) if (crow(r, hi) > r32) S[r] = 0.f;
        }
        v4u w0, w1;
        w0.x = cvtpk(S[0], S[1]); w0.y = cvtpk(S[2], S[3]); w0.z = cvtpk(S[4], S[5]); w0.w = cvtpk(S[6], S[7]);
        w1.x = cvtpk(S[8], S[9]); w1.y = cvtpk(S[10], S[11]); w1.z = cvtpk(S[12], S[13]); w1.w = cvtpk(S[14], S[15]);
        const bf16x8 pa0 = __builtin_bit_cast(bf16x8, w0), pa1 = __builtin_bit_cast(bf16x8, w1);
        acc0 = RET_MFMA(pa0, trfrag(imgV, 2 * eh, 2 * kb, lane), acc0);     acc0 = RET_MFMA(pa1, trfrag(imgV, 2 * eh, 2 * kb + 1, lane), acc0);
        acc1 = RET_MFMA(pa0, trfrag(imgV, 2 * eh + 1, 2 * kb, lane), acc1); acc1 = RET_MFMA(pa1, trfrag(imgV, 2 * eh + 1, 2 * kb + 1, lane), acc1);
    }
    { const bf16* pt = PT + (size_t)u * 16384 + (size_t)(64 * eh + r32) * 128 + 8 * hi;
#pragma unroll
      for (int ds = 0; ds < 8; ++ds) { const bf16x8 p0 = *(const GAS bf16x8*)(pt + 16 * ds), p1 = *(const GAS bf16x8*)(pt + 32 * 128 + 16 * ds);
          acc0 = RET_MFMA(qf[ds], p0, acc0); acc1 = RET_MFMA(qf[ds], p1, acc1); } }
    const float l2g = log2_decay(h);
    float ss[16];
#pragma unroll
    for (int r = 0; r < 16; ++r) { const float f = __builtin_exp2f((float)(32 * qb + crow(r, hi)) * l2g); acc0[r] *= f; acc1[r] *= f; ss[r] = acc0[r] * acc0[r] + acc1[r] * acc1[r]; }
#pragma unroll
    for (int r = 0; r < 16; ++r) { float s = ss[r]; s += __shfl_xor(s, 1); s += __shfl_xor(s, 2); s += __shfl_xor(s, 4); s += __shfl_xor(s, 8); s += __shfl_xor(s, 16); ss[r] = s; }
    LAS float* scr = (LAS float*)(lds + 32768);
    if (r32 == 0) {
#pragma unroll
        for (int r = 0; r < 16; ++r) scr[wid * 32 + crow(r, hi)] = ss[r];
    }
    __syncthreads();
#pragma unroll
    for (int r = 0; r < 16; ++r) { const int ql = crow(r, hi); const float tot = ss[r] + scr[(wid ^ 4) * 32 + ql];
        const float rn = 1.0f / sqrtf(tot * (1.0f / 128.0f) + 1e-6f);
        const size_t row = (size_t)(rowbase + 32 * qb + ql);
        const bf16* gp = ZR + row * 2048 + 1536 + 128 * h + 64 * eh + r32; bf16* op = RT + row * 512 + 128 * h + 64 * eh + r32;
        const float g0 = __uint_as_float((unsigned)gp[0] << 16), g1 = __uint_as_float((unsigned)gp[32] << 16);
        op[0] = (bf16)f2bf(acc0[r] * rn * g0); op[32] = (bf16)f2bf(acc1[r] * rn * g1); }
    __syncthreads();
}
}

struct Args { const float* in[22]; float* out; unsigned char* ws; };
__device__ __forceinline__ unsigned char* arg_ptr(int i) { asm volatile("" : "+s"(i)); return ((unsigned char* const*)__builtin_amdgcn_kernarg_segment_ptr())[i]; }
__device__ __forceinline__ const float* arg_in(int i) { return (const float*)arg_ptr(i); }
#define REFRESH_LANE() do { int t_ = threadIdx.x; asm volatile("" : "+v"(t_)); F.tid = t_; F.lane = t_ & 63; } while (0)
__global__ void __launch_bounds__(NWAVES * 64, 2) layer_fwd(Args) {
    extern __shared__ __attribute__((aligned(16))) unsigned char lds[];
    Frame F;
    F.lds = (LAS unsigned char*)lds;
    F.MISC = (volatile LAS unsigned*)(F.lds + MISC_OFF);
    F.tid = threadIdx.x; F.lane = F.tid & 63; F.wave = __builtin_amdgcn_readfirstlane(F.tid >> 6);
    F.G = gridDim.x; { const int bx = blockIdx.x; F.vcu = (F.G % 8 == 0) ? (bx % 8) * (F.G / 8) + bx / 8 : bx; }
    F.ctl = (gu32*)(arg_ptr(23) + WS_CTL);
    for (int u = F.tid; u < (LDS_BYTES - LDSCTL_OFF) / 4; u += NWAVES * 64) ((LAS unsigned*)(F.lds + LDSCTL_OFF))[u] = 0u;
    __syncthreads();
#if BAR_MODE != 0
    XcdBarrier bar = xcd_barrier_post((unsigned*)(F.ctl + CW_BAR), F.MISC + 8);
#endif
#if BAR_MODE == 0
#define GRID_BAR() do { cg::this_grid().sync(); REFRESH_LANE(); } while (0)
#else
#define GRID_BAR() do { xcd_barrier(bar); REFRESH_LANE(); } while (0)
#endif

#define P_x    (arg_in(0))
#define P_out  ((float*)arg_ptr(22))
#define P_CS   ((float*)(arg_ptr(23) + WS_CS))
#define P_WIN  ((bf16*)(arg_ptr(23) + WS_WIN))
#define P_WAP  ((bf16*)(arg_ptr(23) + WS_WAP))
#define P_WRP  ((bf16*)(arg_ptr(23) + WS_WRP))
#define P_WOUT ((bf16*)(arg_ptr(23) + WS_WOUT))
#define P_WGU  ((bf16*)(arg_ptr(23) + WS_WGU))
#define P_WD   ((bf16*)(arg_ptr(23) + WS_WD))
#define P_XN   ((bf16*)(arg_ptr(23) + WS_XN))
#define P_Y    ((bf16*)(arg_ptr(23) + WS_Y))
#define P_H    ((bf16*)(arg_ptr(23) + WS_H))
#define P_ZQ   ((bf16*)(arg_ptr(23) + WS_ZQ))
#define P_ZR   ((bf16*)(arg_ptr(23) + WS_ZR))
#define P_ZG   ((bf16*)(arg_ptr(23) + WS_ZG))
#define P_AO   ((bf16*)(arg_ptr(23) + WS_AO))
#define P_KVT  ((float*)(arg_ptr(23) + WS_KVT))
#define P_PT   ((bf16*)(arg_ptr(23) + WS_PT))
#define P_RT   ((bf16*)(arg_ptr(23) + WS_RT))
#define P_DA   ((bf16*)(arg_ptr(23) + WS_DA))
#define P_T1   ((bf16*)(arg_ptr(23) + WS_T1))
#define P_MG   ((bf16*)(arg_ptr(23) + WS_MG))
    LAS float* scr = (LAS float*)(F.lds + RING_OFF + F.wave * 16384);
    const int gw = F.vcu * NWAVES + F.wave, NGW = F.G * NWAVES;

#ifndef PROBE
#define PROBE 0
#endif
#define PROBE_DUMP(buf, ld, c0) do { for (int m_ = gw; m_ < M; m_ += NGW) { const bf16* s_ = (buf) + (size_t)m_ * (ld) + (c0); float* o_ = P_out + (size_t)m_ * D; \
        for (int c_ = F.lane; c_ < D; c_ += 64) o_[c_] = __uint_as_float((unsigned)s_[c_] << 16); } return; } while (0)
    {
        constexpr int I_GU = (D / 64) * (FF / 32), I_DN = (FF / 64) * (D / 32), I_IN = (D / 64) * (DIN / 32), I_PJ = (512 / 64) * (D / 32), I_O = (D / 64) * (D / 32);
        constexpr int NITEMS = 2 * I_GU + I_DN + I_IN + 2 * I_PJ + I_O;
        for (int it = gw; it < NITEMS; it += NGW) {
            int r = it;
            if (r < I_GU) { transpose_item(arg_in(2), D, FF, P_WGU, 1, scr, r, F.lane); continue; } r -= I_GU;
            if (r < I_GU) { transpose_item(arg_in(3), D, FF, P_WGU, 2, scr, r, F.lane); continue; } r -= I_GU;
            if (r < I_DN) { transpose_item(arg_in(4), FF, D, P_WD, 0, scr, r, F.lane); continue; } r -= I_DN;
            if (r < I_IN) { transpose_item(arg_in(7), D, DIN, P_WIN, 0, scr, r, F.lane); continue; } r -= I_IN;
            if (r < I_PJ) { transpose_item(arg_in(13), 512, D, P_WAP, 0, scr, r, F.lane); continue; } r -= I_PJ;
            if (r < I_PJ) { transpose_item(arg_in(14), 512, D, P_WRP, 0, scr, r, F.lane); continue; } r -= I_PJ;
            transpose_item(arg_in(15), D, D, P_WOUT, 0, scr, r, F.lane);
        }
        for (int idx = F.vcu * (NWAVES * 64) + F.tid; idx < T * 64; idx += F.G * NWAVES * 64) {
            const int t = idx >> 6, i = idx & 63;
            const float e = (i == 63) ? 1.0f : (float)i * (1.0f / 63.0f);
            const float ang = (float)t * (1.0f / powf(10000.0f, e));
            P_CS[2 * idx] = cosf(ang); P_CS[2 * idx + 1] = sinf(ang);
        }
        row_phase<false, true>(F, P_x, nullptr, nullptr, 0.f, nullptr, arg_in(1), P_XN);
    }
    GRID_BAR();

    { pg8::Gemm g{P_XN, P_WGU, M, 2 * FF, D}; pg8::StaticOrder S; S.init(M, 2 * FF, F.G, (int)blockIdx.x);
      pg8::EpiSwiglu E{P_H, FF};
      pg8::gemm_phase<pg8::EpiSwiglu, pg8::StaticOrder, PG8_ALIGN, PG8_SP2>(F.lds + RING_OFF, g, S, E); }
    GRID_BAR();
    { pg8::Gemm g{P_H, P_WD, M, D, FF}; pg8::StaticOrder S; S.init(M, D, F.G, (int)blockIdx.x);
      pg8::EpiBf16<0> E{P_Y, D, nullptr, 0, 0, 1.f};
      pg8::gemm_phase<pg8::EpiBf16<0>, pg8::StaticOrder, PG8_ALIGN, PG8_SP2>(F.lds + RING_OFF, g, S, E); }
    GRID_BAR();
    row_phase<true, true>(F, P_x, P_Y, arg_in(5), 0.5f, P_out, arg_in(6), P_XN);
    GRID_BAR();
#if PROBE == 3
    return;
#endif
    { pg8::Gemm g{P_XN, P_WIN, M, DIN, D}; pg8::StaticOrder S; S.init(M, DIN, F.G, (int)blockIdx.x);
      pg8::EpiWin E{P_ZQ, P_ZR, P_ZG, P_CS, attn_body::C2};
      pg8::gemm_phase<pg8::EpiWin, pg8::StaticOrder, PG8_ALIGN, PG8_SP2>(F.lds + RING_OFF, g, S, E); }
    GRID_BAR();
#if PROBE == 40
    PROBE_DUMP(P_ZQ, 1536, 0);
#elif PROBE == 41
    PROBE_DUMP(P_ZR, 2048, 0);
#elif PROBE == 42
    PROBE_DUMP(P_ZR, 2048, 1024);
#elif PROBE == 43
    PROBE_DUMP(P_ZG, 2048, 0);
#endif
    {
        for (int u = F.vcu; u < 1024; u += F.G) ret::r1_unit(F.lds + RING_OFF, P_ZR, P_KVT, u, F.wave, F.lane);
        const attn_body::AttnTensors AT{(const attn_body::bf16*)P_ZQ, (attn_body::bf16*)P_AO};
        const attn_body::StaticOrder S((int)F.G, (int)blockIdx.x);
        attn_body::attn_phase<attn_body::StaticOrder>((char*)lds + RING_OFF, AT, S);
    }
    GRID_BAR();
#if PROBE == 5
    PROBE_DUMP(P_AO, 1024, 0);
#endif
    {
        for (int gid = F.vcu * (NWAVES * 64) + F.tid; gid < 32 * 4096; gid += F.G * NWAVES * 64) {
            const int bh = gid >> 12, idx = gid & 4095, h = bh & 3;
            const float l2g = ret::log2_decay(h), g1 = __builtin_exp2f(l2g), gC = __builtin_exp2f(128.0f * l2g);
            const GAS f32x4* kv = (const GAS f32x4*)(P_KVT + (size_t)bh * 32 * 16384) + idx;
            GAS unsigned long long* pt = (GAS unsigned long long*)(P_PT + (size_t)bh * 32 * 16384) + idx;
            f32x4 S = (f32x4){0.f, 0.f, 0.f, 0.f};
#pragma unroll 8
            for (int n = 0; n < 32; ++n) { const f32x4 k = kv[(size_t)n * 4096]; const f32x4 o = S * g1;
                pt[(size_t)n * 4096] = (unsigned long long)pk2(o.x, o.y) | ((unsigned long long)pk2(o.z, o.w) << 32); S = S * gC + k; }
        }
        const float s1 = wave_sum(arg_in(8)[F.lane] * arg_in(9)[F.lane]), s2 = wave_sum(arg_in(10)[F.lane] * arg_in(11)[F.lane]);
        const float lam = expf(s1) - expf(s2) + 0.2f;
        const int hd = F.lane >> 4, e0 = 8 * (F.lane & 15);
        const f32x4 sg0 = *(const f32x4*)(arg_in(12) + e0), sg1 = *(const f32x4*)(arg_in(12) + e0 + 4);
        for (int m = gw; m < M; m += NGW) {
            const bf16* ao = P_AO + (size_t)m * 1024 + 256 * hd + e0;
            const v4u a = *(const GAS v4u*)ao, b = *(const GAS v4u*)(ao + 128);
            float o[8];
            o[0] = bfl(a.x) - lam * bfl(b.x); o[1] = bfh(a.x) - lam * bfh(b.x); o[2] = bfl(a.y) - lam * bfl(b.y); o[3] = bfh(a.y) - lam * bfh(b.y);
            o[4] = bfl(a.z) - lam * bfl(b.z); o[5] = bfh(a.z) - lam * bfh(b.z); o[6] = bfl(a.w) - lam * bfl(b.w); o[7] = bfh(a.w) - lam * bfh(b.w);
            float ss = 0.f;
#pragma unroll
            for (int i = 0; i < 8; ++i) ss += o[i] * o[i];
            ss += __shfl_xor(ss, 1); ss += __shfl_xor(ss, 2); ss += __shfl_xor(ss, 4); ss += __shfl_xor(ss, 8);
            const float rn = 0.8f / sqrtf(ss * (1.0f / 128.0f) + 1e-5f);
            v4u w; w.x = pk2(o[0] * rn * sg0.x, o[1] * rn * sg0.y); w.y = pk2(o[2] * rn * sg0.z, o[3] * rn * sg0.w);
            w.z = pk2(o[4] * rn * sg1.x, o[5] * rn * sg1.y); w.w = pk2(o[6] * rn * sg1.z, o[7] * rn * sg1.w);
            *(GAS v4u*)(P_DA + (size_t)m * 512 + 128 * hd + e0) = w;
        }
    }
    GRID_BAR();
#if PROBE == 6
    PROBE_DUMP(P_PT, 1024, 0);
#endif
    for (int u = F.vcu; u < 1024; u += F.G) ret::r3_unit(F.lds + RING_OFF, P_ZR, P_PT, P_RT, u, F.wave, F.lane);
    GRID_BAR();
#if PROBE == 7
    PROBE_DUMP(P_DA, 512, 0);
#elif PROBE == 71
    PROBE_DUMP(P_RT, 512, 0);
#endif
    { pg8::Gemm g{P_DA, P_WAP, M, D, 512}; pg8::StaticOrder S; S.init(M, D, F.G, (int)blockIdx.x);
      pg8::EpiGate E{P_T1, D, P_ZG, 2048, nullptr, 0};
      pg8::gemm_phase<pg8::EpiGate, pg8::StaticOrder, PG8_ALIGN, PG8_SP2>(F.lds + RING_OFF, g, S, E); }
    VM_WAIT(); __syncthreads(); __builtin_amdgcn_fence(__ATOMIC_ACQUIRE, "agent"); VM_WAIT(); __syncthreads();
    { pg8::Gemm g{P_RT, P_WRP, M, D, 512}; pg8::StaticOrder S; S.init(M, D, F.G, (int)blockIdx.x);
      pg8::EpiGate E{P_MG, D, P_ZG + 1024, 2048, P_T1, D};
      pg8::gemm_phase<pg8::EpiGate, pg8::StaticOrder, PG8_ALIGN, PG8_SP2>(F.lds + RING_OFF, g, S, E); }
    GRID_BAR();
#if PROBE == 8
    PROBE_DUMP(P_MG, 1024, 0);
#endif
    { pg8::Gemm g{P_MG, P_WOUT, M, D, D}; pg8::StaticOrder S; S.init(M, D, F.G, (int)blockIdx.x);
      pg8::EpiBf16<0> E{P_Y, D, nullptr, 0, 0, 1.f};
      pg8::gemm_phase<pg8::EpiBf16<0>, pg8::StaticOrder, PG8_ALIGN, PG8_SP2>(F.lds + RING_OFF, g, S, E); }
    GRID_BAR();
#if PROBE == 9
    PROBE_DUMP(P_Y, 1024, 0);
#endif
    {
        constexpr int I_GU = (D / 64) * (FF / 32), I_DN = (FF / 64) * (D / 32);
        for (int it = gw; it < 2 * I_GU + I_DN; it += NGW) {
            int r = it;
            if (r < I_GU) { transpose_item(arg_in(18), D, FF, P_WGU, 1, scr, r, F.lane); continue; } r -= I_GU;
            if (r < I_GU) { transpose_item(arg_in(19), D, FF, P_WGU, 2, scr, r, F.lane); continue; } r -= I_GU;
            transpose_item(arg_in(20), FF, D, P_WD, 0, scr, r, F.lane);
        }
        row_phase<true, true>(F, P_out, P_Y, arg_in(16), 1.0f, P_out, arg_in(17), P_XN);
    }
    GRID_BAR();
    { pg8::Gemm g{P_XN, P_WGU, M, 2 * FF, D}; pg8::StaticOrder S; S.init(M, 2 * FF, F.G, (int)blockIdx.x);
      pg8::EpiSwiglu E{P_H, FF};
      pg8::gemm_phase<pg8::EpiSwiglu, pg8::StaticOrder, PG8_ALIGN, PG8_SP2>(F.lds + RING_OFF, g, S, E); }
    GRID_BAR();
    { pg8::Gemm g{P_H, P_WD, M, D, FF}; pg8::StaticOrder S; S.init(M, D, F.G, (int)blockIdx.x);
      pg8::EpiBf16<0> E{P_Y, D, nullptr, 0, 0, 1.f};
      pg8::gemm_phase<pg8::EpiBf16<0>, pg8::StaticOrder, PG8_ALIGN, PG8_SP2>(F.lds + RING_OFF, g, S, E); }
    GRID_BAR();
    row_phase<true, false>(F, P_out, P_Y, arg_in(21), 0.5f, P_out, nullptr, nullptr);
#undef GRID_BAR
}

extern "C" void kernel_launch(void* const* d_in, const int* in_sizes, int n_in, void* d_out, int out_size, void* d_ws, size_t ws_size, hipStream_t stream) {
    static int grid = 0;
    if (grid == 0) {
        if (n_in != 22 || in_sizes[0] != M * D || out_size != M * D || ws_size < WS_END) { fprintf(stderr, "kernel_launch: built for 22 inputs, x and out of %d floats, >= %zu bytes of workspace; got n_in %d, in0 %d, out %d, ws %zu; nothing launched\n", M * D, (size_t)WS_END, n_in, n_in > 0 ? in_sizes[0] : -1, out_size, ws_size); grid = -1; return; }
        int dev = 0, cus = 0, per_cu = 0;
        if (hipGetDevice(&dev) != hipSuccess || hipDeviceGetAttribute(&cus, hipDeviceAttributeMultiprocessorCount, dev) != hipSuccess) { fprintf(stderr, "kernel_launch: hipGetDevice / hipDeviceGetAttribute failed; nothing launched\n"); grid = -1; return; }
        if (hipFuncSetAttribute((const void*)layer_fwd, hipFuncAttributeMaxDynamicSharedMemorySize, LDS_BYTES) != hipSuccess) { fprintf(stderr, "kernel_launch: hipFuncSetAttribute failed; nothing launched\n"); grid = -1; return; }
        if (hipOccupancyMaxActiveBlocksPerMultiprocessor(&per_cu, (const void*)layer_fwd, NWAVES * 64, LDS_BYTES) != hipSuccess || per_cu < 1)
            fprintf(stderr, "kernel_launch: note: the occupancy query reports %d workgroups per CU\n", per_cu);
        (void)hipGetLastError();
        grid = cus * (per_cu < 1 ? 1 : per_cu);
    }
    if (grid < 0) return;
    if (hipMemsetAsync((char*)d_ws + WS_CTL, 0, CTL_ZERO_BYTES, stream) != hipSuccess) { fprintf(stderr, "kernel_launch: hipMemsetAsync of the control words failed; nothing launched\n"); return; }
    Args a{};
    for (int i = 0; i < 22; ++i) a.in[i] = (const float*)d_in[i];
    a.out = (float*)d_out; a.ws = (unsigned char*)d_ws;
    void* kargs[] = {&a};
    const hipError_t le = hipLaunchCooperativeKernel((const void*)layer_fwd, dim3(grid), dim3(NWAVES * 64), kargs, LDS_BYTES, stream);
    if (le != hipSuccess) fprintf(stderr, "kernel_launch: launch failed: %s (grid %d x %d threads, %d B LDS)\n", hipGetErrorName(le), grid, NWAVES * 64, LDS_BYTES);
}
```

```cpp
#define BAR_MODE 2
#include <hip/hip_runtime.h>
#include <hip/hip_bf16.h>
#include <hip/hip_cooperative_groups.h>
namespace cg = cooperative_groups;
#ifndef BAR_MODE
#define BAR_MODE 0
#endif
#include <cstdio>
#include <cstdint>
#include <cmath>
namespace pg8 {
#define PG8_LAS __attribute__((address_space(3)))
typedef unsigned short bf16_t;
typedef short bf16x8 __attribute__((ext_vector_type(8)));
typedef float f32x4 __attribute__((ext_vector_type(4)));
typedef unsigned u32x4 __attribute__((ext_vector_type(4)));
constexpr int BM = 256, BK = 64, HALF = 128, HTB = HALF * BK * 2  , STAGE_BYTES = 8 * HTB, NXCD = 8, WGM = 4;

__host__ __device__ __forceinline__ int lds_byte(int r, int c) { const int st = (r >> 4) * 2 + (c >> 5), rr = r & 15, cc = c & 31, ob = rr * 64 + cc * 2; return st * 1024 + (ob ^ (((ob >> 9) & 1) << 5)); }
__host__ __device__ __forceinline__ void stage_rc(int b, int& R, int& C) { const int st = b / 1024, sb = b % 1024, swz = sb ^ (((sb >> 9) & 1) << 5); R = (st >> 1) * 16 + swz / 64; C = (st & 1) * 32 + (swz % 64) / 2; }
__host__ __device__ __forceinline__ int perm32(int rho) { const int n = rho >> 4, i = rho & 15; return 8 * (i >> 2) + 4 * n + (i & 3); }

struct Unit { int pm, pn; };
struct Gemm { const bf16_t* A; const bf16_t* Bt; int M, N, K; int a_tiled = 0; };

struct StaticOrder {
    int nM, nN, nwg, G, c;
    __host__ __device__ void init(int M, int N, int G_, int c_) { nM = M / BM; nN = N / BM; nwg = nM * nN; G = G_; c = c_; }
    __host__ __device__ bool next(int i, Unit& u) const {
        const long L = (long)i * G + c; if (L >= nwg) return false;
        int wgid = (int)L; { const int q = nwg / NXCD, r = nwg % NXCD, xcd = wgid % NXCD, off = wgid / NXCD; wgid = (xcd < r ? xcd * (q + 1) : r * (q + 1) + (xcd - r) * q) + off; }
        const int nig = WGM * nN, gid = wgid / nig, fm = gid * WGM, gsz = (nM - fm) < WGM ? (nM - fm) : WGM;
        u.pm = fm + ((wgid % nig) % gsz); u.pn = (wgid % nig) / gsz; return true;
    }
    __device__ __forceinline__ void a_ready(const Unit&) const {}
    __device__ __forceinline__ void done(const Unit&) const {}
};

__device__ __forceinline__ unsigned cvt_pk_bf16(float lo, float hi) { unsigned r; asm volatile("v_cvt_pk_bf16_f32 %0, %1, %2" : "=v"(r) : "v"(lo), "v"(hi)); return r; }
typedef float f32x2 __attribute__((ext_vector_type(2)));
__device__ __forceinline__ f32x2 gelu_pk(f32x2 v) {
    const f32x2 av = __builtin_elementwise_abs(v), d = av * 0.2316418882f + 1.0f;
    f32x2 t; t.x = __builtin_amdgcn_rcpf(d.x); t.y = __builtin_amdgcn_rcpf(d.y);
    f32x2 q = t * 0.5307027145f + (-0.7265760135f); q = q * t + 0.7107068705f; q = q * t + (-0.142248368f); q = q * t + 0.127414796f; q = q * t;
    const f32x2 s = (v * v) * (-0.72134752044f);
    f32x2 e; e.x = __builtin_amdgcn_exp2f(s.x); e.y = __builtin_amdgcn_exp2f(s.y);
    const f32x2 m = v * (q * e), r = v - m;
    f32x2 o; o.x = v.x < 0.f ? m.x : r.x; o.y = v.y < 0.f ? m.y : r.y; return o;
}

template <int ACT  > struct EpiBf16 {
    static constexpr bool PERM = true, AFTER_DRAIN = false; static constexpr int MID_T = -1; static_assert(ACT == 0 || ACT == 1, "EpiBf16: ACT is 0 (none) or 1 (gelu_pk)");
    bf16_t* O; int ldc; const float* bias; int split_cols; size_t split_stride; float scale0;
    __device__ __forceinline__ void operator()(const f32x4 (&acc)[2][2][4][2], const Unit& u, int wr, int wc, int fr, int fq) const {
        const int row0 = u.pm * BM + wr * 64 + fr; int colt = u.pn * BM; bf16_t* base = O;
        float sc = 1.f; if (split_cols) { const int t = colt / split_cols; base += (size_t)t * split_stride; colt -= t * split_cols; if (t == 0) sc = scale0; }
        const int col0 = colt + wc * 32 + 8 * fq, bcol0 = u.pn * BM + wc * 32 + 8 * fq;
        f32x4 bv[2][2];
#pragma unroll
        for (int bj = 0; bj < 2; ++bj)
#pragma unroll
            for (int n = 0; n < 2; ++n) bv[bj][n] = bias ? *(const f32x4*)(bias + bcol0 + bj * HALF + 4 * n) : (f32x4){0.f, 0.f, 0.f, 0.f};
#pragma unroll
        for (int ai = 0; ai < 2; ++ai)
#pragma unroll
            for (int m = 0; m < 4; ++m) { bf16_t* rowp = base + (size_t)(row0 + ai * HALF + m * 16) * ldc + col0;
#pragma unroll
                for (int bj = 0; bj < 2; ++bj) { f32x4 v0 = acc[ai][bj][m][0] + bv[bj][0], v1 = acc[ai][bj][m][1] + bv[bj][1];
                    if (ACT == 1) { f32x2 a = gelu_pk((f32x2){v0[0], v0[1]}), b = gelu_pk((f32x2){v0[2], v0[3]}), c = gelu_pk((f32x2){v1[0], v1[1]}), d = gelu_pk((f32x2){v1[2], v1[3]});
                        v0 = (f32x4){a.x, a.y, b.x, b.y}; v1 = (f32x4){c.x, c.y, d.x, d.y}; }
                    v0 = v0 * sc; v1 = v1 * sc; u32x4 w; w.x = cvt_pk_bf16(v0[0], v0[1]); w.y = cvt_pk_bf16(v0[2], v0[3]); w.z = cvt_pk_bf16(v1[0], v1[1]); w.w = cvt_pk_bf16(v1[2], v1[3]);
                    *(u32x4*)(rowp + bj * HALF) = w; } }
    }
};

template <class Epi, class Sched, bool ALIGN_EPI = false, bool SP2 = false>
__device__ __forceinline__ void gemm_phase(PG8_LAS unsigned char* lds, const Gemm g, const Sched& S, const Epi& E) {
    int tid_ = threadIdx.x; asm volatile("" : "+v"(tid_));
    const int tid = tid_, wid = __builtin_amdgcn_readfirstlane(tid >> 6), lane = tid & 63, wr = wid >> 2, wc = wid & 3, fr = lane & 15, fq = lane >> 4;
    const int K = g.K, nt = K / BK;
    unsigned voffA[2], voffB[2];
#pragma unroll
    for (int i = 0; i < 2; ++i) { int R, C; stage_rc(tid * 16 + i * 8192, R, C); const int Rb = Epi::PERM ? ((R & ~31) + perm32(R & 31)) : R;
        voffA[i] = g.a_tiled ? (unsigned)(R * BK + C) * 2u : (unsigned)(R * K + C) * 2u; voffB[i] = (unsigned)(Rb * K + C) * 2u; }
    const size_t kstep = (size_t)(BK * 2);
    const size_t hstep = (size_t)HALF * K * 2;
    const size_t tstep = 2 * hstep;
    const size_t kstepA = g.a_tiled ? (size_t)BM * BK * 2 : kstep, hstepA = g.a_tiled ? (size_t)HALF * BK * 2 : hstep, tstepA = g.a_tiled ? (size_t)nt * BM * BK * 2 : tstep;
    const unsigned ldsw = (unsigned)wid * 1024u;
    const int aoff = lds_byte(wr * 64 + fr, fq * 8), boff = lds_byte(wc * 32 + fr, fq * 8);
#define PG8_SA(b, h) (((b) * 2 + (h)) * HTB)
#define PG8_SB(b, h) ((4 + (b) * 2 + (h)) * HTB)
#define PG8_STAGE(bufoff, gbase, voff) do { _Pragma("unroll") for (int _i = 0; _i < 2; ++_i) \
        __builtin_amdgcn_global_load_lds((const unsigned*)((const char*)(gbase) + (voff)[_i]), (PG8_LAS unsigned*)(lds + (bufoff) + ldsw + _i * 8192), 16, 0, 0); } while (0)
#define PG8_LDA(dst, b, h) do { _Pragma("unroll") for (int m = 0; m < 4; ++m) _Pragma("unroll") for (int k = 0; k < 2; ++k) dst[m][k] = *(const PG8_LAS bf16x8*)(lds + PG8_SA(b, h) + aoff + m * 2048 + k * 1024); } while (0)
#define PG8_LDB(dst, b, h) do { _Pragma("unroll") for (int n = 0; n < 2; ++n) _Pragma("unroll") for (int k = 0; k < 2; ++k) dst[n][k] = *(const PG8_LAS bf16x8*)(lds + PG8_SB(b, h) + boff + n * 2048 + k * 1024); } while (0)
#define PG8_MMA(ai, bj, At, Bt) do { __builtin_amdgcn_s_setprio(1); _Pragma("unroll") for (int m = 0; m < 4; ++m) _Pragma("unroll") for (int n = 0; n < 2; ++n) _Pragma("unroll") for (int k = 0; k < 2; ++k) \
        acc[ai][bj][m][n] = __builtin_amdgcn_mfma_f32_16x16x32_bf16(Bt[n][k], At[m][k], acc[ai][bj][m][n], 0, 0, 0); __builtin_amdgcn_s_setprio(0); } while (0)
#define PG8_WAIT_V(n) asm volatile("s_waitcnt vmcnt(" #n ")" ::: "memory")
#define PG8_WAIT_L(n) asm volatile("s_waitcnt lgkmcnt(" #n ")" ::: "memory")
#define PG8_BAR __builtin_amdgcn_s_barrier()
#define PG8_SCHED __builtin_amdgcn_sched_barrier(0)
    Unit cur, nxt; int ui = 0;
    if (!S.next(0, cur)) return;
    f32x4 acc[2][2][4][2];
#pragma unroll
    for (int a = 0; a < 2; ++a)
#pragma unroll
        for (int b = 0; b < 2; ++b)
#pragma unroll
            for (int m = 0; m < 4; ++m)
#pragma unroll
                for (int n = 0; n < 2; ++n) acc[a][b][m][n] = (f32x4){0.f, 0.f, 0.f, 0.f};
    bf16x8 At[4][2], B0[2][2], B1[2][2];
    const char* cA = (const char*)g.A + (size_t)cur.pm * tstepA; const char* cB = (const char*)g.Bt + (size_t)cur.pn * tstep;
    S.a_ready(cur);
    if constexpr (SP2) {
        PG8_STAGE(PG8_SB(0, 0), cB, voffB); PG8_STAGE(PG8_SB(0, 1), cB + hstep, voffB); PG8_STAGE(PG8_SA(0, 0), cA, voffA); PG8_STAGE(PG8_SA(0, 1), cA + hstepA, voffA);
        if (wr == 1) PG8_BAR;
        PG8_WAIT_V(2); PG8_BAR;
        PG8_STAGE(PG8_SB(1, 0), cB + kstep, voffB); PG8_STAGE(PG8_SA(1, 0), cA + kstepA, voffA); PG8_STAGE(PG8_SB(1, 1), cB + hstep + kstep, voffB);
        PG8_WAIT_V(6); PG8_BAR;
    } else {
        PG8_STAGE(PG8_SB(0, 0), cB, voffB); PG8_STAGE(PG8_SA(0, 0), cA, voffA); PG8_STAGE(PG8_SB(0, 1), cB + hstep, voffB); PG8_STAGE(PG8_SA(0, 1), cA + hstepA, voffA);
        if (wr == 1) PG8_BAR;
        PG8_WAIT_V(4); PG8_BAR;
        PG8_STAGE(PG8_SB(1, 0), cB + kstep, voffB); PG8_STAGE(PG8_SA(1, 0), cA + kstepA, voffA); PG8_STAGE(PG8_SB(1, 1), cB + hstep + kstep, voffB);
        PG8_WAIT_V(6); PG8_BAR;
    }
    for (;;) {
        const bool has_next = S.next(ui + 1, nxt);
        const char* nA = has_next ? (const char*)g.A + (size_t)nxt.pm * tstepA : cA; const char* nB = has_next ? (const char*)g.Bt + (size_t)nxt.pn * tstep : cB;
        for (int t = 0; t < nt; t += 2) {
            const bool last = (t == nt - 2);
            if constexpr (Epi::MID_T >= 0) { if (t == Epi::MID_T) E.mid(acc, cur, wr, wc, fr, fq); }
            const char* a1 = cA + (size_t)(t + 1) * kstepA;
            const char* a2 = last ? nA : cA + (size_t)(t + 2) * kstepA; const char* b2 = last ? nB : cB + (size_t)(t + 2) * kstep;
            const char* a3 = a2 + kstepA; const char* b3 = b2 + kstep;
            if (last && has_next) S.a_ready(nxt);
            if constexpr (SP2) {
            PG8_LDB(B0, 0, 0); PG8_LDB(B1, 0, 1); PG8_SCHED; PG8_LDA(At, 0, 0); PG8_STAGE(PG8_SA(1, 1), a1 + hstepA, voffA);
            PG8_WAIT_V(8); PG8_WAIT_L(0); PG8_BAR; PG8_MMA(0, 0, At, B0); PG8_MMA(0, 1, At, B1); PG8_BAR; PG8_SCHED;
            PG8_LDA(At, 0, 1); PG8_STAGE(PG8_SB(0, 0), b2, voffB); PG8_STAGE(PG8_SB(0, 1), b2 + hstep, voffB); PG8_STAGE(PG8_SA(0, 0), a2, voffA);
            PG8_WAIT_V(8); PG8_WAIT_L(0); PG8_BAR; PG8_MMA(1, 0, At, B0); PG8_MMA(1, 1, At, B1); PG8_BAR; PG8_SCHED;
            PG8_LDB(B0, 1, 0); PG8_LDB(B1, 1, 1); PG8_SCHED; PG8_LDA(At, 1, 0); PG8_STAGE(PG8_SA(0, 1), a2 + hstepA, voffA);
            PG8_WAIT_V(8); PG8_WAIT_L(0); PG8_BAR; PG8_MMA(0, 0, At, B0); PG8_MMA(0, 1, At, B1); PG8_BAR; PG8_SCHED;
            PG8_LDA(At, 1, 1); PG8_STAGE(PG8_SB(1, 0), b3, voffB); PG8_STAGE(PG8_SB(1, 1), b3 + hstep, voffB); PG8_STAGE(PG8_SA(1, 0), a3, voffA);
            PG8_WAIT_V(8); PG8_WAIT_L(0); PG8_BAR; PG8_MMA(1, 0, At, B0); PG8_MMA(1, 1, At, B1); PG8_BAR; PG8_SCHED;
            } else {
            PG8_LDB(B0, 0, 0); PG8_SCHED; PG8_LDA(At, 0, 0); PG8_STAGE(PG8_SA(1, 1), a1 + hstepA, voffA);
            PG8_WAIT_L(8); PG8_BAR; PG8_WAIT_L(0); PG8_MMA(0, 0, At, B0); PG8_BAR; PG8_SCHED;
            PG8_LDB(B1, 0, 1); PG8_STAGE(PG8_SB(0, 0), b2, voffB);
            PG8_BAR; PG8_WAIT_L(0); PG8_MMA(0, 1, At, B1); PG8_BAR;
            PG8_LDA(At, 0, 1); PG8_STAGE(PG8_SA(0, 0), a2, voffA);
            PG8_BAR; PG8_WAIT_L(0); PG8_MMA(1, 0, At, B0); PG8_BAR; PG8_SCHED;
            PG8_STAGE(PG8_SB(0, 1), b2 + hstep, voffB);
            PG8_WAIT_V(6); PG8_BAR; PG8_MMA(1, 1, At, B1); PG8_BAR;
            PG8_LDB(B0, 1, 0); PG8_SCHED; PG8_LDA(At, 1, 0); PG8_STAGE(PG8_SA(0, 1), a2 + hstepA, voffA);
            PG8_WAIT_L(8); PG8_BAR; PG8_WAIT_L(0); PG8_MMA(0, 0, At, B0); PG8_BAR; PG8_SCHED;
            PG8_LDB(B1, 1, 1); PG8_STAGE(PG8_SB(1, 0), b3, voffB);
            PG8_BAR; PG8_WAIT_L(0); PG8_MMA(0, 1, At, B1); PG8_BAR;
            PG8_LDA(At, 1, 1); PG8_STAGE(PG8_SA(1, 0), a3, voffA);
            PG8_BAR; PG8_WAIT_L(0); PG8_MMA(1, 0, At, B0); PG8_BAR; PG8_SCHED;
            PG8_STAGE(PG8_SB(1, 1), b3 + hstep, voffB);
            PG8_WAIT_V(6); PG8_BAR; PG8_MMA(1, 1, At, B1); PG8_BAR;
            }
        }
        if constexpr (ALIGN_EPI) { if (wr == 0) PG8_BAR; }
        if constexpr (!Epi::AFTER_DRAIN) { E(acc, cur, wr, wc, fr, fq); S.done(cur); }
        if (!has_next) break;
#pragma unroll
        for (int a = 0; a < 2; ++a)
#pragma unroll
            for (int b = 0; b < 2; ++b)
#pragma unroll
                for (int m = 0; m < 4; ++m)
#pragma unroll
                    for (int n = 0; n < 2; ++n) acc[a][b][m][n] = (f32x4){0.f, 0.f, 0.f, 0.f};
        cur = nxt; cA = nA; cB = nB; ++ui;
        if constexpr (ALIGN_EPI) { if (wr == 1) PG8_BAR; }
    }
    PG8_WAIT_V(0);
    if constexpr (!ALIGN_EPI) { if (wr == 0) PG8_BAR; }
    PG8_BAR;
    if constexpr (Epi::AFTER_DRAIN) { E.fused(acc, cur, wr, wc, fr, fq, lds, wid, lane); S.done(cur); }
#undef PG8_SA
#undef PG8_SB
#undef PG8_STAGE
#undef PG8_LDA
#undef PG8_LDB
#undef PG8_MMA
#undef PG8_WAIT_V
#undef PG8_WAIT_L
#undef PG8_BAR
#undef PG8_SCHED
}
}

#ifndef PG8_SP2
#define PG8_SP2 true
#endif
#ifndef PG8_ALIGN
#define PG8_ALIGN true
#endif
namespace pg8 {
__device__ __forceinline__ float bf_lo(unsigned w) { return __uint_as_float(w << 16); }
__device__ __forceinline__ float bf_hi(unsigned w) { return __uint_as_float(w & 0xffff0000u); }
__device__ __forceinline__ float sigmoid_f(float v) { return __builtin_amdgcn_rcpf(1.0f + __builtin_amdgcn_exp2f(-1.4426950408889634f * v)); }
__device__ __forceinline__ u32x4 pack8(const f32x4 v0, const f32x4 v1) { u32x4 w; w.x = cvt_pk_bf16(v0[0], v0[1]); w.y = cvt_pk_bf16(v0[2], v0[3]); w.z = cvt_pk_bf16(v1[0], v1[1]); w.w = cvt_pk_bf16(v1[2], v1[3]); return w; }

struct EpiSwiglu {
    static constexpr bool PERM = true, AFTER_DRAIN = false; static constexpr int MID_T = -1;
    bf16_t* H; int ldh; int skip;
    __device__ __forceinline__ void operator()(const f32x4 (&acc)[2][2][4][2], const Unit& u, int wr, int wc, int fr, int fq) const {
        if (skip) return;
        const int r0 = wr * 64 + fr, col0 = u.pn * HALF + wc * 32 + 8 * fq;
        bf16_t* tile = H + ((size_t)u.pm * (ldh / 64) + (col0 >> 6)) * (BM * 64) + (col0 & 63);
#pragma unroll
        for (int ai = 0; ai < 2; ++ai)
#pragma unroll
            for (int m = 0; m < 4; ++m) { bf16_t* rowp = tile + (size_t)(r0 + ai * HALF + m * 16) * 64;
                f32x4 h[2];
#pragma unroll
                for (int n = 0; n < 2; ++n)
#pragma unroll
                    for (int i = 0; i < 4; ++i) { const float g = acc[ai][0][m][n][i], up = acc[ai][1][m][n][i]; h[n][i] = (g * up) * __builtin_amdgcn_rcpf(1.0f + __builtin_amdgcn_exp2f(g)); }
                __builtin_nontemporal_store(pack8(h[0], h[1]), (u32x4*)rowp); }
    }
};

struct EpiWin {
    static constexpr bool PERM = true, AFTER_DRAIN = false; static constexpr int MID_T = -1;
    bf16_t *ZQ, *ZR, *ZG; const float* cs; float c2;
    __device__ __forceinline__ void operator()(const f32x4 (&acc)[2][2][4][2], const Unit& u, int wr, int wc, int fr, int fq) const {
        const int pn = u.pn, row0 = u.pm * BM + wr * 64 + fr;
        bf16_t* base; int ld, colt, mode;
        if (pn < 6) { base = ZQ; ld = 1536; colt = 256 * pn; mode = pn < 2 ? 1 : 0; }
        else if (pn < 14) { base = ZR; ld = 2048; colt = 256 * (pn - 6); mode = pn < 8 ? 2 : pn < 10 ? 3 : pn < 12 ? 0 : 4; }
        else { base = ZG; ld = 2048; colt = 256 * (pn - 14); mode = 5; }
        const int col0 = colt + wc * 32 + 8 * fq;
        if (mode == 2 || mode == 3) {
            f32x4 csv[2][4][2];
#pragma unroll
            for (int ai = 0; ai < 2; ++ai)
#pragma unroll
                for (int m = 0; m < 4; ++m) { const int t = (row0 + ai * HALF + m * 16) & 4095; const f32x4* cp = (const f32x4*)(cs + ((size_t)t * 64 + 16 * wc + 4 * fq) * 2); csv[ai][m][0] = cp[0]; csv[ai][m][1] = cp[1]; }
#pragma unroll
            for (int ai = 0; ai < 2; ++ai)
#pragma unroll
                for (int m = 0; m < 4; ++m) { const int row = row0 + ai * HALF + m * 16; bf16_t* rowp = base + (size_t)row * ld + col0; const int t = row & 4095;
                    const f32x4 cs0 = csv[ai][m][0], cs1 = csv[ai][m][1];
#pragma unroll
                    for (int bj = 0; bj < 2; ++bj) { const f32x4 v0 = acc[ai][bj][m][0], v1 = acc[ai][bj][m][1];
                        float sc = 1.f;
                        if (mode == 3) { const int h = 2 * (pn - 8) + bj; const float l2g = __builtin_log2f(1.0f - __builtin_exp2f(-5.0f - (float)h));
                            sc = 0.08838834764831845f * __builtin_exp2f(-(float)(t & 127) * l2g); }
                        f32x4 o0, o1;
                        o0[0] = (v0[0] * cs0[0] - v0[1] * cs0[1]) * sc; o0[1] = (v0[1] * cs0[0] + v0[0] * cs0[1]) * sc;
                        o0[2] = (v0[2] * cs0[2] - v0[3] * cs0[3]) * sc; o0[3] = (v0[3] * cs0[2] + v0[2] * cs0[3]) * sc;
                        o1[0] = (v1[0] * cs1[0] - v1[1] * cs1[1]) * sc; o1[1] = (v1[1] * cs1[0] + v1[0] * cs1[1]) * sc;
                        o1[2] = (v1[2] * cs1[2] - v1[3] * cs1[3]) * sc; o1[3] = (v1[3] * cs1[2] + v1[2] * cs1[3]) * sc;
                        __builtin_nontemporal_store(pack8(o0, o1), (u32x4*)(rowp + bj * HALF)); } }
            return;
        }
#pragma unroll
        for (int ai = 0; ai < 2; ++ai)
#pragma unroll
            for (int m = 0; m < 4; ++m) { const int row = row0 + ai * HALF + m * 16; bf16_t* rowp = base + (size_t)row * ld + col0;
#pragma unroll
                for (int bj = 0; bj < 2; ++bj) { f32x4 v0 = acc[ai][bj][m][0], v1 = acc[ai][bj][m][1];
                    if (mode == 1) { v0 = v0 * c2; v1 = v1 * c2; }
                    else if (mode == 4) {
#pragma unroll
                        for (int i = 0; i < 4; ++i) { v0[i] = v0[i] * sigmoid_f(v0[i]); v1[i] = v1[i] * sigmoid_f(v1[i]); } }
                    if (mode == 5) continue;
                    __builtin_nontemporal_store(pack8(v0, v1), (u32x4*)(rowp + bj * HALF)); }
                if (mode == 5) {
                    f32x4 r0, r1, s0, s1;
#pragma unroll
                    for (int i = 0; i < 4; ++i) { const float ea0 = __builtin_amdgcn_exp2f(acc[ai][0][m][0][i]); float er0 = __builtin_amdgcn_exp2f(acc[ai][1][m][0][i]);
                        const float ea1 = __builtin_amdgcn_exp2f(acc[ai][0][m][1][i]); float er1 = __builtin_amdgcn_exp2f(acc[ai][1][m][1][i]);
                        er0 = __builtin_fminf(er0, 1.0e18f); er1 = __builtin_fminf(er1, 1.0e18f);
                        s0[i] = __builtin_amdgcn_rcpf(1.0f + er0); s1[i] = __builtin_amdgcn_rcpf(1.0f + er1);
                        r0[i] = (1.0f + er0) * __builtin_amdgcn_rcpf(1.0f + ea0); r1[i] = (1.0f + er1) * __builtin_amdgcn_rcpf(1.0f + ea1); }
                    bf16_t* gp = ZG + (size_t)row * 2048 + 128 * (pn - 14) + wc * 32 + 8 * fq;
                    __builtin_nontemporal_store(pack8(r0, r1), (u32x4*)gp); __builtin_nontemporal_store(pack8(s0, s1), (u32x4*)(gp + 1024)); } }
    }
};

struct EpiGateCat {
    static constexpr bool PERM = true, AFTER_DRAIN = false; static constexpr int MID_T = 8;
    bf16_t* O; int ldo; const bf16_t* gate; int ldg;
    __device__ __forceinline__ void mid(f32x4 (&acc)[2][2][4][2], const Unit& u, int, int, int, int) const {
        int t_ = threadIdx.x; asm volatile("" : "+v"(t_));
        const int wid_ = t_ >> 6, wr = wid_ >> 2, wc = wid_ & 3, fr = t_ & 15, fq = (t_ & 63) >> 4;
        const int row0 = u.pm * BM + wr * 64 + fr, col0 = u.pn * BM + wc * 32 + 8 * fq;
#pragma unroll
        for (int ai = 0; ai < 2; ++ai) { u32x4 g[4][2];
#pragma unroll
            for (int m = 0; m < 4; ++m) { const bf16_t* gp = gate + (size_t)(row0 + ai * HALF + m * 16) * ldg + col0; g[m][0] = *(const u32x4*)gp; g[m][1] = *(const u32x4*)(gp + HALF); }
#pragma unroll
            for (int m = 0; m < 4; ++m)
#pragma unroll
                for (int bj = 0; bj < 2; ++bj) { const u32x4 a = g[m][bj]; f32x4& v0 = acc[ai][bj][m][0]; f32x4& v1 = acc[ai][bj][m][1];
                    v0[0] *= bf_lo(a.x); v0[1] *= bf_hi(a.x); v0[2] *= bf_lo(a.y); v0[3] *= bf_hi(a.y);
                    v1[0] *= bf_lo(a.z); v1[1] *= bf_hi(a.z); v1[2] *= bf_lo(a.w); v1[3] *= bf_hi(a.w); }
            asm volatile("" ::: "memory"); }
    }
    __device__ __forceinline__ void operator()(const f32x4 (&acc)[2][2][4][2], const Unit& u, int wr, int wc, int fr, int fq) const {
        const int row0 = u.pm * BM + wr * 64 + fr, col0 = u.pn * BM + wc * 32 + 8 * fq;
#pragma unroll
        for (int ai = 0; ai < 2; ++ai)
#pragma unroll
            for (int m = 0; m < 4; ++m) { const size_t row = (size_t)(row0 + ai * HALF + m * 16);
#pragma unroll
                for (int bj = 0; bj < 2; ++bj) { const int c = col0 + bj * HALF;
                    const u32x4 g = *(const u32x4*)(gate + row * ldg + 1024 + c);
                    f32x4 v0 = acc[ai][bj][m][0], v1 = acc[ai][bj][m][1];
                    v0[0] *= bf_lo(g.x); v0[1] *= bf_hi(g.x); v0[2] *= bf_lo(g.y); v0[3] *= bf_hi(g.y);
                    v1[0] *= bf_lo(g.z); v1[1] *= bf_hi(g.z); v1[2] *= bf_lo(g.w); v1[3] *= bf_hi(g.w);
                    *(u32x4*)(O + row * ldo + c) = pack8(v0, v1); } }
    }
};

struct PanelSumsq {
    float* xbuf;
    unsigned* cnt;
    unsigned* tmo;
    float eps;
    __device__ __forceinline__ bool run(const f32x4 (&v)[2][2][4][2], const Unit& u, int wr, int wc, int fr, int fq, PG8_LAS unsigned char* lds, int wid, int lane) const {
        PG8_LAS float* P = (PG8_LAS float*)lds;
        PG8_LAS float* S = (PG8_LAS float*)(lds + 8192);
        PG8_LAS unsigned* flag = (PG8_LAS unsigned*)(lds + 8192 + 2048);
#pragma unroll
        for (int ai = 0; ai < 2; ++ai)
#pragma unroll
            for (int m = 0; m < 4; ++m) {
                float q = 0.f;
#pragma unroll
                for (int bj = 0; bj < 2; ++bj)
#pragma unroll
                    for (int n = 0; n < 2; ++n) { const f32x4 x = v[ai][bj][m][n]; q += (x[0] * x[0] + x[1] * x[1]) + (x[2] * x[2] + x[3] * x[3]); }
                q += __shfl_xor(q, 16); q += __shfl_xor(q, 32);
                if (fq == 0) P[(ai * HALF + wr * 64 + m * 16 + fr) * 4 + wc] = q;
            }
        asm volatile("s_waitcnt lgkmcnt(0)" ::: "memory"); __builtin_amdgcn_s_barrier(); asm volatile("" ::: "memory");
        const int row = wid * 32 + (lane & 31);
        if (lane < 32) {
            const float t = (P[row * 4 + 0] + P[row * 4 + 1]) + (P[row * 4 + 2] + P[row * 4 + 3]);
            __hip_atomic_store((unsigned*)xbuf + ((size_t)(u.pm * BM + row) * 4 + u.pn), __float_as_uint(t), __ATOMIC_RELAXED, __HIP_MEMORY_SCOPE_AGENT);
        }
        asm volatile("s_waitcnt vmcnt(0)" ::: "memory");
        if (lane == 0) __hip_atomic_fetch_add(cnt + 64 * u.pm, 1u, __ATOMIC_RELAXED, __HIP_MEMORY_SCOPE_AGENT);
        if (wid == 0) {
            bool dead = false; const unsigned long long t0 = __builtin_amdgcn_s_memrealtime();
            for (;;) {
                if ((unsigned)__builtin_amdgcn_readfirstlane(__hip_atomic_load(cnt + 64 * u.pm, __ATOMIC_RELAXED, __HIP_MEMORY_SCOPE_AGENT)) >= 32u) break;
                if (__builtin_amdgcn_s_memrealtime() - t0 > 2000000ull) { if (lane == 0) __hip_atomic_store(tmo, 1u, __ATOMIC_RELAXED, __HIP_MEMORY_SCOPE_AGENT); dead = true; break; }
                __builtin_amdgcn_s_sleep(2);
            }
            __builtin_amdgcn_fence(__ATOMIC_ACQUIRE, "agent");
            if (lane == 0) flag[0] = dead ? 1u : 0u;
        }
        asm volatile("s_waitcnt vmcnt(0) lgkmcnt(0)" ::: "memory"); __builtin_amdgcn_s_barrier(); asm volatile("" ::: "memory");
        const bool bad = flag[0] != 0u;
        if (lane < 32) {
            const unsigned* slot = (const unsigned*)xbuf + (size_t)(u.pm * BM + row) * 4; float tot = 0.f;
#pragma unroll
            for (int t = 0; t < 4; ++t) tot += __uint_as_float(__hip_atomic_load(slot + t, __ATOMIC_RELAXED, __HIP_MEMORY_SCOPE_AGENT));
            S[row] = 1.0f / sqrtf(tot * (1.0f / 1024.0f) + eps);
        }
        asm volatile("s_waitcnt lgkmcnt(0)" ::: "memory"); __builtin_amdgcn_s_barrier(); asm volatile("" ::: "memory");
        return bad;
    }
};
template <bool TWO> struct EpiRmsRes {
    static constexpr bool PERM = false, AFTER_DRAIN = true; static constexpr int MID_T = -1;
    const float* base; float* out; bf16_t* xn; int ldc; const float* gpost; const float* gnext; float scale; PanelSumsq st1, st2;
    __device__ __forceinline__ void fused(f32x4 (&acc)[2][2][4][2], const Unit& u, int wr, int wc, int fr, int fq, PG8_LAS unsigned char* lds, int wid, int lane) const {
        typedef unsigned u32x2v __attribute__((ext_vector_type(2)));
        const PG8_LAS float* S = (const PG8_LAS float*)(lds + 8192);
        const int col0 = u.pn * BM + wc * 32 + 4 * fq;
        (void)st1.run(acc, u, wr, wc, fr, fq, lds, wid, lane);
#pragma unroll
        for (int ai = 0; ai < 2; ++ai)
#pragma unroll
            for (int m = 0; m < 4; ++m) { const int r = ai * HALF + wr * 64 + m * 16 + fr; const float sr = S[r] * scale; const size_t off = (size_t)(u.pm * BM + r) * ldc + col0;
#pragma unroll
                for (int bj = 0; bj < 2; ++bj)
#pragma unroll
                    for (int n = 0; n < 2; ++n) { const f32x4 bs = *(const f32x4*)(base + off + bj * HALF + n * 16), g = *(const f32x4*)(gpost + col0 + bj * HALF + n * 16);
                        const f32x4 x1 = bs + acc[ai][bj][m][n] * sr * g; acc[ai][bj][m][n] = x1; if (!TWO) *(f32x4*)(out + off + bj * HALF + n * 16) = x1; }
                asm volatile("" : "+v"(acc[ai][0][m][0]), "+v"(acc[ai][0][m][1]), "+v"(acc[ai][1][m][0]), "+v"(acc[ai][1][m][1]));
                asm volatile("" ::: "memory"); }
        if (TWO) {
            (void)st2.run(acc, u, wr, wc, fr, fq, lds, wid, lane);
#pragma unroll
            for (int ai = 0; ai < 2; ++ai)
#pragma unroll
                for (int m = 0; m < 4; ++m) { const int r = ai * HALF + wr * 64 + m * 16 + fr; const float sr = S[r]; const size_t off = (size_t)(u.pm * BM + r) * ldc + col0;
#pragma unroll
                    for (int bj = 0; bj < 2; ++bj)
#pragma unroll
                        for (int n = 0; n < 2; ++n) { const f32x4 x1 = acc[ai][bj][m][n], g = *(const f32x4*)(gnext + col0 + bj * HALF + n * 16);
                            *(f32x4*)(out + off + bj * HALF + n * 16) = x1;
                            const f32x4 o = x1 * sr * g; u32x2v w; w.x = cvt_pk_bf16(o[0], o[1]); w.y = cvt_pk_bf16(o[2], o[3]); *(u32x2v*)(xn + off + bj * HALF + n * 16) = w; }
                    asm volatile("" ::: "memory"); }
        }
    }
};
}
#include <hip/hip_bf16.h>
#include <cmath>
namespace attn_body {
using bf16=__hip_bfloat16;
using bf16x8=__attribute__((ext_vector_type(8)))short;
using s16x4=__attribute__((ext_vector_type(4)))short;
using f32x16=__attribute__((ext_vector_type(16)))float;
using u32x4=__attribute__((ext_vector_type(4)))unsigned;
constexpr int BATCH=8,SEQ=4096,D=64,DM=1536,OPITCH=512,DAPITCH=1024;
constexpr int NW=8,QBLK=32,QB=QBLK*NW,KVBLK=64,NQB=SEQ/QB;
constexpr int ATTN_PITCH=DM, ATTN_UNIT_ROWS=QB;
__device__ __forceinline__ int crow(int r,int hi){return (r&3)+8*(r>>2)+4*hi;}
#define SBAR() __builtin_amdgcn_sched_barrier(0)
__device__ __forceinline__ void cmask(f32x16&p0,f32x16&p1,int jb,int qrel,int hi){
  const float NEG=-INFINITY; int kb=64*jb+4*hi;
  #pragma unroll
  for(int r=0;r<16;++r){int kv=kb+(r&3)+8*(r>>2); if(kv>qrel)p0[r]=NEG; if(kv+32>qrel)p1[r]=NEG;}
}

constexpr int NSLOT=3, SLOTB=8192;
constexpr int LDS_K=0, LDS_V=NSLOT*SLOTB, LDS_WS=LDS_V+NSLOT*2*SLOTB, LDS_OST=LDS_WS+NW*64*4, LDS_BYTES=LDS_OST+NW*4096;
constexpr float C2=0.125f*1.4426950408889634f;
__device__ __forceinline__ void glds16(const void*gsrc,unsigned lds_dst){unsigned keep;
  asm volatile("s_mov_b32 %0, m0\n\ts_mov_b32 m0, %2\n\ts_nop 0\n\tglobal_load_lds_dwordx4 %1, off\n\ts_mov_b32 m0, %0":"=&s"(keep):"v"(gsrc),"s"(lds_dst):"memory");}
__device__ __forceinline__ float max3f(float a,float b,float c){float r;asm("v_max3_f32 %0, %1, %2, %3":"=v"(r):"v"(a),"v"(b),"v"(c));return r;}
__device__ __forceinline__ float max2f(float a,float b){float r;asm("v_max_f32_e32 %0, %1, %2":"=v"(r):"v"(a),"v"(b));return r;}
__device__ __forceinline__ float fadd_s(float a,float b){float r;asm("v_add_f32_e32 %0, %1, %2":"=v"(r):"v"(a),"v"(b));return r;}
__device__ __forceinline__ float fsub_s(float a,float b){float r;asm("v_sub_f32_e32 %0, %1, %2":"=v"(r):"v"(a),"v"(b));return r;}
typedef float f32x2_t __attribute__((ext_vector_type(2))); typedef __bf16 bf16x2_t __attribute__((ext_vector_type(2)));
__device__ __forceinline__ unsigned cvtpk_s(float lo,float hi){f32x2_t v={lo,hi};bf16x2_t b=__builtin_convertvector(v,bf16x2_t);return __builtin_bit_cast(unsigned,b);}
#define WAIT_BAR(N) asm volatile("s_waitcnt vmcnt(" #N ") lgkmcnt(0)\n\ts_barrier":::"memory")

__device__ __forceinline__ void qkt(f32x16&p0,f32x16&p1,const char*Kslot,const bf16x8*qr,int r32,int hi){
  const char*kb=Kslot+hi*1024+r32*16;
  #pragma unroll
  for(int d0=0;d0<4;++d0){
    const bf16x8 b0=*reinterpret_cast<const bf16x8*>(kb+d0*2048);
    const bf16x8 b1=*reinterpret_cast<const bf16x8*>(kb+d0*2048+512);
    if(d0==0){p0=__builtin_amdgcn_mfma_f32_32x32x16_bf16(b0,qr[0],f32x16{},0,0,0);p1=__builtin_amdgcn_mfma_f32_32x32x16_bf16(b1,qr[0],f32x16{},0,0,0);}
    else{p0=__builtin_amdgcn_mfma_f32_32x32x16_bf16(b0,qr[d0],p0,0,0,0);p1=__builtin_amdgcn_mfma_f32_32x32x16_bf16(b1,qr[d0],p1,0,0,0);}}
}
typedef __attribute__((address_space(3))) const char* lds_cptr;
typedef short v4i16_t __attribute__((ext_vector_type(4)));
__device__ __forceinline__ void kload8(bf16x8*kf,lds_cptr kp){
  kf[0]=*(const __attribute__((address_space(3))) bf16x8*)(kp);      kf[1]=*(const __attribute__((address_space(3))) bf16x8*)(kp+512);
  kf[2]=*(const __attribute__((address_space(3))) bf16x8*)(kp+2048); kf[3]=*(const __attribute__((address_space(3))) bf16x8*)(kp+2560);
  kf[4]=*(const __attribute__((address_space(3))) bf16x8*)(kp+4096); kf[5]=*(const __attribute__((address_space(3))) bf16x8*)(kp+4608);
  kf[6]=*(const __attribute__((address_space(3))) bf16x8*)(kp+6144); kf[7]=*(const __attribute__((address_space(3))) bf16x8*)(kp+6656);
}
__device__ __forceinline__ void kload2(bf16x8*kf,lds_cptr kp,int j){ kf[2*j]=*(const __attribute__((address_space(3))) bf16x8*)(kp+j*2048); kf[2*j+1]=*(const __attribute__((address_space(3))) bf16x8*)(kp+j*2048+512); }
__device__ __forceinline__ s16x4 vtr(lds_cptr p){ return __builtin_bit_cast(s16x4,__builtin_amdgcn_ds_read_tr16_b64_v4i16((__attribute__((address_space(3))) v4i16_t*)p)); }
__device__ __forceinline__ float rowmax(const f32x16&p0,const f32x16&p1){
  float a=max3f(p0[0],p0[1],p1[0]),b=max3f(p0[2],p0[3],p1[1]);a=max3f(a,p1[2],p1[3]);
  #pragma unroll
  for(int r=4;r<16;r+=4){a=max3f(a,p0[r],p0[r+1]);b=max3f(b,p0[r+2],p0[r+3]);a=max3f(a,p1[r],p1[r+1]);b=max3f(b,p1[r+2],p1[r+3]);}
  const float m=max2f(a,b);
  auto rr=__builtin_amdgcn_permlane32_swap(__float_as_uint(m),__float_as_uint(m),false,false);
  return max2f(__uint_as_float(rr[0]),__uint_as_float(rr[1]));
}
__device__ __forceinline__ void pv(f32x16*o,int vb,bf16x8 pa0,bf16x8 pa1,bf16x8 pa2,bf16x8 pa3){
  #pragma unroll
  for(int d0=0;d0<4;++d0){s16x4 lo[4],hi[4];
    #pragma unroll
    for(int ks=0;ks<4;++ks){
      asm volatile("ds_read_b64_tr_b16 %0,%1 offset:%c2":"=&v"(lo[ks]):"v"(vb),"i"(d0*4096+ks*1024):"memory");
      asm volatile("ds_read_b64_tr_b16 %0,%1 offset:%c2":"=&v"(hi[ks]):"v"(vb),"i"(d0*4096+ks*1024+512):"memory");}
    asm volatile("s_waitcnt lgkmcnt(0)":::"memory");SBAR();
    #define PK(k) (bf16x8){lo[k][0],lo[k][1],lo[k][2],lo[k][3],hi[k][0],hi[k][1],hi[k][2],hi[k][3]}
    o[d0]=__builtin_amdgcn_mfma_f32_32x32x16_bf16(pa0,PK(0),o[d0],0,0,0);
    o[d0]=__builtin_amdgcn_mfma_f32_32x32x16_bf16(pa1,PK(1),o[d0],0,0,0);
    o[d0]=__builtin_amdgcn_mfma_f32_32x32x16_bf16(pa2,PK(2),o[d0],0,0,0);
    o[d0]=__builtin_amdgcn_mfma_f32_32x32x16_bf16(pa3,PK(3),o[d0],0,0,0);
    #undef PK
  }
}

#ifndef ATTN_STORE16
#define ATTN_STORE16(p,v) (*(u32x4*)(p)=(v))
#endif
template<int THRL> __device__ __forceinline__ void attn_unit(int b,int h,int qb,const bf16*Q,const bf16*__restrict__ K,const bf16*__restrict__ V,bf16*O,char*shm,const bool cmb,const float cmb_lam,const float cmb_scale,const float*cmb_g,const bf16*O1,bf16*DAo){
  int tid_=threadIdx.x; asm volatile("":"+v"(tid_)); const int tid=tid_,lane=tid&63,r32=lane&31,hi=lane>>5; const int wid=__builtin_amdgcn_readfirstlane(tid>>6);
  const long rowbase=(long)b*SEQ; const int q0=qb*QB;
  const bf16*Qw=Q+(rowbase+q0+wid*QBLK)*DM+h*D;
  const bf16*Kh=K+rowbase*DM+h*D,*Vh=V+rowbase*DM+h*D;
  const unsigned lds0=(unsigned)(uintptr_t)shm;
  float*wsf=(float*)(shm+LDS_WS)+wid*64;
  const bf16*ksrc=Kh+(long)lane*DM+wid*8;
  const bf16*vsrc=Vh+(long)(16*(wid&3)+(lane>>2))*DM+(wid>>2)*32+(lane&3)*8;
  const unsigned kdst=lds0+LDS_K+wid*1024, vdst=lds0+LDS_V+wid*1024;
  #define DMA_K(t,slot) glds16(ksrc+(long)(t)*KVBLK*DM,(unsigned)__builtin_amdgcn_readfirstlane(kdst+(slot)))
  #define DMA_V(t,slot) do{ glds16(vsrc+(long)(t)*KVBLK*DM,(unsigned)__builtin_amdgcn_readfirstlane(vdst+2*(slot))); glds16(vsrc+64+(long)(t)*KVBLK*DM,(unsigned)__builtin_amdgcn_readfirstlane(vdst+2*(slot)+8192)); }while(0)
  const int vb0=(int)(lds0+LDS_V)+((lane>>4)&1)*32+(lane&3)*8+(4*hi+((lane&15)>>2))*64;
  const char*Kbase=shm+LDS_K; bf16x8 kf[8];
  const lds_cptr shm3=(lds_cptr)shm; const lds_cptr kp0=shm3+LDS_K+hi*1024+r32*16; const lds_cptr vp0=shm3+LDS_V+((lane>>4)&1)*32+(lane&3)*8+(4*hi+((lane&15)>>2))*64;
  const int NT=(q0+QB)/KVBLK;
  DMA_K(0,0);DMA_V(0,0);DMA_K(1,SLOTB);
  bf16x8 qr[4];
  #pragma unroll
  for(int d0=0;d0<4;++d0)qr[d0]=*reinterpret_cast<const bf16x8*>(&Qw[(long)r32*DM+d0*16+hi*8]);
  float mhat=0.f,l_reg=0.f;f32x16 o[4];o[0]=f32x16{};o[1]=f32x16{};o[2]=f32x16{};o[3]=f32x16{};
  const int qrel=wid*QBLK+r32;
  #define CMASK(P0,P1,t) do{int jb_=(t)-(NT-4); if(jb_>=0)cmask(P0,P1,jb_,qrel,hi);}while(0)
  bool resc=false;
  #define START(P0,P1) do{ const float rm=rowmax(P0,P1); resc=false; mhat=rm; \
    _Pragma("unroll") for(int r=0;r<16;++r)P0[r]=__builtin_amdgcn_exp2f(P0[r]-mhat); }while(0)
  #define RESC() do{ if(resc){ asm volatile("s_waitcnt lgkmcnt(0)":::"memory"); \
      _Pragma("unroll") for(int d_=0;d_<4;++d_) _Pragma("unroll") for(int r=0;r<16;++r)o[d_][r]*=wsf[crow(r,hi)]; } }while(0)
  f32x16 pA0,pA1,pB0,pB1;
  int sl_prev=0,sl_cur=0,sl_next=SLOTB;
  #define ROT() do{sl_prev=sl_cur;sl_cur=sl_next;sl_next=(sl_next==(NSLOT-1)*SLOTB)?0:sl_next+SLOTB;}while(0)
  DMA_K(2,2*SLOTB);
  WAIT_BAR(3);
  qkt(pA0,pA1,Kbase,qr,r32,hi);asm volatile("s_nop 15\n\ts_nop 7":"+v"(pA0),"+v"(pA1));CMASK(pA0,pA1,0);
  START(pA0,pA1);
  _Pragma("unroll") for(int r=0;r<16;++r)pA1[r]=__builtin_amdgcn_exp2f(pA1[r]-mhat);
  WAIT_BAR(0);
  DMA_K(3,0);DMA_V(1,SLOTB);
  ROT();
  kload8(kf,kp0+sl_cur);
  WAIT_BAR(3);
  s16x4 vlo[8],vhi[8]; u32x4 pw0,pw1,pw2,pw3;
  #define PKW(P,B) cvtpk_s(P[B],P[B+1])
  #define PAF(k) __builtin_bit_cast(bf16x8,pw##k)
  #define VFR(i) (bf16x8){vlo[i][0],vlo[i][1],vlo[i][2],vlo[i][3],vhi[i][0],vhi[i][1],vhi[i][2],vhi[i][3]}
  #define PIN(x) asm volatile("":"+v"(x))
  #define MX3(a,b,c) __builtin_fmaxf(__builtin_fmaxf((a),(b)),(c))
  #define GAPA(MF,A0,A1,A2,A3,W0,W1,PW) do{ MF; sacc+=A0; sacc+=A1; sacc+=A2; sacc+=A3; PIN(sacc); W0; W1; PIN(PW); SBAR(); }while(0)
  #define EX(v) __builtin_amdgcn_exp2f((v)-mhat)
  #define FIDX(k) ((((k)&3)<<2)+((k)>>2))
  #define VRD(k) do{ vlo[(k)&7]=vtr(vp_+FIDX(k)*1024); vhi[(k)&7]=vtr(vp_+FIDX(k)*1024+512); }while(0)
  #define GAPB(k,PK_,X,B) do{ o[(k)&3]=__builtin_amdgcn_mfma_f32_32x32x16_bf16(PK_,VFR((k)&7),o[(k)&3],0,0,0); X[B]=EX(X[B]); X[B+1]=EX(X[B+1]); PIN(X); SBAR(); }while(0)
  #define KRD(G,j) do{ if(G){ kload2(kf,kp0+sl_next,j); SBAR(); } }while(0)
  #define QK(a,b,c) __builtin_amdgcn_mfma_f32_32x32x16_bf16(a,b,c,0,0,0)
  #define STEP(C0,C1,P0,P1,t,GK,GV,GL) do{ SBAR(); \
    const lds_cptr vp_=vp0+2*sl_prev; \
    float sacc=(P0[0]+P0[1]); \
    GAPA(C0=QK(kf[0],qr[0],f32x16{}), P0[2],P0[3],P0[4],P0[5],     pw0[0]=PKW(P0,0), pw0[1]=PKW(P0,2), pw0); \
    GAPA(C1=QK(kf[1],qr[0],f32x16{}), P0[6],P0[7],P0[8],P0[9],     pw0[2]=PKW(P0,4), pw0[3]=PKW(P0,6), pw0); \
    GAPA(C0=QK(kf[2],qr[1],C0),       P0[10],P0[11],P0[12],P0[13], pw1[0]=PKW(P0,8), pw1[1]=PKW(P0,10), pw1); \
    GAPA(C1=QK(kf[3],qr[1],C1),       P0[14],P0[15],P1[0],P1[1],   pw1[2]=PKW(P0,12),pw1[3]=PKW(P0,14), pw1); \
    VRD(0); SBAR(); GAPA(C0=QK(kf[4],qr[2],C0), P1[2],P1[3],P1[4],P1[5],     pw2[0]=PKW(P1,0), pw2[1]=PKW(P1,2), pw2); \
    VRD(1); SBAR(); GAPA(C1=QK(kf[5],qr[2],C1), P1[6],P1[7],P1[8],P1[9],     pw2[2]=PKW(P1,4), pw2[3]=PKW(P1,6), pw2); \
    VRD(2); SBAR(); GAPA(C0=QK(kf[6],qr[3],C0), P1[10],P1[11],P1[12],P1[13], pw3[0]=PKW(P1,8), pw3[1]=PKW(P1,10), pw3); \
    VRD(3); SBAR(); GAPA(C1=QK(kf[7],qr[3],C1), P1[14],P1[15],0.f,0.f,       pw3[2]=PKW(P1,12),pw3[3]=PKW(P1,14), pw3); \
    l_reg+=sacc; \
    if(GK){DMA_K((t)+3,sl_cur);} if(GV){DMA_V((t)+1,sl_next);} \
    CMASK(C0,C1,t); \
    { float a=MX3(C0[0],C0[1],C1[0]),b=MX3(C0[2],C0[3],C1[1]); a=MX3(a,C1[2],C1[3]); \
      _Pragma("unroll") for(int r=4;r<16;r+=4){a=MX3(a,C0[r],C0[r+1]);b=MX3(b,C0[r+2],C0[r+3]);a=MX3(a,C1[r],C1[r+1]);b=MX3(b,C1[r+2],C1[r+3]);} \
      float rm=__builtin_fmaxf(a,b); { auto rr=__builtin_amdgcn_permlane32_swap(__float_as_uint(rm),__float_as_uint(rm),false,false); rm=__builtin_fmaxf(__uint_as_float(rr[0]),__uint_as_float(rr[1])); } \
      rm-=mhat; resc=false; \
      if(__builtin_expect(__any(rm>(float)THRL),0)){ const float dl=__builtin_fmaxf(rm,0.f); mhat+=dl; \
        const float f=__builtin_amdgcn_exp2f(-dl); l_reg*=f; if(hi==0)wsf[r32]=f; resc=true; } } \
    SBAR(); \
    GAPB(0,PAF(0),C0,0);   VRD(4);  SBAR(); \
    GAPB(1,PAF(0),C0,2);   VRD(5);  SBAR(); \
    GAPB(2,PAF(0),C0,4);   VRD(6);  SBAR(); \
    GAPB(3,PAF(0),C0,6);   VRD(7);  SBAR(); KRD(GL,0); \
    GAPB(4,PAF(1),C0,8);   VRD(8);  SBAR(); \
    GAPB(5,PAF(1),C0,10);  VRD(9);  SBAR(); \
    GAPB(6,PAF(1),C0,12);  VRD(10); SBAR(); KRD(GL,1); \
    GAPB(7,PAF(1),C0,14);  VRD(11); SBAR(); \
    GAPB(8,PAF(2),C1,0);   VRD(12); SBAR(); \
    GAPB(9,PAF(2),C1,2);   VRD(13); SBAR(); KRD(GL,2); \
    GAPB(10,PAF(2),C1,4);  VRD(14); SBAR(); \
    GAPB(11,PAF(2),C1,6);  VRD(15); SBAR(); \
    GAPB(12,PAF(3),C1,8);  KRD(GL,3); \
    GAPB(13,PAF(3),C1,10); \
    GAPB(14,PAF(3),C1,12); \
    GAPB(15,PAF(3),C1,14); \
    }while(0)
  int t=1;
  #undef CMASK
  #define CMASK(P0,P1,t) do{}while(0)
  for(;t+5<NT;t+=2){
    STEP(pB0,pB1,pA0,pA1,t,true,true,true);     WAIT_BAR(3); RESC(); ROT();
    STEP(pA0,pA1,pB0,pB1,t+1,true,true,true);   WAIT_BAR(3); RESC(); ROT();
  }
  #undef CMASK
  #define CMASK(P0,P1,t) do{int jb_=(t)-(NT-4); if(jb_>=0)cmask(P0,P1,jb_,qrel,hi);}while(0)
  #define ENDW(tt) do{ if((tt)+3<NT){WAIT_BAR(3);} else if((tt)+2<NT){WAIT_BAR(2);} else {WAIT_BAR(0);} }while(0)
  for(;t+1<NT;t+=2){
    STEP(pB0,pB1,pA0,pA1,t,(t+3<NT),(t+1<NT),(t+1<NT));       ENDW(t);   RESC(); ROT();
    STEP(pA0,pA1,pB0,pB1,t+1,(t+4<NT),(t+2<NT),(t+2<NT));     ENDW(t+1); RESC(); ROT();
  }
  STEP(pB0,pB1,pA0,pA1,NT-1,false,false,false); RESC();
  { float sacc=pB0[0]+pB0[1]; _Pragma("unroll") for(int r=2;r<16;++r)sacc+=pB0[r]; _Pragma("unroll") for(int r=0;r<16;++r)sacc+=pB1[r]; l_reg+=sacc;
    pw0=(u32x4){PKW(pB0,0),PKW(pB0,2),PKW(pB0,4),PKW(pB0,6)};pw1=(u32x4){PKW(pB0,8),PKW(pB0,10),PKW(pB0,12),PKW(pB0,14)};pw2=(u32x4){PKW(pB1,0),PKW(pB1,2),PKW(pB1,4),PKW(pB1,6)};pw3=(u32x4){PKW(pB1,8),PKW(pB1,10),PKW(pB1,12),PKW(pB1,14)};
    SBAR(); pv(o,vb0+2*sl_cur,PAF(0),PAF(1),PAF(2),PAF(3)); }
  #undef PKW
  #undef PAF
  #undef VFR
  #undef PIN
  #undef MX3
  #undef GAPA
  #undef GAPB
  #undef EX
  #undef VRD
  #undef KRD
  #undef STEP
  #undef FIDX
  #undef QK
  #undef ENDW
  {auto rr=__builtin_amdgcn_permlane32_swap(__float_as_uint(l_reg),__float_as_uint(l_reg),false,false);l_reg=__uint_as_float(rr[0])+__uint_as_float(rr[1]);}
  if(hi==0)wsf[32+r32]=l_reg;asm volatile("s_waitcnt lgkmcnt(0)":::"memory");
  float rli[16];
  #pragma unroll
  for(int r=0;r<16;++r)rli[r]=__builtin_amdgcn_rcpf(wsf[32+crow(r,hi)]);
  bf16*Ow=O+(rowbase+q0+wid*QBLK)*OPITCH+h*D;
  { bf16*stg=(bf16*)(shm+LDS_OST)+wid*2048;
    float dv[2][4][8];
    #pragma unroll
    for(int hp=0;hp<2;++hp){
      #pragma unroll
      for(int r=0;r<16;++r){const int orow=crow(r,hi);
        #pragma unroll
        for(int d0=0;d0<2;++d0)stg[orow*64+d0*32+r32]=__float2bfloat16(o[2*hp+d0][r]*rli[r]);}
      asm volatile("s_waitcnt lgkmcnt(0)":::"memory");
      if(!cmb){
        #pragma unroll
        for(int i=0;i<4;++i){const int row=i*8+(lane>>3),ch=lane&7; const u32x4 v=*(const u32x4*)(stg+row*64+ch*8); ATTN_STORE16(Ow+(long)row*OPITCH+hp*64+ch*8,v);}
      } else {
        const bf16*O1w=O1+(rowbase+q0+wid*QBLK)*OPITCH; const float lam=cmb_lam;
        #pragma unroll
        for(int i=0;i<4;++i){const int row=i*8+(lane>>3),ch=lane&7; const u32x4 v=*(const u32x4*)(stg+row*64+ch*8); const u32x4 a=*(const u32x4*)(O1w+(long)row*OPITCH+hp*64+ch*8);
          #define BL(w) __uint_as_float((w)<<16)
          #define BH(w) __uint_as_float((w)&0xffff0000u)
          dv[hp][i][0]=BL(a.x)-lam*BL(v.x); dv[hp][i][1]=BH(a.x)-lam*BH(v.x); dv[hp][i][2]=BL(a.y)-lam*BL(v.y); dv[hp][i][3]=BH(a.y)-lam*BH(v.y);
          dv[hp][i][4]=BL(a.z)-lam*BL(v.z); dv[hp][i][5]=BH(a.z)-lam*BH(v.z); dv[hp][i][6]=BL(a.w)-lam*BL(v.w); dv[hp][i][7]=BH(a.w)-lam*BH(v.w);
          #undef BL
          #undef BH
        }
      }
      asm volatile("s_waitcnt lgkmcnt(0)":::"memory"); }
    if(cmb){ bf16*Dw=DAo+(rowbase+q0+wid*QBLK)*DAPITCH; const int ch=lane&7;
      #pragma unroll
      for(int i=0;i<4;++i){ const int row=i*8+(lane>>3); float ss=0.f;
        #pragma unroll
        for(int hp=0;hp<2;++hp)
          #pragma unroll
          for(int j=0;j<8;++j)ss+=dv[hp][i][j]*dv[hp][i][j];
        ss+=__shfl_xor(ss,1); ss+=__shfl_xor(ss,2); ss+=__shfl_xor(ss,4);
        const float rn=cmb_scale*__builtin_amdgcn_rsqf(ss*(1.0f/128.0f)+1e-5f);
        #pragma unroll
        for(int hp=0;hp<2;++hp){ const float*gp=cmb_g+hp*64+ch*8; u32x4 w;
          w.x=cvtpk_s(dv[hp][i][0]*rn*gp[0],dv[hp][i][1]*rn*gp[1]); w.y=cvtpk_s(dv[hp][i][2]*rn*gp[2],dv[hp][i][3]*rn*gp[3]);
          w.z=cvtpk_s(dv[hp][i][4]*rn*gp[4],dv[hp][i][5]*rn*gp[5]); w.w=cvtpk_s(dv[hp][i][6]*rn*gp[6],dv[hp][i][7]*rn*gp[7]);
          *(u32x4*)(Dw+(long)row*DAPITCH+hp*64+ch*8)=w; } } } }
  asm volatile("s_waitcnt lgkmcnt(0)\n\ts_barrier":::"memory");
  #undef DMA_K
  #undef DMA_V
  #undef CMASK
  #undef START
  #undef RESC
  #undef ROT
}
constexpr int ATTN_LDS_BYTES=LDS_BYTES;
struct AttnUnit { int b; int m; int qb; };
struct StaticOrder {
  int vcu, G;
  __device__ __forceinline__ explicit StaticOrder(int grid,int block):vcu((grid%8==0)?((block%8)*(grid/8)+block/8):block),G(grid){}
  __device__ __forceinline__ bool next(int i,AttnUnit&u)const{ const int p=vcu+(i>>2)*G; if(p>=256)return false; const int s=p&7, bh=p>>3; u.b=bh>>2; u.m=2*(bh&3)+(i&1); u.qb=(i&2)?s:15-s; return true; }
  __device__ __forceinline__ void a_ready(const AttnUnit&)const{}
  __device__ __forceinline__ void done(const AttnUnit&)const{}
};
struct AttnTensors { const bf16* ZQ; bf16* O; bf16* DA; float lam; float scale; const float* g; };
template<class Sched,int THRL=8> __device__ __forceinline__ void attn_phase(char*lds,const AttnTensors&T,const Sched&S){
  AttnUnit u;
  for(int i=0;S.next(i,u);++i){ S.a_ready(u); const int head=u.m>>1;
    attn_unit<THRL>(u.b,0,u.qb,T.ZQ+64*u.m,T.ZQ+512+64*u.m,T.ZQ+1024+128*head,T.O+128*head,lds,(u.m&1)!=0,T.lam,T.scale,T.g,T.O+128*head,T.DA+128*head); S.done(u); }
}
#undef SBAR
#undef WAIT_BAR
}
constexpr int NWAVES = 8;
constexpr int BATCH = 8, T = 4096, D = 1024, FF = 2816, DIN = 5632;
constexpr int M = BATCH * T;
constexpr size_t MiB = 1u << 20;
constexpr size_t WS_CTL = 0, CTL_ZERO_BYTES = 1 * MiB;
constexpr size_t WS_CS = 1 * MiB;
constexpr size_t WS_WIN = 4 * MiB, WS_WAP = 15 * MiB, WS_WRP = 16 * MiB, WS_WOUT = 17 * MiB;
constexpr size_t WS_XN = 20 * MiB;
constexpr size_t WS_Y = 84 * MiB;
constexpr size_t WS_R0 = 148 * MiB;
constexpr size_t WS_H = WS_R0, WS_WGU = WS_R0 + 176 * MiB, WS_WD = WS_R0 + 188 * MiB;
constexpr size_t WS_ZQ = WS_R0, WS_ZR = WS_R0 + 96 * MiB, WS_ZG = WS_R0 + 224 * MiB;
constexpr size_t WS_PT = WS_ZQ, WS_ACAT = WS_ZQ + 32 * MiB;
constexpr size_t WS_MG = WS_ZR;
constexpr size_t WS_AO = WS_XN, WS_KVT = WS_Y;
constexpr size_t WS_XB = 500 * MiB, XB_BYTES = (size_t)M * 4 * 4;
constexpr size_t WS_RS = 503 * MiB;
constexpr size_t WS_END = 504 * MiB;
static_assert(WS_WD + (size_t)D * FF * 2 <= WS_R0 + 352 * MiB && WS_ZG + (size_t)M * 2048 * 2 == WS_R0 + 352 * MiB && WS_R0 + 352 * MiB == WS_XB && WS_XB + 5 * XB_BYTES <= WS_END, "d_ws map");
static_assert(WS_WIN + (size_t)DIN * D * 2 <= WS_WAP && WS_WOUT + (size_t)D * D * 2 <= WS_XN && WS_XN + (size_t)M * D * 2 == WS_Y && WS_Y + (size_t)M * D * 2 == WS_R0, "d_ws map");
constexpr int CW_TMO = 0;
constexpr int CW_SEAM = 16384, SEAM_BANK = 128 * 64;
constexpr int CW_SCAN = 8192;
constexpr int CW_BAR = 4096;
constexpr int RING_OFF = 0, RING_BYTES = 131072;
constexpr int LDSCTL_OFF = RING_BYTES, MISC_OFF = LDSCTL_OFF + 320;
constexpr int LDS_BYTES = 147456;
static_assert(MISC_OFF + 128 <= LDS_BYTES, "LDS map");
#define GAS __attribute__((address_space(1)))
#define LAS __attribute__((address_space(3)))
typedef unsigned short bf16;
typedef unsigned v4u __attribute__((ext_vector_type(4)));
typedef float f32x4 __attribute__((ext_vector_type(4)));
typedef short bf16x8 __attribute__((ext_vector_type(8)));
typedef GAS unsigned gu32;
typedef GAS unsigned long long gu64;
#define RLX_AGENT __ATOMIC_RELAXED, __HIP_MEMORY_SCOPE_AGENT
#define LDS_WAIT() asm volatile("s_waitcnt lgkmcnt(0)" ::: "memory")
#define VM_WAIT() asm volatile("s_waitcnt vmcnt(0)" ::: "memory")
__device__ __forceinline__ unsigned long long rt() { return __builtin_amdgcn_s_memrealtime(); }
typedef float f32x2v __attribute__((ext_vector_type(2))); typedef __bf16 bf16x2v __attribute__((ext_vector_type(2)));
__device__ __forceinline__ unsigned pk2(float lo, float hi) { const f32x2v v = {lo, hi}; return __builtin_bit_cast(unsigned, __builtin_convertvector(v, bf16x2v)); }
__device__ __forceinline__ unsigned f2bf(float f) { return pk2(f, 0.f) & 0xffffu; }

#define XB_TMO      128
#define XB_XCNT(j)  (256  + 64 * (j))
#define XB_XSUB(j)  (1280 + 64 * (j))
#define XB_XGEN(j)  (2304 + 64 * (j))
#define XB_TOP      3328
#define XB_TOPGEN   3392
#define XCD_BAR_WORDS 3456
#define XB_SPIN_CAP (1u << 18)

__device__ __forceinline__ unsigned xb_ld(unsigned* p)              { return __hip_atomic_load(p, __ATOMIC_RELAXED, __HIP_MEMORY_SCOPE_AGENT); }
__device__ __forceinline__ unsigned xb_add(unsigned* p, unsigned v) { return __hip_atomic_fetch_add(p, v, __ATOMIC_RELAXED, __HIP_MEMORY_SCOPE_AGENT); }
__device__ __forceinline__ unsigned xb_xcc_id() { return (unsigned)__builtin_amdgcn_s_getreg((3 << 11) | 20) & 0xFu; }
#define XB_SPIN(cond, bar) do { unsigned _sp = 0; while (cond) { __builtin_amdgcn_s_sleep(1); \
    if ((++_sp & 255u) == 0u) { if (xb_ld(&(bar)[XB_TMO])) break; if (_sp > XB_SPIN_CAP) { atomicAdd(&(bar)[XB_TMO], 1u); break; } } } } while (0)

struct XcdBarrier {
    unsigned* bar; unsigned x;
    volatile LAS unsigned* st;
};

__device__ __forceinline__ XcdBarrier xcd_barrier_post(unsigned* bar, volatile LAS unsigned* st) {
    XcdBarrier b; b.bar = bar; b.x = xb_xcc_id(); b.st = st;
    if (threadIdx.x == 0) (void)xb_add(&bar[XB_XCNT(b.x)], 1u);
    return b;
}
__device__ __forceinline__ void xcd_barrier_complete(unsigned* bar, unsigned x, unsigned& nloc, unsigned& nx) {
    const unsigned G = gridDim.x * gridDim.y * gridDim.z;
    unsigned sum, cnt, mine, sp = 0u;
    for (;;) {
        sum = 0u; cnt = 0u; mine = 0u;
#pragma unroll
        for (unsigned j = 0; j < 16; ++j) { const unsigned c = xb_ld(&bar[XB_XCNT(j)]); sum += c; cnt += (c > 0u) ? 1u : 0u; mine = (j == x) ? c : mine; }
        if (sum == G) break;
        __builtin_amdgcn_s_sleep(1);
        if ((++sp & 255u) == 0u) { if (xb_ld(&bar[XB_TMO])) break; if (sp > XB_SPIN_CAP) { atomicAdd(&bar[XB_TMO], 1u); break; } }
    }
    nloc = mine > 0u ? mine : 1u; nx = cnt > 0u ? cnt : 1u;
}

__device__ __forceinline__ void xcd_barrier(const XcdBarrier& b) {
    asm volatile("s_waitcnt vmcnt(0)" ::: "memory");
    __syncthreads();
    if (threadIdx.x == 0) {
        unsigned* bar = b.bar;
        __builtin_amdgcn_s_waitcnt(0);
        unsigned nloc = b.st[0], nx = b.st[1];
        if (nloc == 0u) { xcd_barrier_complete(bar, b.x, nloc, nx); b.st[0] = nloc; b.st[1] = nx; }
        const unsigned old = xb_add(&bar[XB_XSUB(b.x)], 1u);
        const unsigned gen = old / nloc;
        if (old + 1u == (gen + 1u) * nloc) {
            __builtin_amdgcn_fence(__ATOMIC_RELEASE, "agent");
            asm volatile("s_waitcnt vmcnt(0)" ::: "memory");
            const unsigned og = xb_add(&bar[XB_TOP], 1u);
            const unsigned tg = og / nx;
            if (og + 1u == (tg + 1u) * nx) xb_add(&bar[XB_TOPGEN], 1u);
            else XB_SPIN(xb_ld(&bar[XB_TOPGEN]) == tg, bar);
            __builtin_amdgcn_fence(__ATOMIC_ACQUIRE, "agent");
            xb_add(&bar[XB_XGEN(b.x)], 1u);
            asm volatile("s_waitcnt vmcnt(0)" ::: "memory");
        } else {
            XB_SPIN(xb_ld(&bar[XB_XGEN(b.x)]) == gen, bar);
            __builtin_amdgcn_fence(__ATOMIC_ACQUIRE, "agent");
            asm volatile("s_waitcnt vmcnt(0)" ::: "memory");
        }
    }
    __syncthreads();
}
struct Frame {
    LAS unsigned char* lds;
    volatile LAS unsigned* MISC;
    gu32* ctl;
    int tid, lane, wave;
    int vcu, G;
};

template <int CTRL> __device__ __forceinline__ float dpp_xadd(float v) { return v + __builtin_bit_cast(float, __builtin_amdgcn_update_dpp(0, __builtin_bit_cast(int, v), CTRL, 0xF, 0xF, false)); }
__device__ __forceinline__ float wave_sum(float v) {
    v = dpp_xadd<0xB1>(v); v = dpp_xadd<0x4E>(v); v = dpp_xadd<0x141>(v); v = dpp_xadd<0x140>(v);
    const int iv = __builtin_bit_cast(int, v);
    const float r0 = __builtin_bit_cast(float, __builtin_amdgcn_readlane(iv, 0)), r1 = __builtin_bit_cast(float, __builtin_amdgcn_readlane(iv, 16));
    const float r2 = __builtin_bit_cast(float, __builtin_amdgcn_readlane(iv, 32)), r3 = __builtin_bit_cast(float, __builtin_amdgcn_readlane(iv, 48));
    return (r0 + r1) + (r2 + r3);
}
__device__ __forceinline__ float bfl(unsigned w) { return __uint_as_float(w << 16); }
__device__ __forceinline__ float bfh(unsigned w) { return __uint_as_float(w & 0xffff0000u); }

__device__ __forceinline__ void transpose_item(const float* W, int K, int N, bf16* WT, int mode, LAS float* scr, int item, int lane, int ldw = 0, int koff = 0, const float* gk = nullptr, float wscale = 1.0f) {
    if (ldw == 0) ldw = K;
    const int nblk = N / 32, kb = item / nblk, nb = item % nblk, k0 = 64 * kb, n0 = 32 * nb;
    int rbase = (mode == 0) ? n0 : (256 * (n0 >> 7) + (n0 & 127) + (mode == 2 ? 128 : 0));
    if (mode == 3) rbase = (n0 < 3584) ? n0 : (n0 < 4608) ? (3584 + 256 * ((n0 - 3584) >> 7) + ((n0 - 3584) & 127)) : (3584 + 256 * ((n0 - 4608) >> 7) + 128 + ((n0 - 4608) & 127));
    const float gl = (gk ? gk[k0 + lane] : 1.0f) * ((mode == 3 && n0 >= 3584) ? -1.4426950408889634f : wscale);
#pragma unroll 8
    for (int i = 0; i < 32; ++i) { const int kk = 2 * i + (lane >> 5); const float gv = __shfl(gl, kk); scr[kk * 33 + (lane & 31)] = W[(size_t)(k0 + kk) * N + n0 + (lane & 31)] * gv; }
    LDS_WAIT(); asm volatile("" ::: "memory");
    const int c = lane & 7;
#pragma unroll
    for (int j = 0; j < 4; ++j) { const int n = (lane >> 3) + 8 * j; const LAS float* s = scr + (8 * c) * 33 + n;
        v4u o; o.x = pk2(s[0 * 33], s[1 * 33]); o.y = pk2(s[2 * 33], s[3 * 33]); o.z = pk2(s[4 * 33], s[5 * 33]); o.w = pk2(s[6 * 33], s[7 * 33]);
        *(GAS v4u*)(WT + (size_t)(rbase + n) * ldw + koff + k0 + 8 * c) = o; }
    LDS_WAIT(); asm volatile("" ::: "memory");
}

template <bool SRC_XN, bool HAS_Y, bool OUT_F32, bool OUT_XN>
__device__ __forceinline__ void row_phase(Frame& F, const float* xin, const bf16* xn_in, const float* rs_in, const bf16* y, const float* gpost, float scale, float* xout, bf16* xn_out, float* rs_out) {
    constexpr int NR = 2;
    const int gw = F.vcu * NWAVES + F.wave, NGW = F.G * NWAVES;
    f32x4 gp[4];
#pragma unroll
    for (int j = 0; j < 4; ++j) gp[j] = HAS_Y ? *(const f32x4*)(gpost + 256 * j + 4 * F.lane) : (f32x4){0.f, 0.f, 0.f, 0.f};
    for (int m0 = gw; m0 < M; m0 += NR * NGW) {
        f32x4 v[NR][4]; unsigned long long yw[NR][4]; float rsv[NR];
#pragma unroll
        for (int q = 0; q < NR; ++q) { const int m = (m0 + q * NGW < M) ? m0 + q * NGW : m0;
            if (SRC_XN) { const GAS unsigned long long* xr = (const GAS unsigned long long*)(xn_in + (size_t)m * D) + F.lane; rsv[q] = rs_in[m];
#pragma unroll
                for (int j = 0; j < 4; ++j) { const unsigned long long w = xr[64 * j]; const unsigned lo = (unsigned)w, hi = (unsigned)(w >> 32); v[q][j] = (f32x4){bfl(lo), bfh(lo), bfl(hi), bfh(hi)}; }
            } else { const GAS f32x4* xr = (const GAS f32x4*)(xin + (size_t)m * D) + F.lane; rsv[q] = 1.f;
#pragma unroll
                for (int j = 0; j < 4; ++j) v[q][j] = xr[64 * j]; }
            if (HAS_Y) { const GAS unsigned long long* yr = (const GAS unsigned long long*)(y + (size_t)m * D) + F.lane;
#pragma unroll
                for (int j = 0; j < 4; ++j) yw[q][j] = yr[64 * j]; } }
#pragma unroll
        for (int q = 0; q < NR; ++q) { const int m = (m0 + q * NGW < M) ? m0 + q * NGW : m0;
            if (SRC_XN) {
#pragma unroll
                for (int j = 0; j < 4; ++j) v[q][j] = v[q][j] * rsv[q]; }
            if (HAS_Y) {
                f32x4 yv[4]; float s = 0.f;
#pragma unroll
                for (int j = 0; j < 4; ++j) { const unsigned lo = (unsigned)yw[q][j], hi = (unsigned)(yw[q][j] >> 32);
                    yv[j] = (f32x4){bfl(lo), bfh(lo), bfl(hi), bfh(hi)}; s += (yv[j].x * yv[j].x + yv[j].y * yv[j].y) + (yv[j].z * yv[j].z + yv[j].w * yv[j].w); }
                const float ry = scale * __builtin_amdgcn_rsqf(wave_sum(s) * (1.f / D) + 1e-6f);
#pragma unroll
                for (int j = 0; j < 4; ++j) v[q][j] = v[q][j] + yv[j] * ry * gp[j];
            }
            if (OUT_F32) { GAS f32x4* xo = (GAS f32x4*)(xout + (size_t)m * D) + F.lane;
#pragma unroll
                for (int j = 0; j < 4; ++j) __builtin_nontemporal_store(v[q][j], (f32x4*)(xo + 64 * j)); }
            if (OUT_XN) {
                float s2 = 0.f;
#pragma unroll
                for (int j = 0; j < 4; ++j) s2 += (v[q][j].x * v[q][j].x + v[q][j].y * v[q][j].y) + (v[q][j].z * v[q][j].z + v[q][j].w * v[q][j].w);
                const float ms = wave_sum(s2) * (1.f / D) + 1e-6f, rx = __builtin_amdgcn_rsqf(ms), rt = ms * rx;
                GAS unsigned long long* o8 = (GAS unsigned long long*)(xn_out + (size_t)m * D) + F.lane;
#pragma unroll
                for (int j = 0; j < 4; ++j) { const f32x4 o = v[q][j] * rx; o8[64 * j] = (unsigned long long)pk2(o.x, o.y) | ((unsigned long long)pk2(o.z, o.w) << 32); }
                if (rs_out && F.lane == 0) rs_out[m] = rt;
            } }
    }
}

namespace ret {
typedef short bf16x8 __attribute__((ext_vector_type(8)));
typedef short s16x4 __attribute__((ext_vector_type(4)));
typedef float f32x16 __attribute__((ext_vector_type(16)));
typedef __attribute__((address_space(3))) const char* lds_cptr;
#define RET_MFMA(a, b, c) __builtin_amdgcn_mfma_f32_32x32x16_bf16(a, b, c, 0, 0, 0)
__device__ __forceinline__ int crow(int r, int hi) { return (r & 3) + 8 * (r >> 2) + 4 * hi; }
__device__ __forceinline__ s16x4 vtr(lds_cptr p) { return __builtin_bit_cast(s16x4, __builtin_amdgcn_ds_read_tr16_b64_v4i16((__attribute__((address_space(3))) s16x4*)p)); }
typedef float f32x2_t __attribute__((ext_vector_type(2))); typedef __bf16 bf16x2_t __attribute__((ext_vector_type(2)));
__device__ __forceinline__ unsigned cvtpk(float lo, float hi) { f32x2_t v = {lo, hi}; bf16x2_t b = __builtin_convertvector(v, bf16x2_t); return __builtin_bit_cast(unsigned, b); }
__device__ __forceinline__ bf16x8 trfrag(lds_cptr img, int cb, int kg, int lane) {
    lds_cptr p = img + (cb * 8 + kg) * 1024 + ((lane >> 4) & 1) * 32 + (lane & 3) * 8 + (4 * (lane >> 5) + ((lane & 15) >> 2)) * 64;
    const s16x4 lo = vtr(p), h = vtr(p + 512);
    return (bf16x8){lo[0], lo[1], lo[2], lo[3], h[0], h[1], h[2], h[3]};
}
__device__ __forceinline__ void load_tr_image(LAS unsigned char* img, const bf16* src, int pitch, int wid, int lane) {
#pragma unroll
    for (int i = 0; i < 4; ++i) { const int p = wid * 4 + i, cb = p >> 3, kg = p & 7, row = 16 * kg + (lane >> 2), col = 32 * cb + (lane & 3) * 8;
        const v4u v = *(const GAS v4u*)(src + (size_t)row * pitch + col); *(LAS v4u*)(img + p * 1024 + lane * 16) = v; }
}
__device__ __forceinline__ float log2_decay(int h) { return __builtin_log2f(1.0f - __builtin_exp2f(-5.0f - (float)h)); }

__device__ __forceinline__ int run_unit(int r, int k) { return (r >> 3) * 32 + 4 * (r & 7) + k; }
__device__ __forceinline__ void r1_load(v4u (&t)[8], const bf16* ZR, int u, int wid, int lane) {
    const int bh = u >> 5, n = u & 31, b = bh >> 2, h = bh & 3;
    const bf16* Zrow = ZR + (size_t)(b * T + 128 * n) * 2048;
#pragma unroll
    for (int i = 0; i < 4; ++i) { const int p = wid * 4 + i, cb = p >> 3, kg = p & 7; const bf16* zr = Zrow + (size_t)(16 * kg + (lane >> 2)) * 2048 + 128 * h + 32 * cb + (lane & 3) * 8;
        t[i] = *(const GAS v4u*)(zr + 1024); t[4 + i] = *(const GAS v4u*)(zr + 512); }
}
__device__ __forceinline__ void r1_phase(LAS unsigned char* lds, const bf16* ZR, bf16* PTL, float* TT, int r0, int rstep, int wid, int lane) {
    const lds_cptr imgV = (lds_cptr)lds, imgK = (lds_cptr)(lds + 32768);
    const int eblk = wid & 3, dh = wid >> 2, r32 = lane & 31, hi = lane >> 5;
    for (int r = r0; r < 256; r += rstep) {
        const float l2g = log2_decay((r >> 3) & 3), g1 = __builtin_exp2f(l2g), gC = __builtin_exp2f(128.0f * l2g), gc1 = __builtin_exp2f(127.0f * l2g);
        v4u t[8];
        r1_load(t, ZR, run_unit(r, 0), wid, lane);
        f32x16 L0 = f32x16{}, L1 = f32x16{};
#pragma unroll
        for (int k = 0; k < 4; ++k) {
            const int u = run_unit(r, k);
#pragma unroll
            for (int i = 0; i < 4; ++i) { *(LAS v4u*)(lds + (wid * 4 + i) * 1024 + lane * 16) = t[i]; *(LAS v4u*)(lds + 32768 + (wid * 4 + i) * 1024 + lane * 16) = t[4 + i]; }
            __syncthreads();
            if (k < 3) r1_load(t, ZR, u + 1, wid, lane);
            f32x16 acc0 = f32x16{}, acc1 = f32x16{};
#pragma unroll
            for (int kg = 0; kg < 8; ++kg) { const bf16x8 a = trfrag(imgV, eblk, kg, lane), b0 = trfrag(imgK, 2 * dh, kg, lane), b1 = trfrag(imgK, 2 * dh + 1, kg, lane);
                acc0 = RET_MFMA(a, b0, acc0); acc1 = RET_MFMA(a, b1, acc1); }
            bf16* out = PTL + (size_t)u * 16384 + 64 * dh + r32;
#pragma unroll
            for (int q = 0; q < 16; ++q) { const int e = 32 * eblk + crow(q, hi); out[e * 128] = (bf16)f2bf(L0[q] * g1); out[e * 128 + 32] = (bf16)f2bf(L1[q] * g1);
                L0[q] = L0[q] * gC + acc0[q] * gc1; L1[q] = L1[q] * gC + acc1[q] * gc1; }
            __syncthreads();
        }
        float* tt = TT + (size_t)r * 16384 + 64 * dh + r32;
#pragma unroll
        for (int q = 0; q < 16; ++q) { const int e = 32 * eblk + crow(q, hi); tt[e * 128] = L0[q]; tt[e * 128 + 32] = L1[q]; }
    }
}

__device__ __forceinline__ bf16x8 rmfrag(const LAS unsigned char* img, int row, int c) { return *(const LAS bf16x8*)(img + row * 256 + ((c ^ (row & 15)) << 4)); }
constexpr int R3_SCR = 131072 + 1024;
struct R3Tiles { v4u tq[4], tk[4], tp[4], tv[4]; };
__device__ __forceinline__ void r3_load(R3Tiles& t, const bf16* ZR, const bf16* PT, int u, int wid, int lane) {
    const int bh = u >> 5, n = u & 31, b = bh >> 2, h = bh & 3, tid = wid * 64 + lane;
    const bf16* Zrow = ZR + (size_t)(b * T + 128 * n) * 2048;
#pragma unroll
    for (int i = 0; i < 4; ++i) { const int idx = i * 512 + tid, row = idx >> 4, c = idx & 15; const bf16* zr = Zrow + (size_t)row * 2048 + 128 * h + c * 8;
        t.tq[i] = *(const GAS v4u*)zr; t.tk[i] = *(const GAS v4u*)(zr + 512);
        t.tp[i] = *(const GAS v4u*)(PT + (size_t)u * 16384 + row * 128 + c * 8);
        const int p = wid * 4 + i, cb = p >> 3, kg = p & 7; t.tv[i] = *(const GAS v4u*)(Zrow + (size_t)(16 * kg + (lane >> 2)) * 2048 + 1024 + 128 * h + 32 * cb + (lane & 3) * 8); }
}
__device__ __forceinline__ void r3_phase(LAS unsigned char* lds, const bf16* ZR, bf16* PT, const float* TT, bf16* OUT, int opitch, int ocol, int r0, int rstep, int wid, int lane) {
 for (int rr = r0; rr < 256; rr += rstep) {
  { const int bh0 = rr >> 3, c0 = rr & 7, tid0 = wid * 64 + lane;
    if (c0 > 0) {
        const float l2g0 = log2_decay(bh0 & 3), G4 = __builtin_exp2f(512.0f * l2g0);
        float S0[4][8];
#pragma unroll
        for (int i = 0; i < 4; ++i)
#pragma unroll
            for (int j = 0; j < 8; ++j) S0[i][j] = 0.f;
        const float* tt = TT + (size_t)(bh0 * 8) * 16384 + tid0 * 8;
        int cp = 0;
        for (; cp + 1 < c0; cp += 2) {
            f32x4 a0[4], a1[4], b0[4], b1[4];
#pragma unroll
            for (int i = 0; i < 4; ++i) { const float* q = tt + (size_t)cp * 16384 + i * 4096; a0[i] = *(const GAS f32x4*)q; a1[i] = *(const GAS f32x4*)(q + 4); b0[i] = *(const GAS f32x4*)(q + 16384); b1[i] = *(const GAS f32x4*)(q + 16384 + 4); }
#pragma unroll
            for (int i = 0; i < 4; ++i)
#pragma unroll
                for (int j = 0; j < 4; ++j) { S0[i][j] = (S0[i][j] * G4 + a0[i][j]) * G4 + b0[i][j]; S0[i][4 + j] = (S0[i][4 + j] * G4 + a1[i][j]) * G4 + b1[i][j]; }
        }
        if (cp < c0) {
#pragma unroll
            for (int i = 0; i < 4; ++i) { const float* q = tt + (size_t)cp * 16384 + i * 4096; const f32x4 a0 = *(const GAS f32x4*)q, a1 = *(const GAS f32x4*)(q + 4);
#pragma unroll
                for (int j = 0; j < 4; ++j) { S0[i][j] = S0[i][j] * G4 + a0[j]; S0[i][4 + j] = S0[i][4 + j] * G4 + a1[j]; } }
        }
        bf16* pt = (bf16*)PT + (size_t)run_unit(rr, 0) * 16384 + tid0 * 8;
        v4u w[4][4];
#pragma unroll
        for (int k = 0; k < 4; ++k)
#pragma unroll
            for (int i = 0; i < 4; ++i) w[k][i] = *(const GAS v4u*)(pt + (size_t)k * 16384 + i * 4096);
#pragma unroll
        for (int k = 0; k < 4; ++k) { const float gk = __builtin_exp2f((float)(128 * k + 1) * l2g0);
#pragma unroll
            for (int i = 0; i < 4; ++i) { const v4u x = w[k][i]; v4u o;
                o.x = cvtpk(bfl(x.x) + gk * S0[i][0], bfh(x.x) + gk * S0[i][1]); o.y = cvtpk(bfl(x.y) + gk * S0[i][2], bfh(x.y) + gk * S0[i][3]);
                o.z = cvtpk(bfl(x.z) + gk * S0[i][4], bfh(x.z) + gk * S0[i][5]); o.w = cvtpk(bfl(x.w) + gk * S0[i][6], bfh(x.w) + gk * S0[i][7]);
                *(GAS v4u*)(pt + (size_t)k * 16384 + i * 4096) = o; } }
    } }
  for (int kk = 0; kk < 4; ++kk) {
    const int u = run_unit(rr, kk);
    R3Tiles tl; r3_load(tl, ZR, PT, u, wid, lane);
    const int bh_ = u >> 5, tid_ = wid * 64 + lane; v4u gt[4];
#pragma unroll
    for (int i = 0; i < 4; ++i) { const int idx = i * 512 + tid_, row = idx >> 4, c = idx & 15; gt[i] = *(const GAS v4u*)(ZR + (size_t)((bh_ >> 2) * T + 128 * (u & 31) + row) * 2048 + 1536 + 128 * (bh_ & 3) + c * 8); }
    const int bh = u >> 5, n = u & 31, b = bh >> 2, h = bh & 3, rowbase = b * T + 128 * n, tid = wid * 64 + lane;
#pragma unroll
    for (int i = 0; i < 4; ++i) { const int idx = i * 512 + tid, row = idx >> 4, c = idx & 15, off = row * 256 + ((c ^ (row & 15)) << 4);
        *(LAS v4u*)(lds + off) = tl.tq[i]; *(LAS v4u*)(lds + 32768 + off) = tl.tk[i]; *(LAS v4u*)(lds + 65536 + off) = tl.tp[i];
        *(LAS v4u*)(lds + 98304 + (wid * 4 + i) * 1024 + lane * 16) = tl.tv[i]; }
    __syncthreads();
    const LAS unsigned char* imgQ = lds; const LAS unsigned char* imgK = lds + 32768; const LAS unsigned char* imgP = lds + 65536; const lds_cptr imgV = (lds_cptr)(lds + 98304);
    const int eh = wid >> 2, qb = eh ? 3 - (wid & 3) : (wid & 3), r32 = lane & 31, hi = lane >> 5;
    f32x16 acc0 = f32x16{}, acc1 = f32x16{};
    for (int kb = 0; kb <= qb; ++kb) {
        f32x16 S = f32x16{};
#pragma unroll 4
        for (int ds = 0; ds < 8; ++ds) S = RET_MFMA(rmfrag(imgK, 32 * kb + r32, 2 * ds + hi), rmfrag(imgQ, 32 * qb + r32, 2 * ds + hi), S);
        if (kb == qb) {
#pragma unroll
            for (int r = 0; r < 16; ++r) if (crow(r, hi) > r32) S[r] = 0.f;
        }
        v4u w0, w1;
        w0.x = cvtpk(S[0], S[1]); w0.y = cvtpk(S[2], S[3]); w0.z = cvtpk(S[4], S[5]); w0.w = cvtpk(S[6], S[7]);
        w1.x = cvtpk(S[8], S[9]); w1.y = cvtpk(S[10], S[11]); w1.z = cvtpk(S[12], S[13]); w1.w = cvtpk(S[14], S[15]);
        const bf16x8 pa0 = __builtin_bit_cast(bf16x8, w0), pa1 = __builtin_bit_cast(bf16x8, w1);
        acc0 = RET_MFMA(pa0, trfrag(imgV, 2 * eh, 2 * kb, lane), acc0);     acc0 = RET_MFMA(pa1, trfrag(imgV, 2 * eh, 2 * kb + 1, lane), acc0);
        acc1 = RET_MFMA(pa0, trfrag(imgV, 2 * eh + 1, 2 * kb, lane), acc1); acc1 = RET_MFMA(pa1, trfrag(imgV, 2 * eh + 1, 2 * kb + 1, lane), acc1);
    }
#pragma unroll
    for (int ds = 0; ds < 8; ++ds) { const bf16x8 qf = rmfrag(imgQ, 32 * qb + r32, 2 * ds + hi); acc0 = RET_MFMA(qf, rmfrag(imgP, 64 * eh + r32, 2 * ds + hi), acc0); acc1 = RET_MFMA(qf, rmfrag(imgP, 64 * eh + 32 + r32, 2 * ds + hi), acc1); }
    const float l2g = log2_decay(h);
    float ss[16];
#pragma unroll
    for (int r = 0; r < 16; ++r) { const float f = __builtin_exp2f((float)(32 * qb + crow(r, hi)) * l2g); acc0[r] *= f; acc1[r] *= f; ss[r] = acc0[r] * acc0[r] + acc1[r] * acc1[r]; }
#pragma unroll
    for (int r = 0; r < 16; ++r) { float s_ = ss[r]; s_ = dpp_xadd<0xB1>(s_); s_ = dpp_xadd<0x4E>(s_); s_ = dpp_xadd<0x141>(s_); s_ = dpp_xadd<0x140>(s_);
        s_ += __shfl_xor(s_, 16); ss[r] = s_; }
    LAS float* scr = (LAS float*)(lds + R3_SCR);
    if (r32 == 0) {
#pragma unroll
        for (int r = 0; r < 16; ++r) scr[wid * 32 + crow(r, hi)] = ss[r];
    }
    __syncthreads();
    LAS float* stage = (LAS float*)lds;
#pragma unroll
    for (int r = 0; r < 16; ++r) { const int ql = crow(r, hi); const float tot = ss[r] + scr[(7 - wid) * 32 + ql];
        const float rn = __builtin_amdgcn_rsqf(tot * (1.0f / 128.0f) + 1e-6f);
        LAS float* sp = stage + (32 * qb + ql) * 128 + 64 * eh + r32; sp[0] = acc0[r] * rn; sp[32] = acc1[r] * rn; }
    __syncthreads();
#pragma unroll
    for (int i = 0; i < 4; ++i) { const int idx = i * 512 + tid, row = idx >> 4, c = idx & 15;
        const f32x4 y0 = *(const LAS f32x4*)(stage + row * 128 + c * 8), y1 = *(const LAS f32x4*)(stage + row * 128 + c * 8 + 4); const v4u g = gt[i];
        v4u w; w.x = pk2(y0.x * bfl(g.x), y0.y * bfh(g.x)); w.y = pk2(y0.z * bfl(g.y), y0.w * bfh(g.y)); w.z = pk2(y1.x * bfl(g.z), y1.y * bfh(g.z)); w.w = pk2(y1.z * bfl(g.w), y1.w * bfh(g.w));
        *(GAS v4u*)(OUT + (size_t)(rowbase + row) * opitch + ocol + 128 * h + c * 8) = w; }
    __syncthreads();
  }
 }
}
}

struct Args { const float* in[22]; float* out; unsigned char* ws; };
#ifndef TWICE
#define TWICE 0
#endif
#ifndef TWICE_N
#define TWICE_N 2
#endif
__device__ __forceinline__ unsigned char* arg_ptr(int i) { asm volatile("" : "+s"(i)); return ((unsigned char* const*)__builtin_amdgcn_kernarg_segment_ptr())[i]; }
__device__ __forceinline__ const float* arg_in(int i) { return (const float*)arg_ptr(i); }
__device__ __forceinline__ int opaque_i(int v) { asm volatile("" : "+s"(v)); return v; }
#if TWICE
#define REP_BEGIN(k) _Pragma("nounroll") for (int rep_ = 0, reps_ = opaque_i(TWICE == (k) ? TWICE_N : 1); rep_ < ((TWICE == (k)) ? reps_ : 1); ++rep_) {
#define REP_END() }
#else
#define REP_BEGIN(k) {
#define REP_END() }
#endif
__device__ __forceinline__ void skew_delay(int vcu, int ticks) { const unsigned long long t0 = __builtin_amdgcn_s_memrealtime(), w = (unsigned long long)((vcu & 3) * ticks);
    while (__builtin_amdgcn_s_memrealtime() - t0 < w) __builtin_amdgcn_s_sleep(8); }
#ifndef P8_SKEW_TICKS
#define P8_SKEW_TICKS 0
#endif
#ifndef SKEW_TICKS
#define SKEW_TICKS 0
#endif
#define REFRESH_LANE() do { int t_ = threadIdx.x; asm volatile("" : "+v"(t_)); F.tid = t_; F.lane = t_ & 63; } while (0)
__global__ void __launch_bounds__(NWAVES * 64, 2) layer_fwd(Args) {
    extern __shared__ __attribute__((aligned(16))) unsigned char lds[];
    Frame F;
    F.lds = (LAS unsigned char*)lds;
    F.MISC = (volatile LAS unsigned*)(F.lds + MISC_OFF);
    F.tid = threadIdx.x; F.lane = F.tid & 63; F.wave = __builtin_amdgcn_readfirstlane(F.tid >> 6);
    F.G = gridDim.x; { const int bx = blockIdx.x; F.vcu = (F.G % 8 == 0) ? (bx % 8) * (F.G / 8) + bx / 8 : bx; }
    F.ctl = (gu32*)(arg_ptr(23) + WS_CTL);
    for (int u = F.tid; u < (LDS_BYTES - LDSCTL_OFF) / 4; u += NWAVES * 64) ((LAS unsigned*)(F.lds + LDSCTL_OFF))[u] = 0u;
    __syncthreads();
#if BAR_MODE == 1
    XcdBarrier bar = xcd_barrier_post((unsigned*)(F.ctl + CW_BAR), F.MISC + 8);
#elif BAR_MODE == 3
    XcdBarrier bar = xcd_barrier_post((unsigned*)(F.ctl + CW_BAR), F.MISC + 8);
    if (gridDim.y == 0x7fffu) cg::this_grid().sync();
#elif BAR_MODE == 2
    if (blockIdx.x == 0) for (int i = F.tid; i < XCD_BAR_WORDS; i += NWAVES * 64) __hip_atomic_store((unsigned*)(F.ctl + CW_BAR) + i, 0u, __ATOMIC_RELAXED, __HIP_MEMORY_SCOPE_AGENT);
    XcdBarrier bar; bar.bar = (unsigned*)(F.ctl + CW_BAR); bar.x = 0; bar.st = F.MISC + 8;
    { const int id = (int)blockIdx.x * (NWAVES * 64) + F.tid;
      if (id < 5 * 128) __hip_atomic_store((unsigned*)(F.ctl + CW_SEAM) + (id >> 7) * SEAM_BANK + 64 * (id & 127), 0u, __ATOMIC_RELAXED, __HIP_MEMORY_SCOPE_AGENT);
      if (id == 0) __hip_atomic_store((unsigned*)(F.ctl + CW_TMO), 0u, __ATOMIC_RELAXED, __HIP_MEMORY_SCOPE_AGENT);
    }
#endif
#if BAR_MODE == 0
#define GRID_BAR() do { cg::this_grid().sync(); REFRESH_LANE(); } while (0)
#define GRID_BAR0() GRID_BAR()
#elif BAR_MODE == 1
#define GRID_BAR() do { xcd_barrier(bar); REFRESH_LANE(); } while (0)
#define GRID_BAR0() GRID_BAR()
#elif BAR_MODE == 3
#define GRID_BAR() do { xcd_barrier(bar); REFRESH_LANE(); } while (0)
#define GRID_BAR0() GRID_BAR()
#else
#ifndef XBAR_FLAT
#define XBAR_FLAT 0
#endif
#if XBAR_FLAT
#define GRID_BAR() do { xcd_barrier_flat(bar); REFRESH_LANE(); } while (0)
#else
#define GRID_BAR() do { xcd_barrier(bar); REFRESH_LANE(); } while (0)
#endif
#define GRID_BAR0() do { cg::this_grid().sync(); bar = xcd_barrier_post((unsigned*)(F.ctl + CW_BAR), F.MISC + 8); REFRESH_LANE(); } while (0)
#endif

#define P_x    (arg_in(0))
#define P_out  ((float*)arg_ptr(22))
#define P_CS   ((float*)(arg_ptr(23) + WS_CS))
#define P_WIN  ((bf16*)(arg_ptr(23) + WS_WIN))
#define P_WAP  ((bf16*)(arg_ptr(23) + WS_WAP))
#define P_WOUT ((bf16*)(arg_ptr(23) + WS_WOUT))
#define P_WGU  ((bf16*)(arg_ptr(23) + WS_WGU))
#define P_WD   ((bf16*)(arg_ptr(23) + WS_WD))
#define P_XN   ((bf16*)(arg_ptr(23) + WS_XN))
#define P_Y    ((bf16*)(arg_ptr(23) + WS_Y))
#define P_H    ((bf16*)(arg_ptr(23) + WS_H))
#define P_ZQ   ((bf16*)(arg_ptr(23) + WS_ZQ))
#define P_ZR   ((bf16*)(arg_ptr(23) + WS_ZR))
#define P_ZG   ((bf16*)(arg_ptr(23) + WS_ZG))
#define P_AO   ((bf16*)arg_ptr(22))
#define P_TT   ((float*)(arg_ptr(23) + WS_KVT))
#define P_PT   ((bf16*)(arg_ptr(22) + 32 * MiB))
#define P_ACAT ((bf16*)(arg_ptr(22) + 64 * MiB))
#define P_MG   ((bf16*)(arg_ptr(23) + WS_MG))
#define P_RS   ((float*)(arg_ptr(23) + WS_RS))
    LAS float* scr = (LAS float*)(F.lds + RING_OFF + F.wave * 16384);
    const int gw = F.vcu * NWAVES + F.wave, NGW = F.G * NWAVES;

#ifndef PROBE
#define PROBE 0
#endif

#define PROBE_DUMP(buf, ld, c0) do { for (int m_ = gw; m_ < M; m_ += NGW) { const bf16* s_ = (buf) + (size_t)m_ * (ld) + (c0); float* o_ = P_out + (size_t)m_ * D; \
        for (int c_ = F.lane; c_ < D; c_ += 64) o_[c_] = __uint_as_float((unsigned)s_[c_] << 16); } return; } while (0)
    {
        constexpr int I_GU = (D / 64) * (FF / 32), I_DN = (FF / 64) * (D / 32), I_IN = (D / 64) * (DIN / 32), I_PJ = (512 / 64) * (D / 32), I_O = (D / 64) * (D / 32);
        constexpr int NITEMS = 2 * I_GU + I_DN + I_IN + 2 * I_PJ + I_O;
        REP_BEGIN(101)
        for (int it = gw; it < NITEMS; it += NGW) {
            int r = it;
            if (r < I_GU) { transpose_item(arg_in(2), D, FF, P_WGU, 1, scr, r, F.lane, 0, 0, arg_in(1), -1.4426950408889634f); continue; } r -= I_GU;
            if (r < I_GU) { transpose_item(arg_in(3), D, FF, P_WGU, 2, scr, r, F.lane, 0, 0, arg_in(1), -0.6931471805599453f); continue; } r -= I_GU;
            if (r < I_DN) { transpose_item(arg_in(4), FF, D, P_WD, 0, scr, r, F.lane); continue; } r -= I_DN;
            if (r < I_IN) { transpose_item(arg_in(7), D, DIN, P_WIN, 3, scr, r, F.lane, 0, 0, arg_in(6)); continue; } r -= I_IN;
            if (r < I_PJ) { transpose_item(arg_in(13), 512, D, P_WAP, 0, scr, r, F.lane, 1024, 0); continue; } r -= I_PJ;
            if (r < I_PJ) { transpose_item(arg_in(14), 512, D, P_WAP, 0, scr, r, F.lane, 1024, 512); continue; } r -= I_PJ;
            transpose_item(arg_in(15), D, D, P_WOUT, 0, scr, r, F.lane);
        }
        REP_END()
        REP_BEGIN(102)
        for (int idx = F.vcu * (NWAVES * 64) + F.tid; idx < T * 64; idx += F.G * NWAVES * 64) {
            const int t = idx >> 6, i = idx & 63;
            const float e = (i == 63) ? 1.0f : (float)i * (1.0f / 63.0f);
            const float ang = (float)t * (1.0f / powf(10000.0f, e));
            P_CS[2 * idx] = cosf(ang); P_CS[2 * idx + 1] = sinf(ang);
        }
        REP_END()
        REP_BEGIN(103)
        row_phase<false, false, false, true>(F, P_x, nullptr, nullptr, nullptr, nullptr, 0.f, nullptr, P_XN, P_RS);
        REP_END()
    }
    GRID_BAR0();

#define FUSED_GEMM(TWO_, A_, Bt_, K_, base_, out_, xn_, gpost_, gnext_, scale_, inst_) do { \
        _Pragma("nounroll") for (int half_ = 0; half_ < 2; ++half_) { const size_t r0_ = (size_t)half_ * (M / 2); \
            pg8::Gemm g{(A_) + r0_ * (K_), (Bt_), M / 2, D, (K_)}; pg8::StaticOrder S; S.init(M / 2, D, F.G, (int)blockIdx.x); \
            pg8::PanelSumsq st1_{(float*)(arg_ptr(23) + WS_XB + (size_t)(inst_) * XB_BYTES) + r0_ * 4, (unsigned*)(F.ctl + CW_SEAM) + (inst_) * SEAM_BANK + 64 * 64 * half_, (unsigned*)(F.ctl + CW_TMO), 1e-6f}; \
            pg8::PanelSumsq st2_{(float*)(arg_ptr(23) + WS_XB + (size_t)((inst_) + 1) * XB_BYTES) + r0_ * 4, (unsigned*)(F.ctl + CW_SEAM) + ((inst_) + 1) * SEAM_BANK + 64 * 64 * half_, (unsigned*)(F.ctl + CW_TMO), 1e-6f}; \
            pg8::EpiRmsRes<TWO_> E{(base_) + r0_ * D, (out_) + r0_ * D, (xn_) ? (xn_) + r0_ * D : nullptr, D, (gpost_), (gnext_), (scale_), st1_, st2_}; \
            pg8::gemm_phase<pg8::EpiRmsRes<TWO_>, pg8::StaticOrder, false, PG8_SP2>(F.lds + RING_OFF, g, S, E); } } while (0)
    REP_BEGIN(1)
    if (SKEW_TICKS) skew_delay(F.vcu, SKEW_TICKS);
    { pg8::Gemm g{P_XN, P_WGU, M, 2 * FF, D}; pg8::StaticOrder S; S.init(M, 2 * FF, F.G, (int)blockIdx.x);
#if TWICE == 1 && defined(TWICE_NULL_EPI)
      pg8::EpiSwiglu E{P_H, FF, rep_};
#else
      pg8::EpiSwiglu E{P_H, FF, 0};
#endif
      pg8::gemm_phase<pg8::EpiSwiglu, pg8::StaticOrder, PG8_ALIGN, PG8_SP2>(F.lds + RING_OFF, g, S, E); }
    GRID_BAR();
    REP_END()
    REP_BEGIN(2)
    { pg8::Gemm g{P_H, P_WD, M, D, FF, 1}; pg8::StaticOrder S; S.init(M, D, F.G, (int)blockIdx.x);
      pg8::EpiBf16<0> E{P_Y, D, nullptr, 0, 0, 1.f};
      pg8::gemm_phase<pg8::EpiBf16<0>, pg8::StaticOrder, PG8_ALIGN, PG8_SP2>(F.lds + RING_OFF, g, S, E); }
    GRID_BAR();
    REP_END()
    REP_BEGIN(3)
    row_phase<true, true, false, true>(F, nullptr, P_XN, P_RS, P_Y, arg_in(5), 0.5f, nullptr, P_XN, P_RS);
    GRID_BAR();
    REP_END()
#ifdef EXTRA_BARS
    for (int eb_ = 0; eb_ < EXTRA_BARS; ++eb_) GRID_BAR();
#endif
    REP_BEGIN(4)
    if (SKEW_TICKS) skew_delay(F.vcu, SKEW_TICKS);
    { pg8::Gemm g{P_XN, P_WIN, M, DIN, D}; pg8::StaticOrder S; S.init(M, DIN, F.G, (int)blockIdx.x);
      pg8::EpiWin E{P_ZQ, P_ZR, P_ZG, P_CS, attn_body::C2};
      pg8::gemm_phase<pg8::EpiWin, pg8::StaticOrder, PG8_ALIGN, PG8_SP2>(F.lds + RING_OFF, g, S, E); }
    GRID_BAR();
    REP_END()
#if PROBE == 40
    PROBE_DUMP(P_ZQ, 1536, 0);
#elif PROBE == 41
    PROBE_DUMP(P_ZR, 2048, 0);
#elif PROBE == 42
    PROBE_DUMP(P_ZR, 2048, 1024);
#elif PROBE == 43
    PROBE_DUMP(P_ZG, 2048, 0);
#endif
    REP_BEGIN(5)
    {
        REP_BEGIN(51)
        ret::r1_phase(F.lds + RING_OFF, P_ZR, P_PT, P_TT, F.vcu, F.G, F.wave, F.lane);
        REP_END()
        REP_BEGIN(52)
        const float s1_ = wave_sum(arg_in(8)[F.lane] * arg_in(9)[F.lane]), s2_ = wave_sum(arg_in(10)[F.lane] * arg_in(11)[F.lane]);
        const attn_body::AttnTensors AT{(const attn_body::bf16*)P_ZQ, (attn_body::bf16*)P_AO, (attn_body::bf16*)P_ACAT, expf(s1_) - expf(s2_) + 0.2f, 0.8f, arg_in(12)};
        const attn_body::StaticOrder S((int)F.G, (int)blockIdx.x);
        attn_body::attn_phase<attn_body::StaticOrder>((char*)lds + RING_OFF, AT, S);
        REP_END()
    }
    GRID_BAR();
    REP_END()
#if PROBE == 5
    PROBE_DUMP(P_AO, 1024, 0);
#endif
    REP_BEGIN(7)
    ret::r3_phase(F.lds + RING_OFF, P_ZR, P_PT, P_TT, P_ACAT, 1024, 512, F.vcu, F.G, F.wave, F.lane);
    GRID_BAR();
    REP_END()
#if PROBE == 7
    PROBE_DUMP(P_ACAT, 1024, 0);
#endif
    REP_BEGIN(8)
    if (P8_SKEW_TICKS) skew_delay(F.vcu, P8_SKEW_TICKS);
    { pg8::Gemm g{P_ACAT, P_WAP, M, D, D}; pg8::StaticOrder S; S.init(M, D, F.G, (int)blockIdx.x);
      pg8::EpiGateCat E{P_MG, D, P_ZG, 2048};
      pg8::gemm_phase<pg8::EpiGateCat, pg8::StaticOrder, PG8_ALIGN, PG8_SP2>(F.lds + RING_OFF, g, S, E); }
    GRID_BAR();
    REP_END()
#if PROBE == 8
    PROBE_DUMP(P_MG, 1024, 0);
#endif
    REP_BEGIN(9)
    { pg8::Gemm g{P_MG, P_WOUT, M, D, D}; pg8::StaticOrder S; S.init(M, D, F.G, (int)blockIdx.x);
      pg8::EpiBf16<0> E{P_Y, D, nullptr, 0, 0, 1.f};
      pg8::gemm_phase<pg8::EpiBf16<0>, pg8::StaticOrder, PG8_ALIGN, PG8_SP2>(F.lds + RING_OFF, g, S, E); }
    GRID_BAR();
    REP_END()
    {
        constexpr int I_GU = (D / 64) * (FF / 32), I_DN = (FF / 64) * (D / 32);
        for (int it = gw; it < 2 * I_GU + I_DN; it += NGW) {
            int r = it;
            if (r < I_GU) { transpose_item(arg_in(18), D, FF, P_WGU, 1, scr, r, F.lane, 0, 0, arg_in(17), -1.4426950408889634f); continue; } r -= I_GU;
            if (r < I_GU) { transpose_item(arg_in(19), D, FF, P_WGU, 2, scr, r, F.lane, 0, 0, arg_in(17), -0.6931471805599453f); continue; } r -= I_GU;
            transpose_item(arg_in(20), FF, D, P_WD, 0, scr, r, F.lane);
        }
        row_phase<true, true, false, true>(F, nullptr, P_XN, P_RS, P_Y, arg_in(16), 1.0f, nullptr, P_XN, P_RS);
    }
    GRID_BAR();
    if (SKEW_TICKS) skew_delay(F.vcu, SKEW_TICKS);
    { pg8::Gemm g{P_XN, P_WGU, M, 2 * FF, D}; pg8::StaticOrder S; S.init(M, 2 * FF, F.G, (int)blockIdx.x);
      pg8::EpiSwiglu E{P_H, FF, 0};
      pg8::gemm_phase<pg8::EpiSwiglu, pg8::StaticOrder, PG8_ALIGN, PG8_SP2>(F.lds + RING_OFF, g, S, E); }
    GRID_BAR();
    { pg8::Gemm g{P_H, P_WD, M, D, FF, 1}; pg8::StaticOrder S; S.init(M, D, F.G, (int)blockIdx.x);
      pg8::EpiBf16<0> E{P_Y, D, nullptr, 0, 0, 1.f};
      pg8::gemm_phase<pg8::EpiBf16<0>, pg8::StaticOrder, PG8_ALIGN, PG8_SP2>(F.lds + RING_OFF, g, S, E); }
    GRID_BAR();
    row_phase<true, true, true, false>(F, nullptr, P_XN, P_RS, P_Y, arg_in(21), 0.5f, P_out, nullptr, nullptr);
#if BAR_MODE != 0
    if ((__hip_atomic_load((unsigned*)(F.ctl + CW_BAR) + XB_TMO, __ATOMIC_RELAXED, __HIP_MEMORY_SCOPE_AGENT) | __hip_atomic_load((unsigned*)(F.ctl + CW_TMO), __ATOMIC_RELAXED, __HIP_MEMORY_SCOPE_AGENT)) != 0u) {
        const float qn = __builtin_nanf(""); for (int m = gw; m < M; m += NGW) P_out[(size_t)m * D + F.lane] = qn; }
#endif
#undef GRID_BAR
}

extern "C" void kernel_launch(void* const* d_in, const int* in_sizes, int n_in, void* d_out, int out_size, void* d_ws, size_t ws_size, hipStream_t stream) {
    static int grid = 0;
    if (grid == 0) {
        if (n_in != 22 || in_sizes[0] != M * D || out_size != M * D || ws_size < WS_END) { fprintf(stderr, "kernel_launch: built for 22 inputs, x and out of %d floats, >= %zu bytes of workspace; got n_in %d, in0 %d, out %d, ws %zu; nothing launched\n", M * D, (size_t)WS_END, n_in, n_in > 0 ? in_sizes[0] : -1, out_size, ws_size); grid = -1; return; }
        int dev = 0, cus = 0, per_cu = 0;
        if (hipGetDevice(&dev) != hipSuccess || hipDeviceGetAttribute(&cus, hipDeviceAttributeMultiprocessorCount, dev) != hipSuccess) { fprintf(stderr, "kernel_launch: hipGetDevice / hipDeviceGetAttribute failed; nothing launched\n"); grid = -1; return; }
        if (hipFuncSetAttribute((const void*)layer_fwd, hipFuncAttributeMaxDynamicSharedMemorySize, LDS_BYTES) != hipSuccess) { fprintf(stderr, "kernel_launch: hipFuncSetAttribute failed; nothing launched\n"); grid = -1; return; }
        if (hipOccupancyMaxActiveBlocksPerMultiprocessor(&per_cu, (const void*)layer_fwd, NWAVES * 64, LDS_BYTES) != hipSuccess || per_cu < 1)
            fprintf(stderr, "kernel_launch: note: the occupancy query reports %d workgroups per CU\n", per_cu);
        (void)hipGetLastError();
        grid = cus * (per_cu < 1 ? 1 : per_cu); if (grid > 256) grid = 256; grid &= ~7;
        if (grid < 8) { fprintf(stderr, "kernel_launch: needs at least 8 co-resident workgroups; the occupancy query gives %d x %d; nothing launched\n", cus, per_cu); grid = -1; return; }
    }
    if (grid < 0) return;
#if BAR_MODE == 3
    if (hipMemsetAsync((char*)d_ws + WS_CTL, 0, CTL_ZERO_BYTES, stream) != hipSuccess) { fprintf(stderr, "kernel_launch: hipMemsetAsync of the control words failed; nothing launched\n"); return; }
#endif
    Args a{};
    for (int i = 0; i < 22; ++i) a.in[i] = (const float*)d_in[i];
    a.out = (float*)d_out; a.ws = (unsigned char*)d_ws;
    void* kargs[] = {&a};
    const hipError_t le = hipLaunchCooperativeKernel((const void*)layer_fwd, dim3(grid), dim3(NWAVES * 64), kargs, LDS_BYTES, stream);
    if (le != hipSuccess) fprintf(stderr, "kernel_launch: launch failed: %s (grid %d x %d threads, %d B LDS)\n", hipGetErrorName(le), grid, NWAVES * 64, LDS_BYTES);
}
```

```cpp
#define BAR_MODE 2
#include <hip/hip_runtime.h>
#include <hip/hip_bf16.h>
#include <hip/hip_cooperative_groups.h>
namespace cg = cooperative_groups;
#ifndef BAR_MODE
#define BAR_MODE 0
#endif
#include <cstdio>
#include <cstdint>
#include <cmath>
namespace pg8 {
#define PG8_LAS __attribute__((address_space(3)))
typedef unsigned short bf16_t;
typedef short bf16x8 __attribute__((ext_vector_type(8)));
typedef float f32x4 __attribute__((ext_vector_type(4)));
typedef unsigned u32x4 __attribute__((ext_vector_type(4)));
constexpr int BM = 256, BK = 64, HALF = 128, HTB = HALF * BK * 2  , STAGE_BYTES = 8 * HTB, NXCD = 8, WGM = 4;

__host__ __device__ __forceinline__ int lds_byte(int r, int c) { const int st = (r >> 4) * 2 + (c >> 5), rr = r & 15, cc = c & 31, ob = rr * 64 + cc * 2; return st * 1024 + (ob ^ (((ob >> 9) & 1) << 5)); }
__host__ __device__ __forceinline__ void stage_rc(int b, int& R, int& C) { const int st = b / 1024, sb = b % 1024, swz = sb ^ (((sb >> 9) & 1) << 5); R = (st >> 1) * 16 + swz / 64; C = (st & 1) * 32 + (swz % 64) / 2; }
__host__ __device__ __forceinline__ int perm32(int rho) { const int n = rho >> 4, i = rho & 15; return 8 * (i >> 2) + 4 * n + (i & 3); }

struct Unit { int pm, pn; };
struct Gemm { const bf16_t* A; const bf16_t* Bt; int M, N, K; int a_tiled = 0; };

struct StaticOrder {
    int nM, nN, nwg, G, c;
    __host__ __device__ void init(int M, int N, int G_, int c_) { nM = M / BM; nN = N / BM; nwg = nM * nN; G = G_; c = c_; }
    __host__ __device__ bool next(int i, Unit& u) const {
        const long L = (long)i * G + c; if (L >= nwg) return false;
        int wgid = (int)L; { const int q = nwg / NXCD, r = nwg % NXCD, xcd = wgid % NXCD, off = wgid / NXCD; wgid = (xcd < r ? xcd * (q + 1) : r * (q + 1) + (xcd - r) * q) + off; }
        const int nig = WGM * nN, gid = wgid / nig, fm = gid * WGM, gsz = (nM - fm) < WGM ? (nM - fm) : WGM;
        u.pm = fm + ((wgid % nig) % gsz); u.pn = (wgid % nig) / gsz; return true;
    }
    __device__ __forceinline__ void a_ready(const Unit&) const {}
    __device__ __forceinline__ void done(const Unit&) const {}
};

__device__ __forceinline__ unsigned cvt_pk_bf16(float lo, float hi) { unsigned r; asm volatile("v_cvt_pk_bf16_f32 %0, %1, %2" : "=v"(r) : "v"(lo), "v"(hi)); return r; }
typedef float f32x2 __attribute__((ext_vector_type(2)));
__device__ __forceinline__ f32x2 gelu_pk(f32x2 v) {
    const f32x2 av = __builtin_elementwise_abs(v), d = av * 0.2316418882f + 1.0f;
    f32x2 t; t.x = __builtin_amdgcn_rcpf(d.x); t.y = __builtin_amdgcn_rcpf(d.y);
    f32x2 q = t * 0.5307027145f + (-0.7265760135f); q = q * t + 0.7107068705f; q = q * t + (-0.142248368f); q = q * t + 0.127414796f; q = q * t;
    const f32x2 s = (v * v) * (-0.72134752044f);
    f32x2 e; e.x = __builtin_amdgcn_exp2f(s.x); e.y = __builtin_amdgcn_exp2f(s.y);
    const f32x2 m = v * (q * e), r = v - m;
    f32x2 o; o.x = v.x < 0.f ? m.x : r.x; o.y = v.y < 0.f ? m.y : r.y; return o;
}

template <int ACT  > struct EpiBf16 {
    static constexpr bool PERM = true, AFTER_DRAIN = false; static constexpr int MID_T = -1; static_assert(ACT == 0 || ACT == 1, "EpiBf16: ACT is 0 (none) or 1 (gelu_pk)");
    bf16_t* O; int ldc; const float* bias; int split_cols; size_t split_stride; float scale0;
    __device__ __forceinline__ void operator()(const f32x4 (&acc)[2][2][4][2], const Unit& u, int wr, int wc, int fr, int fq) const {
        const int row0 = u.pm * BM + wr * 64 + fr; int colt = u.pn * BM; bf16_t* base = O;
        float sc = 1.f; if (split_cols) { const int t = colt / split_cols; base += (size_t)t * split_stride; colt -= t * split_cols; if (t == 0) sc = scale0; }
        const int col0 = colt + wc * 32 + 8 * fq, bcol0 = u.pn * BM + wc * 32 + 8 * fq;
        f32x4 bv[2][2];
#pragma unroll
        for (int bj = 0; bj < 2; ++bj)
#pragma unroll
            for (int n = 0; n < 2; ++n) bv[bj][n] = bias ? *(const f32x4*)(bias + bcol0 + bj * HALF + 4 * n) : (f32x4){0.f, 0.f, 0.f, 0.f};
#pragma unroll
        for (int ai = 0; ai < 2; ++ai)
#pragma unroll
            for (int m = 0; m < 4; ++m) { bf16_t* rowp = base + (size_t)(row0 + ai * HALF + m * 16) * ldc + col0;
#pragma unroll
                for (int bj = 0; bj < 2; ++bj) { f32x4 v0 = acc[ai][bj][m][0] + bv[bj][0], v1 = acc[ai][bj][m][1] + bv[bj][1];
                    if (ACT == 1) { f32x2 a = gelu_pk((f32x2){v0[0], v0[1]}), b = gelu_pk((f32x2){v0[2], v0[3]}), c = gelu_pk((f32x2){v1[0], v1[1]}), d = gelu_pk((f32x2){v1[2], v1[3]});
                        v0 = (f32x4){a.x, a.y, b.x, b.y}; v1 = (f32x4){c.x, c.y, d.x, d.y}; }
                    v0 = v0 * sc; v1 = v1 * sc; u32x4 w; w.x = cvt_pk_bf16(v0[0], v0[1]); w.y = cvt_pk_bf16(v0[2], v0[3]); w.z = cvt_pk_bf16(v1[0], v1[1]); w.w = cvt_pk_bf16(v1[2], v1[3]);
                    __builtin_nontemporal_store(w, (u32x4*)(rowp + bj * HALF)); } }
    }
};

template <class Epi, class Sched, bool ALIGN_EPI = false, bool SP2 = false>
__device__ __forceinline__ void gemm_phase(PG8_LAS unsigned char* lds, const Gemm g, const Sched& S, const Epi& E) {
    int tid_ = threadIdx.x; asm volatile("" : "+v"(tid_));
    const int tid = tid_, wid = __builtin_amdgcn_readfirstlane(tid >> 6), lane = tid & 63, wr = wid >> 2, wc = wid & 3, fr = lane & 15, fq = lane >> 4;
    const int K = g.K, nt = K / BK;
    unsigned voffA[2], voffB[2];
#pragma unroll
    for (int i = 0; i < 2; ++i) { int R, C; stage_rc(tid * 16 + i * 8192, R, C); const int Rb = Epi::PERM ? ((R & ~31) + perm32(R & 31)) : R;
        voffA[i] = g.a_tiled ? (unsigned)(R * BK + C) * 2u : (unsigned)(R * K + C) * 2u; voffB[i] = (unsigned)(Rb * K + C) * 2u; }
    const size_t kstep = (size_t)(BK * 2);
    const size_t hstep = (size_t)HALF * K * 2;
    const size_t tstep = 2 * hstep;
    const size_t kstepA = g.a_tiled ? (size_t)BM * BK * 2 : kstep, hstepA = g.a_tiled ? (size_t)HALF * BK * 2 : hstep, tstepA = g.a_tiled ? (size_t)nt * BM * BK * 2 : tstep;
    const unsigned ldsw = (unsigned)wid * 1024u;
    const int aoff = lds_byte(wr * 64 + fr, fq * 8), boff = lds_byte(wc * 32 + fr, fq * 8);
#define PG8_SA(b, h) (((b) * 2 + (h)) * HTB)
#define PG8_SB(b, h) ((4 + (b) * 2 + (h)) * HTB)
#define PG8_STAGE(bufoff, gbase, voff) do { _Pragma("unroll") for (int _i = 0; _i < 2; ++_i) \
        __builtin_amdgcn_global_load_lds((const unsigned*)((const char*)(gbase) + (voff)[_i]), (PG8_LAS unsigned*)(lds + (bufoff) + ldsw + _i * 8192), 16, 0, 0); } while (0)
#define PG8_LDA(dst, b, h) do { _Pragma("unroll") for (int m = 0; m < 4; ++m) _Pragma("unroll") for (int k = 0; k < 2; ++k) dst[m][k] = *(const PG8_LAS bf16x8*)(lds + PG8_SA(b, h) + aoff + m * 2048 + k * 1024); } while (0)
#define PG8_LDB(dst, b, h) do { _Pragma("unroll") for (int n = 0; n < 2; ++n) _Pragma("unroll") for (int k = 0; k < 2; ++k) dst[n][k] = *(const PG8_LAS bf16x8*)(lds + PG8_SB(b, h) + boff + n * 2048 + k * 1024); } while (0)
#define PG8_MMA(ai, bj, At, Bt) do { __builtin_amdgcn_s_setprio(1); _Pragma("unroll") for (int m = 0; m < 4; ++m) _Pragma("unroll") for (int n = 0; n < 2; ++n) _Pragma("unroll") for (int k = 0; k < 2; ++k) \
        acc[ai][bj][m][n] = __builtin_amdgcn_mfma_f32_16x16x32_bf16(Bt[n][k], At[m][k], acc[ai][bj][m][n], 0, 0, 0); __builtin_amdgcn_s_setprio(0); } while (0)
#define PG8_WAIT_V(n) asm volatile("s_waitcnt vmcnt(" #n ")" ::: "memory")
#define PG8_WAIT_L(n) asm volatile("s_waitcnt lgkmcnt(" #n ")" ::: "memory")
#define PG8_BAR __builtin_amdgcn_s_barrier()
#define PG8_SCHED __builtin_amdgcn_sched_barrier(0)
    Unit cur, nxt; int ui = 0;
    if (!S.next(0, cur)) return;
    f32x4 acc[2][2][4][2];
#pragma unroll
    for (int a = 0; a < 2; ++a)
#pragma unroll
        for (int b = 0; b < 2; ++b)
#pragma unroll
            for (int m = 0; m < 4; ++m)
#pragma unroll
                for (int n = 0; n < 2; ++n) acc[a][b][m][n] = (f32x4){0.f, 0.f, 0.f, 0.f};
    bf16x8 At[4][2], B0[2][2], B1[2][2];
    const char* cA = (const char*)g.A + (size_t)cur.pm * tstepA; const char* cB = (const char*)g.Bt + (size_t)cur.pn * tstep;
    S.a_ready(cur);
    if constexpr (SP2) {
        PG8_STAGE(PG8_SB(0, 0), cB, voffB); PG8_STAGE(PG8_SB(0, 1), cB + hstep, voffB); PG8_STAGE(PG8_SA(0, 0), cA, voffA); PG8_STAGE(PG8_SA(0, 1), cA + hstepA, voffA);
        if (wr == 1) PG8_BAR;
        PG8_WAIT_V(2); PG8_BAR;
        PG8_STAGE(PG8_SB(1, 0), cB + kstep, voffB); PG8_STAGE(PG8_SA(1, 0), cA + kstepA, voffA); PG8_STAGE(PG8_SB(1, 1), cB + hstep + kstep, voffB);
        PG8_WAIT_V(6); PG8_BAR;
    } else {
        PG8_STAGE(PG8_SB(0, 0), cB, voffB); PG8_STAGE(PG8_SA(0, 0), cA, voffA); PG8_STAGE(PG8_SB(0, 1), cB + hstep, voffB); PG8_STAGE(PG8_SA(0, 1), cA + hstepA, voffA);
        if (wr == 1) PG8_BAR;
        PG8_WAIT_V(4); PG8_BAR;
        PG8_STAGE(PG8_SB(1, 0), cB + kstep, voffB); PG8_STAGE(PG8_SA(1, 0), cA + kstepA, voffA); PG8_STAGE(PG8_SB(1, 1), cB + hstep + kstep, voffB);
        PG8_WAIT_V(6); PG8_BAR;
    }
    for (;;) {
        const bool has_next = S.next(ui + 1, nxt);
        const char* nA = has_next ? (const char*)g.A + (size_t)nxt.pm * tstepA : cA; const char* nB = has_next ? (const char*)g.Bt + (size_t)nxt.pn * tstep : cB;
        for (int t = 0; t < nt; t += 2) {
            const bool last = (t == nt - 2);
            if constexpr (Epi::MID_T >= 0) { if (t == Epi::MID_T) E.mid(acc, cur, wr, wc, fr, fq); }
            const char* a1 = cA + (size_t)(t + 1) * kstepA;
            const char* a2 = last ? nA : cA + (size_t)(t + 2) * kstepA; const char* b2 = last ? nB : cB + (size_t)(t + 2) * kstep;
            const char* a3 = a2 + kstepA; const char* b3 = b2 + kstep;
            if (last && has_next) S.a_ready(nxt);
            if constexpr (SP2) {
            PG8_LDB(B0, 0, 0); PG8_LDB(B1, 0, 1); PG8_SCHED; PG8_LDA(At, 0, 0); PG8_STAGE(PG8_SA(1, 1), a1 + hstepA, voffA);
            PG8_WAIT_V(8); PG8_WAIT_L(0); PG8_BAR; PG8_MMA(0, 0, At, B0); PG8_MMA(0, 1, At, B1); PG8_BAR; PG8_SCHED;
            PG8_LDA(At, 0, 1); PG8_STAGE(PG8_SB(0, 0), b2, voffB); PG8_STAGE(PG8_SB(0, 1), b2 + hstep, voffB); PG8_STAGE(PG8_SA(0, 0), a2, voffA);
            PG8_WAIT_V(8); PG8_WAIT_L(0); PG8_BAR; PG8_MMA(1, 0, At, B0); PG8_MMA(1, 1, At, B1); PG8_BAR; PG8_SCHED;
            PG8_LDB(B0, 1, 0); PG8_LDB(B1, 1, 1); PG8_SCHED; PG8_LDA(At, 1, 0); PG8_STAGE(PG8_SA(0, 1), a2 + hstepA, voffA);
            PG8_WAIT_V(8); PG8_WAIT_L(0); PG8_BAR; PG8_MMA(0, 0, At, B0); PG8_MMA(0, 1, At, B1); PG8_BAR; PG8_SCHED;
            PG8_LDA(At, 1, 1); PG8_STAGE(PG8_SB(1, 0), b3, voffB); PG8_STAGE(PG8_SB(1, 1), b3 + hstep, voffB); PG8_STAGE(PG8_SA(1, 0), a3, voffA);
            PG8_WAIT_V(8); PG8_WAIT_L(0); PG8_BAR; PG8_MMA(1, 0, At, B0); PG8_MMA(1, 1, At, B1); PG8_BAR; PG8_SCHED;
            } else {
            PG8_LDB(B0, 0, 0); PG8_SCHED; PG8_LDA(At, 0, 0); PG8_STAGE(PG8_SA(1, 1), a1 + hstepA, voffA);
            PG8_WAIT_L(8); PG8_BAR; PG8_WAIT_L(0); PG8_MMA(0, 0, At, B0); PG8_BAR; PG8_SCHED;
            PG8_LDB(B1, 0, 1); PG8_STAGE(PG8_SB(0, 0), b2, voffB);
            PG8_BAR; PG8_WAIT_L(0); PG8_MMA(0, 1, At, B1); PG8_BAR;
            PG8_LDA(At, 0, 1); PG8_STAGE(PG8_SA(0, 0), a2, voffA);
            PG8_BAR; PG8_WAIT_L(0); PG8_MMA(1, 0, At, B0); PG8_BAR; PG8_SCHED;
            PG8_STAGE(PG8_SB(0, 1), b2 + hstep, voffB);
            PG8_WAIT_V(6); PG8_BAR; PG8_MMA(1, 1, At, B1); PG8_BAR;
            PG8_LDB(B0, 1, 0); PG8_SCHED; PG8_LDA(At, 1, 0); PG8_STAGE(PG8_SA(0, 1), a2 + hstepA, voffA);
            PG8_WAIT_L(8); PG8_BAR; PG8_WAIT_L(0); PG8_MMA(0, 0, At, B0); PG8_BAR; PG8_SCHED;
            PG8_LDB(B1, 1, 1); PG8_STAGE(PG8_SB(1, 0), b3, voffB);
            PG8_BAR; PG8_WAIT_L(0); PG8_MMA(0, 1, At, B1); PG8_BAR;
            PG8_LDA(At, 1, 1); PG8_STAGE(PG8_SA(1, 0), a3, voffA);
            PG8_BAR; PG8_WAIT_L(0); PG8_MMA(1, 0, At, B0); PG8_BAR; PG8_SCHED;
            PG8_STAGE(PG8_SB(1, 1), b3 + hstep, voffB);
            PG8_WAIT_V(6); PG8_BAR; PG8_MMA(1, 1, At, B1); PG8_BAR;
            }
        }
        if constexpr (ALIGN_EPI) { if (wr == 0) PG8_BAR; }
        if constexpr (!Epi::AFTER_DRAIN) { E(acc, cur, wr, wc, fr, fq); S.done(cur); }
        if (!has_next) break;
#pragma unroll
        for (int a = 0; a < 2; ++a)
#pragma unroll
            for (int b = 0; b < 2; ++b)
#pragma unroll
                for (int m = 0; m < 4; ++m)
#pragma unroll
                    for (int n = 0; n < 2; ++n) acc[a][b][m][n] = (f32x4){0.f, 0.f, 0.f, 0.f};
        cur = nxt; cA = nA; cB = nB; ++ui;
        if constexpr (ALIGN_EPI) { if (wr == 1) PG8_BAR; }
    }
    PG8_WAIT_V(0);
    if constexpr (!ALIGN_EPI) { if (wr == 0) PG8_BAR; }
    PG8_BAR;
    if constexpr (Epi::AFTER_DRAIN) { E.fused(acc, cur, wr, wc, fr, fq, lds, wid, lane); S.done(cur); }
#undef PG8_SA
#undef PG8_SB
#undef PG8_STAGE
#undef PG8_LDA
#undef PG8_LDB
#undef PG8_MMA
#undef PG8_WAIT_V
#undef PG8_WAIT_L
#undef PG8_BAR
#undef PG8_SCHED
}
}

#ifndef PG8_SP2
#define PG8_SP2 true
#endif
#ifndef PG8_ALIGN
#define PG8_ALIGN true
#endif
namespace pg8 {
__device__ __forceinline__ float bf_lo(unsigned w) { return __uint_as_float(w << 16); }
__device__ __forceinline__ float bf_hi(unsigned w) { return __uint_as_float(w & 0xffff0000u); }
__device__ __forceinline__ float sigmoid_f(float v) { return __builtin_amdgcn_rcpf(1.0f + __builtin_amdgcn_exp2f(-1.4426950408889634f * v)); }
__device__ __forceinline__ u32x4 pack8(const f32x4 v0, const f32x4 v1) { u32x4 w; w.x = cvt_pk_bf16(v0[0], v0[1]); w.y = cvt_pk_bf16(v0[2], v0[3]); w.z = cvt_pk_bf16(v1[0], v1[1]); w.w = cvt_pk_bf16(v1[2], v1[3]); return w; }

struct EpiSwiglu {
    static constexpr bool PERM = true, AFTER_DRAIN = false; static constexpr int MID_T = -1;
    bf16_t* H; int ldh; int skip;
    __device__ __forceinline__ void operator()(const f32x4 (&acc)[2][2][4][2], const Unit& u, int wr, int wc, int fr, int fq) const {
        if (skip) return;
        const int r0 = wr * 64 + fr, col0 = u.pn * HALF + wc * 32 + 8 * fq;
        bf16_t* tile = H + ((size_t)u.pm * (ldh / 64) + (col0 >> 6)) * (BM * 64) + (col0 & 63);
#pragma unroll
        for (int ai = 0; ai < 2; ++ai)
#pragma unroll
            for (int m = 0; m < 4; ++m) { bf16_t* rowp = tile + (size_t)(r0 + ai * HALF + m * 16) * 64;
                f32x4 h[2];
#pragma unroll
                for (int n = 0; n < 2; ++n)
#pragma unroll
                    for (int i = 0; i < 4; ++i) { const float g = acc[ai][0][m][n][i], up = acc[ai][1][m][n][i]; h[n][i] = (g * up) * __builtin_amdgcn_rcpf(1.0f + __builtin_amdgcn_exp2f(g)); }
                __builtin_nontemporal_store(pack8(h[0], h[1]), (u32x4*)rowp); }
    }
};

struct EpiWin {
    static constexpr bool PERM = true, AFTER_DRAIN = false; static constexpr int MID_T = -1;
    bf16_t *ZQ, *ZR, *ZG; const float* cs; float c2;
    __device__ __forceinline__ void operator()(const f32x4 (&acc)[2][2][4][2], const Unit& u, int wr, int wc, int fr, int fq) const {
        const int pn = u.pn, row0 = u.pm * BM + wr * 64 + fr;
        bf16_t* base; int ld, colt, mode;
        if (pn < 6) { base = ZQ; ld = 1536; colt = 256 * pn; mode = pn < 2 ? 1 : 0; }
        else if (pn < 14) { base = ZR; ld = 2048; colt = 256 * (pn - 6); mode = pn < 8 ? 2 : pn < 10 ? 3 : pn < 12 ? 0 : 4; }
        else { base = ZG; ld = 2048; colt = 256 * (pn - 14); mode = 5; }
        const int col0 = colt + wc * 32 + 8 * fq;
        if (mode == 2 || mode == 3) {
            f32x4 csv[2][4][2];
#pragma unroll
            for (int ai = 0; ai < 2; ++ai)
#pragma unroll
                for (int m = 0; m < 4; ++m) { const int t = (row0 + ai * HALF + m * 16) & 4095; const f32x4* cp = (const f32x4*)(cs + ((size_t)t * 64 + 16 * wc + 4 * fq) * 2); csv[ai][m][0] = cp[0]; csv[ai][m][1] = cp[1]; }
#pragma unroll
            for (int ai = 0; ai < 2; ++ai)
#pragma unroll
                for (int m = 0; m < 4; ++m) { const int row = row0 + ai * HALF + m * 16; bf16_t* rowp = base + (size_t)row * ld + col0; const int t = row & 4095;
                    const f32x4 cs0 = csv[ai][m][0], cs1 = csv[ai][m][1];
#pragma unroll
                    for (int bj = 0; bj < 2; ++bj) { const f32x4 v0 = acc[ai][bj][m][0], v1 = acc[ai][bj][m][1];
                        float sc = 1.f;
                        if (mode == 3) { const int h = 2 * (pn - 8) + bj; const float l2g = __builtin_log2f(1.0f - __builtin_exp2f(-5.0f - (float)h));
                            sc = 0.08838834764831845f * __builtin_exp2f(-(float)(t & 127) * l2g); }
                        f32x4 o0, o1;
                        o0[0] = (v0[0] * cs0[0] - v0[1] * cs0[1]) * sc; o0[1] = (v0[1] * cs0[0] + v0[0] * cs0[1]) * sc;
                        o0[2] = (v0[2] * cs0[2] - v0[3] * cs0[3]) * sc; o0[3] = (v0[3] * cs0[2] + v0[2] * cs0[3]) * sc;
                        o1[0] = (v1[0] * cs1[0] - v1[1] * cs1[1]) * sc; o1[1] = (v1[1] * cs1[0] + v1[0] * cs1[1]) * sc;
                        o1[2] = (v1[2] * cs1[2] - v1[3] * cs1[3]) * sc; o1[3] = (v1[3] * cs1[2] + v1[2] * cs1[3]) * sc;
                        __builtin_nontemporal_store(pack8(o0, o1), (u32x4*)(rowp + bj * HALF)); } }
            return;
        }
#pragma unroll
        for (int ai = 0; ai < 2; ++ai)
#pragma unroll
            for (int m = 0; m < 4; ++m) { const int row = row0 + ai * HALF + m * 16; bf16_t* rowp = base + (size_t)row * ld + col0;
#pragma unroll
                for (int bj = 0; bj < 2; ++bj) { f32x4 v0 = acc[ai][bj][m][0], v1 = acc[ai][bj][m][1];
                    if (mode == 1) { v0 = v0 * c2; v1 = v1 * c2; }
                    else if (mode == 4) {
#pragma unroll
                        for (int i = 0; i < 4; ++i) { v0[i] = v0[i] * sigmoid_f(v0[i]); v1[i] = v1[i] * sigmoid_f(v1[i]); } }
                    if (mode == 5) continue;
                    __builtin_nontemporal_store(pack8(v0, v1), (u32x4*)(rowp + bj * HALF)); }
                if (mode == 5) {
                    f32x4 r0, r1, s0, s1;
#pragma unroll
                    for (int i = 0; i < 4; ++i) { const float ea0 = __builtin_amdgcn_exp2f(acc[ai][0][m][0][i]); float er0 = __builtin_amdgcn_exp2f(acc[ai][1][m][0][i]);
                        const float ea1 = __builtin_amdgcn_exp2f(acc[ai][0][m][1][i]); float er1 = __builtin_amdgcn_exp2f(acc[ai][1][m][1][i]);
                        er0 = __builtin_fminf(er0, 1.0e18f); er1 = __builtin_fminf(er1, 1.0e18f);
                        s0[i] = __builtin_amdgcn_rcpf(1.0f + er0); s1[i] = __builtin_amdgcn_rcpf(1.0f + er1);
                        r0[i] = (1.0f + er0) * __builtin_amdgcn_rcpf(1.0f + ea0); r1[i] = (1.0f + er1) * __builtin_amdgcn_rcpf(1.0f + ea1); }
                    bf16_t* gp = ZG + (size_t)row * 2048 + 128 * (pn - 14) + wc * 32 + 8 * fq;
                    __builtin_nontemporal_store(pack8(r0, r1), (u32x4*)gp); __builtin_nontemporal_store(pack8(s0, s1), (u32x4*)(gp + 1024)); } }
    }
};

struct EpiGateCat {
    static constexpr bool PERM = true, AFTER_DRAIN = false; static constexpr int MID_T = 8;
    bf16_t* O; int ldo; const bf16_t* gate; int ldg;
    __device__ __forceinline__ void mid(f32x4 (&acc)[2][2][4][2], const Unit& u, int, int, int, int) const {
        int t_ = threadIdx.x; asm volatile("" : "+v"(t_));
        const int wid_ = t_ >> 6, wr = wid_ >> 2, wc = wid_ & 3, fr = t_ & 15, fq = (t_ & 63) >> 4;
        const int row0 = u.pm * BM + wr * 64 + fr, col0 = u.pn * BM + wc * 32 + 8 * fq;
#pragma unroll
        for (int ai = 0; ai < 2; ++ai) { u32x4 g[4][2];
#pragma unroll
            for (int m = 0; m < 4; ++m) { const bf16_t* gp = gate + (size_t)(row0 + ai * HALF + m * 16) * ldg + col0; g[m][0] = *(const u32x4*)gp; g[m][1] = *(const u32x4*)(gp + HALF); }
#pragma unroll
            for (int m = 0; m < 4; ++m)
#pragma unroll
                for (int bj = 0; bj < 2; ++bj) { const u32x4 a = g[m][bj]; f32x4& v0 = acc[ai][bj][m][0]; f32x4& v1 = acc[ai][bj][m][1];
                    v0[0] *= bf_lo(a.x); v0[1] *= bf_hi(a.x); v0[2] *= bf_lo(a.y); v0[3] *= bf_hi(a.y);
                    v1[0] *= bf_lo(a.z); v1[1] *= bf_hi(a.z); v1[2] *= bf_lo(a.w); v1[3] *= bf_hi(a.w); }
            asm volatile("" ::: "memory"); }
    }
    __device__ __forceinline__ void operator()(const f32x4 (&acc)[2][2][4][2], const Unit& u, int wr, int wc, int fr, int fq) const {
        const int row0 = u.pm * BM + wr * 64 + fr, col0 = u.pn * BM + wc * 32 + 8 * fq;
#pragma unroll
        for (int ai = 0; ai < 2; ++ai)
#pragma unroll
            for (int m = 0; m < 4; ++m) { const size_t row = (size_t)(row0 + ai * HALF + m * 16);
#pragma unroll
                for (int bj = 0; bj < 2; ++bj) { const int c = col0 + bj * HALF;
                    const u32x4 g = *(const u32x4*)(gate + row * ldg + 1024 + c);
                    f32x4 v0 = acc[ai][bj][m][0], v1 = acc[ai][bj][m][1];
                    v0[0] *= bf_lo(g.x); v0[1] *= bf_hi(g.x); v0[2] *= bf_lo(g.y); v0[3] *= bf_hi(g.y);
                    v1[0] *= bf_lo(g.z); v1[1] *= bf_hi(g.z); v1[2] *= bf_lo(g.w); v1[3] *= bf_hi(g.w);
                    *(u32x4*)(O + row * ldo + c) = pack8(v0, v1); } }
    }
};

struct PanelSumsq {
    float* xbuf;
    unsigned* cnt;
    unsigned* tmo;
    float eps;
    __device__ __forceinline__ bool run(const f32x4 (&v)[2][2][4][2], const Unit& u, int wr, int wc, int fr, int fq, PG8_LAS unsigned char* lds, int wid, int lane) const {
        PG8_LAS float* P = (PG8_LAS float*)lds;
        PG8_LAS float* S = (PG8_LAS float*)(lds + 8192);
        PG8_LAS unsigned* flag = (PG8_LAS unsigned*)(lds + 8192 + 2048);
#pragma unroll
        for (int ai = 0; ai < 2; ++ai)
#pragma unroll
            for (int m = 0; m < 4; ++m) {
                float q = 0.f;
#pragma unroll
                for (int bj = 0; bj < 2; ++bj)
#pragma unroll
                    for (int n = 0; n < 2; ++n) { const f32x4 x = v[ai][bj][m][n]; q += (x[0] * x[0] + x[1] * x[1]) + (x[2] * x[2] + x[3] * x[3]); }
                q += __shfl_xor(q, 16); q += __shfl_xor(q, 32);
                if (fq == 0) P[(ai * HALF + wr * 64 + m * 16 + fr) * 4 + wc] = q;
            }
        asm volatile("s_waitcnt lgkmcnt(0)" ::: "memory"); __builtin_amdgcn_s_barrier(); asm volatile("" ::: "memory");
        const int row = wid * 32 + (lane & 31);
        if (lane < 32) {
            const float t = (P[row * 4 + 0] + P[row * 4 + 1]) + (P[row * 4 + 2] + P[row * 4 + 3]);
            __hip_atomic_store((unsigned*)xbuf + ((size_t)(u.pm * BM + row) * 4 + u.pn), __float_as_uint(t), __ATOMIC_RELAXED, __HIP_MEMORY_SCOPE_AGENT);
        }
        asm volatile("s_waitcnt vmcnt(0)" ::: "memory");
        if (lane == 0) __hip_atomic_fetch_add(cnt + 64 * u.pm, 1u, __ATOMIC_RELAXED, __HIP_MEMORY_SCOPE_AGENT);
        if (wid == 0) {
            bool dead = false; const unsigned long long t0 = __builtin_amdgcn_s_memrealtime();
            for (;;) {
                if ((unsigned)__builtin_amdgcn_readfirstlane(__hip_atomic_load(cnt + 64 * u.pm, __ATOMIC_RELAXED, __HIP_MEMORY_SCOPE_AGENT)) >= 32u) break;
                if (__builtin_amdgcn_s_memrealtime() - t0 > 2000000ull) { if (lane == 0) __hip_atomic_store(tmo, 1u, __ATOMIC_RELAXED, __HIP_MEMORY_SCOPE_AGENT); dead = true; break; }
                __builtin_amdgcn_s_sleep(2);
            }
            __builtin_amdgcn_fence(__ATOMIC_ACQUIRE, "agent");
            if (lane == 0) flag[0] = dead ? 1u : 0u;
        }
        asm volatile("s_waitcnt vmcnt(0) lgkmcnt(0)" ::: "memory"); __builtin_amdgcn_s_barrier(); asm volatile("" ::: "memory");
        const bool bad = flag[0] != 0u;
        if (lane < 32) {
            const unsigned* slot = (const unsigned*)xbuf + (size_t)(u.pm * BM + row) * 4; float tot = 0.f;
#pragma unroll
            for (int t = 0; t < 4; ++t) tot += __uint_as_float(__hip_atomic_load(slot + t, __ATOMIC_RELAXED, __HIP_MEMORY_SCOPE_AGENT));
            S[row] = 1.0f / sqrtf(tot * (1.0f / 1024.0f) + eps);
        }
        asm volatile("s_waitcnt lgkmcnt(0)" ::: "memory"); __builtin_amdgcn_s_barrier(); asm volatile("" ::: "memory");
        return bad;
    }
};
template <bool TWO> struct EpiRmsRes {
    static constexpr bool PERM = false, AFTER_DRAIN = true; static constexpr int MID_T = -1;
    const float* base; float* out; bf16_t* xn; int ldc; const float* gpost; const float* gnext; float scale; PanelSumsq st1, st2;
    __device__ __forceinline__ void fused(f32x4 (&acc)[2][2][4][2], const Unit& u, int wr, int wc, int fr, int fq, PG8_LAS unsigned char* lds, int wid, int lane) const {
        typedef unsigned u32x2v __attribute__((ext_vector_type(2)));
        const PG8_LAS float* S = (const PG8_LAS float*)(lds + 8192);
        const int col0 = u.pn * BM + wc * 32 + 4 * fq;
        (void)st1.run(acc, u, wr, wc, fr, fq, lds, wid, lane);
#pragma unroll
        for (int ai = 0; ai < 2; ++ai)
#pragma unroll
            for (int m = 0; m < 4; ++m) { const int r = ai * HALF + wr * 64 + m * 16 + fr; const float sr = S[r] * scale; const size_t off = (size_t)(u.pm * BM + r) * ldc + col0;
#pragma unroll
                for (int bj = 0; bj < 2; ++bj)
#pragma unroll
                    for (int n = 0; n < 2; ++n) { const f32x4 bs = *(const f32x4*)(base + off + bj * HALF + n * 16), g = *(const f32x4*)(gpost + col0 + bj * HALF + n * 16);
                        const f32x4 x1 = bs + acc[ai][bj][m][n] * sr * g; acc[ai][bj][m][n] = x1; if (!TWO) *(f32x4*)(out + off + bj * HALF + n * 16) = x1; }
                asm volatile("" : "+v"(acc[ai][0][m][0]), "+v"(acc[ai][0][m][1]), "+v"(acc[ai][1][m][0]), "+v"(acc[ai][1][m][1]));
                asm volatile("" ::: "memory"); }
        if (TWO) {
            (void)st2.run(acc, u, wr, wc, fr, fq, lds, wid, lane);
#pragma unroll
            for (int ai = 0; ai < 2; ++ai)
#pragma unroll
                for (int m = 0; m < 4; ++m) { const int r = ai * HALF + wr * 64 + m * 16 + fr; const float sr = S[r]; const size_t off = (size_t)(u.pm * BM + r) * ldc + col0;
#pragma unroll
                    for (int bj = 0; bj < 2; ++bj)
#pragma unroll
                        for (int n = 0; n < 2; ++n) { const f32x4 x1 = acc[ai][bj][m][n], g = *(const f32x4*)(gnext + col0 + bj * HALF + n * 16);
                            *(f32x4*)(out + off + bj * HALF + n * 16) = x1;
                            const f32x4 o = x1 * sr * g; u32x2v w; w.x = cvt_pk_bf16(o[0], o[1]); w.y = cvt_pk_bf16(o[2], o[3]); *(u32x2v*)(xn + off + bj * HALF + n * 16) = w; }
                    asm volatile("" ::: "memory"); }
        }
    }
};
}
#include <hip/hip_bf16.h>
#include <cmath>
namespace attn_body {
using bf16=__hip_bfloat16;
using bf16x8=__attribute__((ext_vector_type(8)))short;
using s16x4=__attribute__((ext_vector_type(4)))short;
using f32x16=__attribute__((ext_vector_type(16)))float;
using u32x4=__attribute__((ext_vector_type(4)))unsigned;
constexpr int BATCH=8,SEQ=4096,D=64,DM=1536,OPITCH=512,DAPITCH=1024;
constexpr int NW=8,QBLK=32,QB=QBLK*NW,KVBLK=64,NQB=SEQ/QB;
constexpr int ATTN_PITCH=DM, ATTN_UNIT_ROWS=QB;
__device__ __forceinline__ int crow(int r,int hi){return (r&3)+8*(r>>2)+4*hi;}
#define SBAR() __builtin_amdgcn_sched_barrier(0)
__device__ __forceinline__ void cmask(f32x16&p0,f32x16&p1,int jb,int qrel,int hi){
  const float NEG=-INFINITY; int kb=64*jb+4*hi;
  #pragma unroll
  for(int r=0;r<16;++r){int kv=kb+(r&3)+8*(r>>2); if(kv>qrel)p0[r]=NEG; if(kv+32>qrel)p1[r]=NEG;}
}

constexpr int NSLOT=3, SLOTB=8192;
constexpr int LDS_K=0, LDS_V=NSLOT*SLOTB, LDS_WS=LDS_V+NSLOT*2*SLOTB, LDS_OST=LDS_WS+NW*64*4, LDS_BYTES=LDS_OST+NW*4096;
constexpr float C2=0.125f*1.4426950408889634f;
__device__ __forceinline__ void glds16(const void*gsrc,unsigned lds_dst){unsigned keep;
  asm volatile("s_mov_b32 %0, m0\n\ts_mov_b32 m0, %2\n\ts_nop 0\n\tglobal_load_lds_dwordx4 %1, off\n\ts_mov_b32 m0, %0":"=&s"(keep):"v"(gsrc),"s"(lds_dst):"memory");}
__device__ __forceinline__ float max3f(float a,float b,float c){float r;asm("v_max3_f32 %0, %1, %2, %3":"=v"(r):"v"(a),"v"(b),"v"(c));return r;}
__device__ __forceinline__ float max2f(float a,float b){float r;asm("v_max_f32_e32 %0, %1, %2":"=v"(r):"v"(a),"v"(b));return r;}
__device__ __forceinline__ float fadd_s(float a,float b){float r;asm("v_add_f32_e32 %0, %1, %2":"=v"(r):"v"(a),"v"(b));return r;}
__device__ __forceinline__ float fsub_s(float a,float b){float r;asm("v_sub_f32_e32 %0, %1, %2":"=v"(r):"v"(a),"v"(b));return r;}
typedef float f32x2_t __attribute__((ext_vector_type(2))); typedef __bf16 bf16x2_t __attribute__((ext_vector_type(2)));
__device__ __forceinline__ unsigned cvtpk_s(float lo,float hi){f32x2_t v={lo,hi};bf16x2_t b=__builtin_convertvector(v,bf16x2_t);return __builtin_bit_cast(unsigned,b);}
#define WAIT_BAR(N) asm volatile("s_waitcnt vmcnt(" #N ") lgkmcnt(0)\n\ts_barrier":::"memory")

__device__ __forceinline__ void qkt(f32x16&p0,f32x16&p1,const char*Kslot,const bf16x8*qr,int r32,int hi){
  const char*kb=Kslot+hi*1024+r32*16;
  #pragma unroll
  for(int d0=0;d0<4;++d0){
    const bf16x8 b0=*reinterpret_cast<const bf16x8*>(kb+d0*2048);
    const bf16x8 b1=*reinterpret_cast<const bf16x8*>(kb+d0*2048+512);
    if(d0==0){p0=__builtin_amdgcn_mfma_f32_32x32x16_bf16(b0,qr[0],f32x16{},0,0,0);p1=__builtin_amdgcn_mfma_f32_32x32x16_bf16(b1,qr[0],f32x16{},0,0,0);}
    else{p0=__builtin_amdgcn_mfma_f32_32x32x16_bf16(b0,qr[d0],p0,0,0,0);p1=__builtin_amdgcn_mfma_f32_32x32x16_bf16(b1,qr[d0],p1,0,0,0);}}
}
typedef __attribute__((address_space(3))) const char* lds_cptr;
typedef short v4i16_t __attribute__((ext_vector_type(4)));
__device__ __forceinline__ void kload8(bf16x8*kf,lds_cptr kp){
  kf[0]=*(const __attribute__((address_space(3))) bf16x8*)(kp);      kf[1]=*(const __attribute__((address_space(3))) bf16x8*)(kp+512);
  kf[2]=*(const __attribute__((address_space(3))) bf16x8*)(kp+2048); kf[3]=*(const __attribute__((address_space(3))) bf16x8*)(kp+2560);
  kf[4]=*(const __attribute__((address_space(3))) bf16x8*)(kp+4096); kf[5]=*(const __attribute__((address_space(3))) bf16x8*)(kp+4608);
  kf[6]=*(const __attribute__((address_space(3))) bf16x8*)(kp+6144); kf[7]=*(const __attribute__((address_space(3))) bf16x8*)(kp+6656);
}
__device__ __forceinline__ void kload2(bf16x8*kf,lds_cptr kp,int j){ kf[2*j]=*(const __attribute__((address_space(3))) bf16x8*)(kp+j*2048); kf[2*j+1]=*(const __attribute__((address_space(3))) bf16x8*)(kp+j*2048+512); }
__device__ __forceinline__ s16x4 vtr(lds_cptr p){ return __builtin_bit_cast(s16x4,__builtin_amdgcn_ds_read_tr16_b64_v4i16((__attribute__((address_space(3))) v4i16_t*)p)); }
__device__ __forceinline__ float rowmax(const f32x16&p0,const f32x16&p1){
  float a=max3f(p0[0],p0[1],p1[0]),b=max3f(p0[2],p0[3],p1[1]);a=max3f(a,p1[2],p1[3]);
  #pragma unroll
  for(int r=4;r<16;r+=4){a=max3f(a,p0[r],p0[r+1]);b=max3f(b,p0[r+2],p0[r+3]);a=max3f(a,p1[r],p1[r+1]);b=max3f(b,p1[r+2],p1[r+3]);}
  const float m=max2f(a,b);
  auto rr=__builtin_amdgcn_permlane32_swap(__float_as_uint(m),__float_as_uint(m),false,false);
  return max2f(__uint_as_float(rr[0]),__uint_as_float(rr[1]));
}
__device__ __forceinline__ void pv(f32x16*o,int vb,bf16x8 pa0,bf16x8 pa1,bf16x8 pa2,bf16x8 pa3){
  #pragma unroll
  for(int d0=0;d0<4;++d0){s16x4 lo[4],hi[4];
    #pragma unroll
    for(int ks=0;ks<4;++ks){
      asm volatile("ds_read_b64_tr_b16 %0,%1 offset:%c2":"=&v"(lo[ks]):"v"(vb),"i"(d0*4096+ks*1024):"memory");
      asm volatile("ds_read_b64_tr_b16 %0,%1 offset:%c2":"=&v"(hi[ks]):"v"(vb),"i"(d0*4096+ks*1024+512):"memory");}
    asm volatile("s_waitcnt lgkmcnt(0)":::"memory");SBAR();
    #define PK(k) (bf16x8){lo[k][0],lo[k][1],lo[k][2],lo[k][3],hi[k][0],hi[k][1],hi[k][2],hi[k][3]}
    o[d0]=__builtin_amdgcn_mfma_f32_32x32x16_bf16(pa0,PK(0),o[d0],0,0,0);
    o[d0]=__builtin_amdgcn_mfma_f32_32x32x16_bf16(pa1,PK(1),o[d0],0,0,0);
    o[d0]=__builtin_amdgcn_mfma_f32_32x32x16_bf16(pa2,PK(2),o[d0],0,0,0);
    o[d0]=__builtin_amdgcn_mfma_f32_32x32x16_bf16(pa3,PK(3),o[d0],0,0,0);
    #undef PK
  }
}

#ifndef ATTN_STORE16
#define ATTN_STORE16(p,v) (*(u32x4*)(p)=(v))
#endif
template<int THRL> __device__ __forceinline__ void attn_unit(int b,int h,int qb,const bf16*Q,const bf16*__restrict__ K,const bf16*__restrict__ V,bf16*O,char*shm,const bool cmb,const float cmb_lam,const float cmb_scale,const float*cmb_g,const bf16*O1,bf16*DAo){
  int tid_=threadIdx.x; asm volatile("":"+v"(tid_)); const int tid=tid_,lane=tid&63,r32=lane&31,hi=lane>>5; const int wid=__builtin_amdgcn_readfirstlane(tid>>6);
  const long rowbase=(long)b*SEQ; const int q0=qb*QB;
  const bf16*Qw=Q+(rowbase+q0+wid*QBLK)*DM+h*D;
  const bf16*Kh=K+rowbase*DM+h*D,*Vh=V+rowbase*DM+h*D;
  const unsigned lds0=(unsigned)(uintptr_t)shm;
  float*wsf=(float*)(shm+LDS_WS)+wid*64;
  const bf16*ksrc=Kh+(long)lane*DM+wid*8;
  const bf16*vsrc=Vh+(long)(16*(wid&3)+(lane>>2))*DM+(wid>>2)*32+(lane&3)*8;
  const unsigned kdst=lds0+LDS_K+wid*1024, vdst=lds0+LDS_V+wid*1024;
  #define DMA_K(t,slot) glds16(ksrc+(long)(t)*KVBLK*DM,(unsigned)__builtin_amdgcn_readfirstlane(kdst+(slot)))
  #define DMA_V(t,slot) do{ glds16(vsrc+(long)(t)*KVBLK*DM,(unsigned)__builtin_amdgcn_readfirstlane(vdst+2*(slot))); glds16(vsrc+64+(long)(t)*KVBLK*DM,(unsigned)__builtin_amdgcn_readfirstlane(vdst+2*(slot)+8192)); }while(0)
  const int vb0=(int)(lds0+LDS_V)+((lane>>4)&1)*32+(lane&3)*8+(4*hi+((lane&15)>>2))*64;
  const char*Kbase=shm+LDS_K; bf16x8 kf[8];
  const lds_cptr shm3=(lds_cptr)shm; const lds_cptr kp0=shm3+LDS_K+hi*1024+r32*16; const lds_cptr vp0=shm3+LDS_V+((lane>>4)&1)*32+(lane&3)*8+(4*hi+((lane&15)>>2))*64;
  const int NT=(q0+QB)/KVBLK;
  DMA_K(0,0);DMA_V(0,0);DMA_K(1,SLOTB);
  bf16x8 qr[4];
  #pragma unroll
  for(int d0=0;d0<4;++d0)qr[d0]=*reinterpret_cast<const bf16x8*>(&Qw[(long)r32*DM+d0*16+hi*8]);
  float mhat=0.f,l_reg=0.f;f32x16 o[4];o[0]=f32x16{};o[1]=f32x16{};o[2]=f32x16{};o[3]=f32x16{};
  const int qrel=wid*QBLK+r32;
  #define CMASK(P0,P1,t) do{int jb_=(t)-(NT-4); if(jb_>=0)cmask(P0,P1,jb_,qrel,hi);}while(0)
  bool resc=false;
  #define START(P0,P1) do{ const float rm=rowmax(P0,P1); resc=false; mhat=rm; \
    _Pragma("unroll") for(int r=0;r<16;++r)P0[r]=__builtin_amdgcn_exp2f(P0[r]-mhat); }while(0)
  #define RESC() do{ if(resc){ asm volatile("s_waitcnt lgkmcnt(0)":::"memory"); \
      _Pragma("unroll") for(int d_=0;d_<4;++d_) _Pragma("unroll") for(int r=0;r<16;++r)o[d_][r]*=wsf[crow(r,hi)]; } }while(0)
  f32x16 pA0,pA1,pB0,pB1;
  int sl_prev=0,sl_cur=0,sl_next=SLOTB;
  #define ROT() do{sl_prev=sl_cur;sl_cur=sl_next;sl_next=(sl_next==(NSLOT-1)*SLOTB)?0:sl_next+SLOTB;}while(0)
  DMA_K(2,2*SLOTB);
  WAIT_BAR(3);
  qkt(pA0,pA1,Kbase,qr,r32,hi);asm volatile("s_nop 15\n\ts_nop 7":"+v"(pA0),"+v"(pA1));CMASK(pA0,pA1,0);
  START(pA0,pA1);
  _Pragma("unroll") for(int r=0;r<16;++r)pA1[r]=__builtin_amdgcn_exp2f(pA1[r]-mhat);
  WAIT_BAR(0);
  DMA_K(3,0);DMA_V(1,SLOTB);
  ROT();
  kload8(kf,kp0+sl_cur);
  WAIT_BAR(3);
  s16x4 vlo[8],vhi[8]; u32x4 pw0,pw1,pw2,pw3;
  #define PKW(P,B) cvtpk_s(P[B],P[B+1])
  #define PAF(k) __builtin_bit_cast(bf16x8,pw##k)
  #define VFR(i) (bf16x8){vlo[i][0],vlo[i][1],vlo[i][2],vlo[i][3],vhi[i][0],vhi[i][1],vhi[i][2],vhi[i][3]}
  #define PIN(x) asm volatile("":"+v"(x))
  #define MX3(a,b,c) __builtin_fmaxf(__builtin_fmaxf((a),(b)),(c))
  #define GAPA(MF,A0,A1,A2,A3,W0,W1,PW) do{ MF; sacc+=A0; sacc+=A1; sacc+=A2; sacc+=A3; PIN(sacc); W0; W1; PIN(PW); SBAR(); }while(0)
  #define EX(v) __builtin_amdgcn_exp2f((v)-mhat)
  #define FIDX(k) ((((k)&3)<<2)+((k)>>2))
  #define VRD(k) do{ vlo[(k)&7]=vtr(vp_+FIDX(k)*1024); vhi[(k)&7]=vtr(vp_+FIDX(k)*1024+512); }while(0)
  #define GAPB(k,PK_,X,B) do{ o[(k)&3]=__builtin_amdgcn_mfma_f32_32x32x16_bf16(PK_,VFR((k)&7),o[(k)&3],0,0,0); X[B]=EX(X[B]); X[B+1]=EX(X[B+1]); PIN(X); SBAR(); }while(0)
  #define KRD(G,j) do{ if(G){ kload2(kf,kp0+sl_next,j); SBAR(); } }while(0)
  #define QK(a,b,c) __builtin_amdgcn_mfma_f32_32x32x16_bf16(a,b,c,0,0,0)
  #define STEP(C0,C1,P0,P1,t,GK,GV,GL) do{ SBAR(); \
    const lds_cptr vp_=vp0+2*sl_prev; \
    float sacc=(P0[0]+P0[1]); \
    GAPA(C0=QK(kf[0],qr[0],f32x16{}), P0[2],P0[3],P0[4],P0[5],     pw0[0]=PKW(P0,0), pw0[1]=PKW(P0,2), pw0); \
    GAPA(C1=QK(kf[1],qr[0],f32x16{}), P0[6],P0[7],P0[8],P0[9],     pw0[2]=PKW(P0,4), pw0[3]=PKW(P0,6), pw0); \
    GAPA(C0=QK(kf[2],qr[1],C0),       P0[10],P0[11],P0[12],P0[13], pw1[0]=PKW(P0,8), pw1[1]=PKW(P0,10), pw1); \
    GAPA(C1=QK(kf[3],qr[1],C1),       P0[14],P0[15],P1[0],P1[1],   pw1[2]=PKW(P0,12),pw1[3]=PKW(P0,14), pw1); \
    VRD(0); SBAR(); GAPA(C0=QK(kf[4],qr[2],C0), P1[2],P1[3],P1[4],P1[5],     pw2[0]=PKW(P1,0), pw2[1]=PKW(P1,2), pw2); \
    VRD(1); SBAR(); GAPA(C1=QK(kf[5],qr[2],C1), P1[6],P1[7],P1[8],P1[9],     pw2[2]=PKW(P1,4), pw2[3]=PKW(P1,6), pw2); \
    VRD(2); SBAR(); GAPA(C0=QK(kf[6],qr[3],C0), P1[10],P1[11],P1[12],P1[13], pw3[0]=PKW(P1,8), pw3[1]=PKW(P1,10), pw3); \
    VRD(3); SBAR(); GAPA(C1=QK(kf[7],qr[3],C1), P1[14],P1[15],0.f,0.f,       pw3[2]=PKW(P1,12),pw3[3]=PKW(P1,14), pw3); \
    l_reg+=sacc; \
    if(GK){DMA_K((t)+3,sl_cur);} if(GV){DMA_V((t)+1,sl_next);} \
    CMASK(C0,C1,t); \
    { float a=MX3(C0[0],C0[1],C1[0]),b=MX3(C0[2],C0[3],C1[1]); a=MX3(a,C1[2],C1[3]); \
      _Pragma("unroll") for(int r=4;r<16;r+=4){a=MX3(a,C0[r],C0[r+1]);b=MX3(b,C0[r+2],C0[r+3]);a=MX3(a,C1[r],C1[r+1]);b=MX3(b,C1[r+2],C1[r+3]);} \
      float rm=__builtin_fmaxf(a,b); { auto rr=__builtin_amdgcn_permlane32_swap(__float_as_uint(rm),__float_as_uint(rm),false,false); rm=__builtin_fmaxf(__uint_as_float(rr[0]),__uint_as_float(rr[1])); } \
      rm-=mhat; resc=false; \
      if(__builtin_expect(__any(rm>(float)THRL),0)){ const float dl=__builtin_fmaxf(rm,0.f); mhat+=dl; \
        const float f=__builtin_amdgcn_exp2f(-dl); l_reg*=f; if(hi==0)wsf[r32]=f; resc=true; } } \
    SBAR(); \
    GAPB(0,PAF(0),C0,0);   VRD(4);  SBAR(); \
    GAPB(1,PAF(0),C0,2);   VRD(5);  SBAR(); \
    GAPB(2,PAF(0),C0,4);   VRD(6);  SBAR(); \
    GAPB(3,PAF(0),C0,6);   VRD(7);  SBAR(); KRD(GL,0); \
    GAPB(4,PAF(1),C0,8);   VRD(8);  SBAR(); \
    GAPB(5,PAF(1),C0,10);  VRD(9);  SBAR(); \
    GAPB(6,PAF(1),C0,12);  VRD(10); SBAR(); KRD(GL,1); \
    GAPB(7,PAF(1),C0,14);  VRD(11); SBAR(); \
    GAPB(8,PAF(2),C1,0);   VRD(12); SBAR(); \
    GAPB(9,PAF(2),C1,2);   VRD(13); SBAR(); KRD(GL,2); \
    GAPB(10,PAF(2),C1,4);  VRD(14); SBAR(); \
    GAPB(11,PAF(2),C1,6);  VRD(15); SBAR(); \
    GAPB(12,PAF(3),C1,8);  KRD(GL,3); \
    GAPB(13,PAF(3),C1,10); \
    GAPB(14,PAF(3),C1,12); \
    GAPB(15,PAF(3),C1,14); \
    }while(0)
  int t=1;
  #undef CMASK
  #define CMASK(P0,P1,t) do{}while(0)
  for(;t+5<NT;t+=2){
    STEP(pB0,pB1,pA0,pA1,t,true,true,true);     WAIT_BAR(3); RESC(); ROT();
    STEP(pA0,pA1,pB0,pB1,t+1,true,true,true);   WAIT_BAR(3); RESC(); ROT();
  }
  #undef CMASK
  #define CMASK(P0,P1,t) do{int jb_=(t)-(NT-4); if(jb_>=0)cmask(P0,P1,jb_,qrel,hi);}while(0)
  #define ENDW(tt) do{ if((tt)+3<NT){WAIT_BAR(3);} else if((tt)+2<NT){WAIT_BAR(2);} else {WAIT_BAR(0);} }while(0)
  for(;t+1<NT;t+=2){
    STEP(pB0,pB1,pA0,pA1,t,(t+3<NT),(t+1<NT),(t+1<NT));       ENDW(t);   RESC(); ROT();
    STEP(pA0,pA1,pB0,pB1,t+1,(t+4<NT),(t+2<NT),(t+2<NT));     ENDW(t+1); RESC(); ROT();
  }
  STEP(pB0,pB1,pA0,pA1,NT-1,false,false,false); RESC();
  { float sacc=pB0[0]+pB0[1]; _Pragma("unroll") for(int r=2;r<16;++r)sacc+=pB0[r]; _Pragma("unroll") for(int r=0;r<16;++r)sacc+=pB1[r]; l_reg+=sacc;
    pw0=(u32x4){PKW(pB0,0),PKW(pB0,2),PKW(pB0,4),PKW(pB0,6)};pw1=(u32x4){PKW(pB0,8),PKW(pB0,10),PKW(pB0,12),PKW(pB0,14)};pw2=(u32x4){PKW(pB1,0),PKW(pB1,2),PKW(pB1,4),PKW(pB1,6)};pw3=(u32x4){PKW(pB1,8),PKW(pB1,10),PKW(pB1,12),PKW(pB1,14)};
    SBAR(); pv(o,vb0+2*sl_cur,PAF(0),PAF(1),PAF(2),PAF(3)); }
  #undef PKW
  #undef PAF
  #undef VFR
  #undef PIN
  #undef MX3
  #undef GAPA
  #undef GAPB
  #undef EX
  #undef VRD
  #undef KRD
  #undef STEP
  #undef FIDX
  #undef QK
  #undef ENDW
  {auto rr=__builtin_amdgcn_permlane32_swap(__float_as_uint(l_reg),__float_as_uint(l_reg),false,false);l_reg=__uint_as_float(rr[0])+__uint_as_float(rr[1]);}
  if(hi==0)wsf[32+r32]=l_reg;asm volatile("s_waitcnt lgkmcnt(0)":::"memory");
  float rli[16];
  #pragma unroll
  for(int r=0;r<16;++r)rli[r]=__builtin_amdgcn_rcpf(wsf[32+crow(r,hi)]);
  bf16*Ow=O+(rowbase+q0+wid*QBLK)*OPITCH+h*D;
  { bf16*stg=(bf16*)(shm+LDS_OST)+wid*2048;
    float dv[2][4][8];
    #pragma unroll
    for(int hp=0;hp<2;++hp){
      #pragma unroll
      for(int r=0;r<16;++r){const int orow=crow(r,hi);
        #pragma unroll
        for(int d0=0;d0<2;++d0)stg[orow*64+d0*32+r32]=__float2bfloat16(o[2*hp+d0][r]*rli[r]);}
      asm volatile("s_waitcnt lgkmcnt(0)":::"memory");
      if(!cmb){
        #pragma unroll
        for(int i=0;i<4;++i){const int row=i*8+(lane>>3),ch=lane&7; const u32x4 v=*(const u32x4*)(stg+row*64+ch*8); ATTN_STORE16(Ow+(long)row*OPITCH+hp*64+ch*8,v);}
      } else {
        const bf16*O1w=O1+(rowbase+q0+wid*QBLK)*OPITCH; const float lam=cmb_lam;
        #pragma unroll
        for(int i=0;i<4;++i){const int row=i*8+(lane>>3),ch=lane&7; const u32x4 v=*(const u32x4*)(stg+row*64+ch*8); const u32x4 a=*(const u32x4*)(O1w+(long)row*OPITCH+hp*64+ch*8);
          #define BL(w) __uint_as_float((w)<<16)
          #define BH(w) __uint_as_float((w)&0xffff0000u)
          dv[hp][i][0]=BL(a.x)-lam*BL(v.x); dv[hp][i][1]=BH(a.x)-lam*BH(v.x); dv[hp][i][2]=BL(a.y)-lam*BL(v.y); dv[hp][i][3]=BH(a.y)-lam*BH(v.y);
          dv[hp][i][4]=BL(a.z)-lam*BL(v.z); dv[hp][i][5]=BH(a.z)-lam*BH(v.z); dv[hp][i][6]=BL(a.w)-lam*BL(v.w); dv[hp][i][7]=BH(a.w)-lam*BH(v.w);
          #undef BL
          #undef BH
        }
      }
      asm volatile("s_waitcnt lgkmcnt(0)":::"memory"); }
    if(cmb){ bf16*Dw=DAo+(rowbase+q0+wid*QBLK)*DAPITCH; const int ch=lane&7;
      #pragma unroll
      for(int i=0;i<4;++i){ const int row=i*8+(lane>>3); float ss=0.f;
        #pragma unroll
        for(int hp=0;hp<2;++hp)
          #pragma unroll
          for(int j=0;j<8;++j)ss+=dv[hp][i][j]*dv[hp][i][j];
        ss+=__shfl_xor(ss,1); ss+=__shfl_xor(ss,2); ss+=__shfl_xor(ss,4);
        const float rn=cmb_scale*__builtin_amdgcn_rsqf(ss*(1.0f/128.0f)+1e-5f);
        #pragma unroll
        for(int hp=0;hp<2;++hp){ const float*gp=cmb_g+hp*64+ch*8; u32x4 w;
          w.x=cvtpk_s(dv[hp][i][0]*rn*gp[0],dv[hp][i][1]*rn*gp[1]); w.y=cvtpk_s(dv[hp][i][2]*rn*gp[2],dv[hp][i][3]*rn*gp[3]);
          w.z=cvtpk_s(dv[hp][i][4]*rn*gp[4],dv[hp][i][5]*rn*gp[5]); w.w=cvtpk_s(dv[hp][i][6]*rn*gp[6],dv[hp][i][7]*rn*gp[7]);
          *(u32x4*)(Dw+(long)row*DAPITCH+hp*64+ch*8)=w; } } } }
  asm volatile("s_waitcnt lgkmcnt(0)\n\ts_barrier":::"memory");
  #undef DMA_K
  #undef DMA_V
  #undef CMASK
  #undef START
  #undef RESC
  #undef ROT
}
constexpr int ATTN_LDS_BYTES=LDS_BYTES;
struct AttnUnit { int b; int m; int qb; };
struct StaticOrder {
  int vcu, G;
  __device__ __forceinline__ explicit StaticOrder(int grid,int block):vcu((grid%8==0)?((block%8)*(grid/8)+block/8):block),G(grid){}
  __device__ __forceinline__ bool next(int i,AttnUnit&u)const{ const int p=vcu+(i>>2)*G; if(p>=256)return false; const int s=p&7, bh=p>>3; u.b=bh>>2; u.m=2*(bh&3)+(i&1); u.qb=(i&2)?s:15-s; return true; }
  __device__ __forceinline__ void a_ready(const AttnUnit&)const{}
  __device__ __forceinline__ void done(const AttnUnit&)const{}
};
struct AttnTensors { const bf16* ZQ; bf16* O; bf16* DA; float lam; float scale; const float* g; };
template<class Sched,int THRL=8> __device__ __forceinline__ void attn_phase(char*lds,const AttnTensors&T,const Sched&S){
  AttnUnit u;
  for(int i=0;S.next(i,u);++i){ S.a_ready(u); const int head=u.m>>1;
    attn_unit<THRL>(u.b,0,u.qb,T.ZQ+64*u.m,T.ZQ+512+64*u.m,T.ZQ+1024+128*head,T.O+128*head,lds,(u.m&1)!=0,T.lam,T.scale,T.g,T.O+128*head,T.DA+128*head); S.done(u); }
}
#undef SBAR
#undef WAIT_BAR
}
constexpr int NWAVES = 8;
constexpr int BATCH = 8, T = 4096, D = 1024, FF = 2816, DIN = 5632;
constexpr int M = BATCH * T;
constexpr size_t MiB = 1u << 20;
constexpr size_t WS_CTL = 0, CTL_ZERO_BYTES = 1 * MiB;
constexpr size_t WS_CS = 1 * MiB;
constexpr size_t WS_WIN = 4 * MiB, WS_WAP = 15 * MiB, WS_WRP = 16 * MiB, WS_WOUT = 17 * MiB;
constexpr size_t WS_XN = 20 * MiB;
constexpr size_t WS_Y = 84 * MiB;
constexpr size_t WS_R0 = 148 * MiB;
constexpr size_t WS_H = WS_R0, WS_WGU = WS_R0 + 176 * MiB, WS_WD = WS_R0 + 188 * MiB;
constexpr size_t WS_ZQ = WS_R0, WS_ZR = WS_R0 + 96 * MiB, WS_ZG = WS_R0 + 224 * MiB;
constexpr size_t WS_PT = WS_ZQ, WS_ACAT = WS_ZQ + 32 * MiB;
constexpr size_t WS_MG = WS_ZR;
constexpr size_t WS_AO = WS_XN, WS_KVT = WS_Y;
constexpr size_t WS_XB = 500 * MiB, XB_BYTES = (size_t)M * 4 * 4;
constexpr size_t WS_RS = 503 * MiB;
constexpr size_t WS_END = 504 * MiB;
static_assert(WS_WD + (size_t)D * FF * 2 <= WS_R0 + 352 * MiB && WS_ZG + (size_t)M * 2048 * 2 == WS_R0 + 352 * MiB && WS_R0 + 352 * MiB == WS_XB && WS_XB + 5 * XB_BYTES <= WS_END, "d_ws map");
static_assert(WS_WIN + (size_t)DIN * D * 2 <= WS_WAP && WS_WOUT + (size_t)D * D * 2 <= WS_XN && WS_XN + (size_t)M * D * 2 == WS_Y && WS_Y + (size_t)M * D * 2 == WS_R0, "d_ws map");
constexpr int CW_TMO = 0;
constexpr int CW_SEAM = 16384, SEAM_BANK = 128 * 64;
constexpr int CW_SCAN = 8192;
constexpr int CW_BAR = 4096;
constexpr int RING_OFF = 0, RING_BYTES = 131072;
constexpr int LDSCTL_OFF = RING_BYTES, MISC_OFF = LDSCTL_OFF + 320;
constexpr int LDS_BYTES = 147456;
static_assert(MISC_OFF + 128 <= LDS_BYTES, "LDS map");
#define GAS __attribute__((address_space(1)))
#define LAS __attribute__((address_space(3)))
typedef unsigned short bf16;
typedef unsigned v4u __attribute__((ext_vector_type(4)));
typedef float f32x4 __attribute__((ext_vector_type(4)));
typedef short bf16x8 __attribute__((ext_vector_type(8)));
typedef GAS unsigned gu32;
typedef GAS unsigned long long gu64;
#define RLX_AGENT __ATOMIC_RELAXED, __HIP_MEMORY_SCOPE_AGENT
#define LDS_WAIT() asm volatile("s_waitcnt lgkmcnt(0)" ::: "memory")
#define VM_WAIT() asm volatile("s_waitcnt vmcnt(0)" ::: "memory")
__device__ __forceinline__ unsigned long long rt() { return __builtin_amdgcn_s_memrealtime(); }
typedef float f32x2v __attribute__((ext_vector_type(2))); typedef __bf16 bf16x2v __attribute__((ext_vector_type(2)));
__device__ __forceinline__ unsigned pk2(float lo, float hi) { const f32x2v v = {lo, hi}; return __builtin_bit_cast(unsigned, __builtin_convertvector(v, bf16x2v)); }
__device__ __forceinline__ unsigned f2bf(float f) { return pk2(f, 0.f) & 0xffffu; }

#define XB_TMO      128
#define XB_XCNT(j)  (256  + 64 * (j))
#define XB_XSUB(j)  (1280 + 64 * (j))
#define XB_XGEN(j)  (2304 + 64 * (j))
#define XB_TOP      3328
#define XB_TOPGEN   3392
#define XCD_BAR_WORDS 3456
#define XB_SPIN_CAP (1u << 18)

__device__ __forceinline__ unsigned xb_ld(unsigned* p)              { return __hip_atomic_load(p, __ATOMIC_RELAXED, __HIP_MEMORY_SCOPE_AGENT); }
__device__ __forceinline__ unsigned xb_add(unsigned* p, unsigned v) { return __hip_atomic_fetch_add(p, v, __ATOMIC_RELAXED, __HIP_MEMORY_SCOPE_AGENT); }
__device__ __forceinline__ unsigned xb_xcc_id() { return (unsigned)__builtin_amdgcn_s_getreg((3 << 11) | 20) & 0xFu; }
#define XB_SPIN(cond, bar) do { unsigned _sp = 0; while (cond) { __builtin_amdgcn_s_sleep(1); \
    if ((++_sp & 255u) == 0u) { if (xb_ld(&(bar)[XB_TMO])) break; if (_sp > XB_SPIN_CAP) { atomicAdd(&(bar)[XB_TMO], 1u); break; } } } } while (0)

struct XcdBarrier {
    unsigned* bar; unsigned x;
    volatile LAS unsigned* st;
};

__device__ __forceinline__ XcdBarrier xcd_barrier_post(unsigned* bar, volatile LAS unsigned* st) {
    XcdBarrier b; b.bar = bar; b.x = xb_xcc_id(); b.st = st;
    if (threadIdx.x == 0) (void)xb_add(&bar[XB_XCNT(b.x)], 1u);
    return b;
}
__device__ __forceinline__ void xcd_barrier_complete(unsigned* bar, unsigned x, unsigned& nloc, unsigned& nx) {
    const unsigned G = gridDim.x * gridDim.y * gridDim.z;
    unsigned sum, cnt, mine, sp = 0u;
    for (;;) {
        sum = 0u; cnt = 0u; mine = 0u;
#pragma unroll
        for (unsigned j = 0; j < 16; ++j) { const unsigned c = xb_ld(&bar[XB_XCNT(j)]); sum += c; cnt += (c > 0u) ? 1u : 0u; mine = (j == x) ? c : mine; }
        if (sum == G) break;
        __builtin_amdgcn_s_sleep(1);
        if ((++sp & 255u) == 0u) { if (xb_ld(&bar[XB_TMO])) break; if (sp > XB_SPIN_CAP) { atomicAdd(&bar[XB_TMO], 1u); break; } }
    }
    nloc = mine > 0u ? mine : 1u; nx = cnt > 0u ? cnt : 1u;
}

__device__ __forceinline__ void xcd_barrier(const XcdBarrier& b) {
    asm volatile("s_waitcnt vmcnt(0)" ::: "memory");
    __syncthreads();
    if (threadIdx.x == 0) {
        unsigned* bar = b.bar;
        __builtin_amdgcn_s_waitcnt(0);
        unsigned nloc = b.st[0], nx = b.st[1];
        if (nloc == 0u) { xcd_barrier_complete(bar, b.x, nloc, nx); b.st[0] = nloc; b.st[1] = nx; }
        const unsigned old = xb_add(&bar[XB_XSUB(b.x)], 1u);
        const unsigned gen = old / nloc;
        if (old + 1u == (gen + 1u) * nloc) {
            __builtin_amdgcn_fence(__ATOMIC_RELEASE, "agent");
            asm volatile("s_waitcnt vmcnt(0)" ::: "memory");
            const unsigned og = xb_add(&bar[XB_TOP], 1u);
            const unsigned tg = og / nx;
            if (og + 1u == (tg + 1u) * nx) xb_add(&bar[XB_TOPGEN], 1u);
            else XB_SPIN(xb_ld(&bar[XB_TOPGEN]) == tg, bar);
            __builtin_amdgcn_fence(__ATOMIC_ACQUIRE, "agent");
            xb_add(&bar[XB_XGEN(b.x)], 1u);
            asm volatile("s_waitcnt vmcnt(0)" ::: "memory");
        } else {
            XB_SPIN(xb_ld(&bar[XB_XGEN(b.x)]) == gen, bar);
            __builtin_amdgcn_fence(__ATOMIC_ACQUIRE, "agent");
            asm volatile("s_waitcnt vmcnt(0)" ::: "memory");
        }
    }
    __syncthreads();
}
struct Frame {
    LAS unsigned char* lds;
    volatile LAS unsigned* MISC;
    gu32* ctl;
    int tid, lane, wave;
    int vcu, G;
};

template <int CTRL> __device__ __forceinline__ float dpp_xadd(float v) { return v + __builtin_bit_cast(float, __builtin_amdgcn_update_dpp(0, __builtin_bit_cast(int, v), CTRL, 0xF, 0xF, false)); }
__device__ __forceinline__ float wave_sum(float v) {
    v = dpp_xadd<0xB1>(v); v = dpp_xadd<0x4E>(v); v = dpp_xadd<0x141>(v); v = dpp_xadd<0x140>(v);
    const int iv = __builtin_bit_cast(int, v);
    const float r0 = __builtin_bit_cast(float, __builtin_amdgcn_readlane(iv, 0)), r1 = __builtin_bit_cast(float, __builtin_amdgcn_readlane(iv, 16));
    const float r2 = __builtin_bit_cast(float, __builtin_amdgcn_readlane(iv, 32)), r3 = __builtin_bit_cast(float, __builtin_amdgcn_readlane(iv, 48));
    return (r0 + r1) + (r2 + r3);
}
__device__ __forceinline__ float bfl(unsigned w) { return __uint_as_float(w << 16); }
__device__ __forceinline__ float bfh(unsigned w) { return __uint_as_float(w & 0xffff0000u); }

__device__ __forceinline__ void transpose_item(const float* W, int K, int N, bf16* WT, int mode, LAS float* scr, int item, int lane, int ldw = 0, int koff = 0, const float* gk = nullptr, float wscale = 1.0f) {
    if (ldw == 0) ldw = K;
    const int nblk = N / 32, kb = item / nblk, nb = item % nblk, k0 = 64 * kb, n0 = 32 * nb;
    int rbase = (mode == 0) ? n0 : (256 * (n0 >> 7) + (n0 & 127) + (mode == 2 ? 128 : 0));
    if (mode == 3) rbase = (n0 < 3584) ? n0 : (n0 < 4608) ? (3584 + 256 * ((n0 - 3584) >> 7) + ((n0 - 3584) & 127)) : (3584 + 256 * ((n0 - 4608) >> 7) + 128 + ((n0 - 4608) & 127));
    const float gl = (gk ? gk[k0 + lane] : 1.0f) * ((mode == 3 && n0 >= 3584) ? -1.4426950408889634f : wscale);
#pragma unroll 8
    for (int i = 0; i < 32; ++i) { const int kk = 2 * i + (lane >> 5); const float gv = __shfl(gl, kk); scr[kk * 33 + (lane & 31)] = W[(size_t)(k0 + kk) * N + n0 + (lane & 31)] * gv; }
    LDS_WAIT(); asm volatile("" ::: "memory");
    const int c = lane & 7;
#pragma unroll
    for (int j = 0; j < 4; ++j) { const int n = (lane >> 3) + 8 * j; const LAS float* s = scr + (8 * c) * 33 + n;
        v4u o; o.x = pk2(s[0 * 33], s[1 * 33]); o.y = pk2(s[2 * 33], s[3 * 33]); o.z = pk2(s[4 * 33], s[5 * 33]); o.w = pk2(s[6 * 33], s[7 * 33]);
        *(GAS v4u*)(WT + (size_t)(rbase + n) * ldw + koff + k0 + 8 * c) = o; }
    LDS_WAIT(); asm volatile("" ::: "memory");
}

template <bool SRC_XN, bool HAS_Y, bool OUT_F32, bool OUT_XN>
__device__ __forceinline__ void row_phase(Frame& F, const float* xin, const bf16* xn_in, const float* rs_in, const bf16* y, const float* gpost, float scale, float* xout, bf16* xn_out, float* rs_out) {
    constexpr int NR = 2;
    const int gw = F.vcu * NWAVES + F.wave, NGW = F.G * NWAVES;
    f32x4 gp[4];
#pragma unroll
    for (int j = 0; j < 4; ++j) gp[j] = HAS_Y ? *(const f32x4*)(gpost + 256 * j + 4 * F.lane) : (f32x4){0.f, 0.f, 0.f, 0.f};
    for (int m0 = gw; m0 < M; m0 += NR * NGW) {
        f32x4 v[NR][4]; unsigned long long yw[NR][4]; float rsv[NR];
#pragma unroll
        for (int q = 0; q < NR; ++q) { const int m = (m0 + q * NGW < M) ? m0 + q * NGW : m0;
            if (SRC_XN) { const GAS unsigned long long* xr = (const GAS unsigned long long*)(xn_in + (size_t)m * D) + F.lane; rsv[q] = rs_in[m];
#pragma unroll
                for (int j = 0; j < 4; ++j) { const unsigned long long w = xr[64 * j]; const unsigned lo = (unsigned)w, hi = (unsigned)(w >> 32); v[q][j] = (f32x4){bfl(lo), bfh(lo), bfl(hi), bfh(hi)}; }
            } else { const GAS f32x4* xr = (const GAS f32x4*)(xin + (size_t)m * D) + F.lane; rsv[q] = 1.f;
#pragma unroll
                for (int j = 0; j < 4; ++j) v[q][j] = xr[64 * j]; }
            if (HAS_Y) { const GAS unsigned long long* yr = (const GAS unsigned long long*)(y + (size_t)m * D) + F.lane;
#pragma unroll
                for (int j = 0; j < 4; ++j) yw[q][j] = yr[64 * j]; } }
#pragma unroll
        for (int q = 0; q < NR; ++q) { const int m = (m0 + q * NGW < M) ? m0 + q * NGW : m0;
            if (SRC_XN) {
#pragma unroll
                for (int j = 0; j < 4; ++j) v[q][j] = v[q][j] * rsv[q]; }
            if (HAS_Y) {
                f32x4 yv[4]; float s = 0.f;
#pragma unroll
                for (int j = 0; j < 4; ++j) { const unsigned lo = (unsigned)yw[q][j], hi = (unsigned)(yw[q][j] >> 32);
                    yv[j] = (f32x4){bfl(lo), bfh(lo), bfl(hi), bfh(hi)}; s += (yv[j].x * yv[j].x + yv[j].y * yv[j].y) + (yv[j].z * yv[j].z + yv[j].w * yv[j].w); }
                const float ry = scale * __builtin_amdgcn_rsqf(wave_sum(s) * (1.f / D) + 1e-6f);
#pragma unroll
                for (int j = 0; j < 4; ++j) v[q][j] = v[q][j] + yv[j] * ry * gp[j];
            }
            if (OUT_F32) { GAS f32x4* xo = (GAS f32x4*)(xout + (size_t)m * D) + F.lane;
#pragma unroll
                for (int j = 0; j < 4; ++j) xo[64 * j] = v[q][j]; }
            if (OUT_XN) {
                float s2 = 0.f;
#pragma unroll
                for (int j = 0; j < 4; ++j) s2 += (v[q][j].x * v[q][j].x + v[q][j].y * v[q][j].y) + (v[q][j].z * v[q][j].z + v[q][j].w * v[q][j].w);
                const float ms = wave_sum(s2) * (1.f / D) + 1e-6f, rx = __builtin_amdgcn_rsqf(ms), rt = ms * rx;
                GAS unsigned long long* o8 = (GAS unsigned long long*)(xn_out + (size_t)m * D) + F.lane;
#pragma unroll
                for (int j = 0; j < 4; ++j) { const f32x4 o = v[q][j] * rx; o8[64 * j] = (unsigned long long)pk2(o.x, o.y) | ((unsigned long long)pk2(o.z, o.w) << 32); }
                if (rs_out && F.lane == 0) rs_out[m] = rt;
            } }
    }
}

namespace ret {
typedef short bf16x8 __attribute__((ext_vector_type(8)));
typedef short s16x4 __attribute__((ext_vector_type(4)));
typedef float f32x16 __attribute__((ext_vector_type(16)));
typedef __attribute__((address_space(3))) const char* lds_cptr;
#define RET_MFMA(a, b, c) __builtin_amdgcn_mfma_f32_32x32x16_bf16(a, b, c, 0, 0, 0)
__device__ __forceinline__ int crow(int r, int hi) { return (r & 3) + 8 * (r >> 2) + 4 * hi; }
__device__ __forceinline__ s16x4 vtr(lds_cptr p) { return __builtin_bit_cast(s16x4, __builtin_amdgcn_ds_read_tr16_b64_v4i16((__attribute__((address_space(3))) s16x4*)p)); }
typedef float f32x2_t __attribute__((ext_vector_type(2))); typedef __bf16 bf16x2_t __attribute__((ext_vector_type(2)));
__device__ __forceinline__ unsigned cvtpk(float lo, float hi) { f32x2_t v = {lo, hi}; bf16x2_t b = __builtin_convertvector(v, bf16x2_t); return __builtin_bit_cast(unsigned, b); }
__device__ __forceinline__ bf16x8 trfrag(lds_cptr img, int cb, int kg, int lane) {
    lds_cptr p = img + (cb * 8 + kg) * 1024 + ((lane >> 4) & 1) * 32 + (lane & 3) * 8 + (4 * (lane >> 5) + ((lane & 15) >> 2)) * 64;
    const s16x4 lo = vtr(p), h = vtr(p + 512);
    return (bf16x8){lo[0], lo[1], lo[2], lo[3], h[0], h[1], h[2], h[3]};
}
__device__ __forceinline__ void load_tr_image(LAS unsigned char* img, const bf16* src, int pitch, int wid, int lane) {
#pragma unroll
    for (int i = 0; i < 4; ++i) { const int p = wid * 4 + i, cb = p >> 3, kg = p & 7, row = 16 * kg + (lane >> 2), col = 32 * cb + (lane & 3) * 8;
        const v4u v = *(const GAS v4u*)(src + (size_t)row * pitch + col); *(LAS v4u*)(img + p * 1024 + lane * 16) = v; }
}
__device__ __forceinline__ float log2_decay(int h) { return __builtin_log2f(1.0f - __builtin_exp2f(-5.0f - (float)h)); }

__device__ __forceinline__ int run_unit(int r, int k) { return (r >> 3) * 32 + 4 * (r & 7) + k; }
__device__ __forceinline__ void r1_load(v4u (&t)[8], const bf16* ZR, int u, int wid, int lane) {
    const int bh = u >> 5, n = u & 31, b = bh >> 2, h = bh & 3;
    const bf16* Zrow = ZR + (size_t)(b * T + 128 * n) * 2048;
#pragma unroll
    for (int i = 0; i < 4; ++i) { const int p = wid * 4 + i, cb = p >> 3, kg = p & 7; const bf16* zr = Zrow + (size_t)(16 * kg + (lane >> 2)) * 2048 + 128 * h + 32 * cb + (lane & 3) * 8;
        t[i] = *(const GAS v4u*)(zr + 1024); t[4 + i] = *(const GAS v4u*)(zr + 512); }
}
__device__ __forceinline__ void r1_phase(LAS unsigned char* lds, const bf16* ZR, bf16* PTL, float* TT, int r0, int rstep, int wid, int lane) {
    const lds_cptr imgV = (lds_cptr)lds, imgK = (lds_cptr)(lds + 32768);
    const int eblk = wid & 3, dh = wid >> 2, r32 = lane & 31, hi = lane >> 5;
    for (int r = r0; r < 256; r += rstep) {
        const float l2g = log2_decay((r >> 3) & 3), g1 = __builtin_exp2f(l2g), gC = __builtin_exp2f(128.0f * l2g), gc1 = __builtin_exp2f(127.0f * l2g);
        v4u t[8];
        r1_load(t, ZR, run_unit(r, 0), wid, lane);
        f32x16 L0 = f32x16{}, L1 = f32x16{};
#pragma unroll
        for (int k = 0; k < 4; ++k) {
            const int u = run_unit(r, k);
#pragma unroll
            for (int i = 0; i < 4; ++i) { *(LAS v4u*)(lds + (wid * 4 + i) * 1024 + lane * 16) = t[i]; *(LAS v4u*)(lds + 32768 + (wid * 4 + i) * 1024 + lane * 16) = t[4 + i]; }
            __syncthreads();
            if (k < 3) r1_load(t, ZR, u + 1, wid, lane);
            f32x16 acc0 = f32x16{}, acc1 = f32x16{};
#pragma unroll
            for (int kg = 0; kg < 8; ++kg) { const bf16x8 a = trfrag(imgV, eblk, kg, lane), b0 = trfrag(imgK, 2 * dh, kg, lane), b1 = trfrag(imgK, 2 * dh + 1, kg, lane);
                acc0 = RET_MFMA(a, b0, acc0); acc1 = RET_MFMA(a, b1, acc1); }
            bf16* out = PTL + (size_t)u * 16384 + 64 * dh + r32;
#pragma unroll
            for (int q = 0; q < 16; ++q) { const int e = 32 * eblk + crow(q, hi); out[e * 128] = (bf16)f2bf(L0[q] * g1); out[e * 128 + 32] = (bf16)f2bf(L1[q] * g1);
                L0[q] = L0[q] * gC + acc0[q] * gc1; L1[q] = L1[q] * gC + acc1[q] * gc1; }
            __syncthreads();
        }
        float* tt = TT + (size_t)r * 16384 + 64 * dh + r32;
#pragma unroll
        for (int q = 0; q < 16; ++q) { const int e = 32 * eblk + crow(q, hi); tt[e * 128] = L0[q]; tt[e * 128 + 32] = L1[q]; }
    }
}

__device__ __forceinline__ bf16x8 rmfrag(const LAS unsigned char* img, int row, int c) { return *(const LAS bf16x8*)(img + row * 256 + ((c ^ (row & 15)) << 4)); }
constexpr int R3_SCR = 131072 + 1024;
struct R3Tiles { v4u tq[4], tk[4], tp[4], tv[4]; };
__device__ __forceinline__ void r3_load(R3Tiles& t, const bf16* ZR, const bf16* PT, int u, int wid, int lane) {
    const int bh = u >> 5, n = u & 31, b = bh >> 2, h = bh & 3, tid = wid * 64 + lane;
    const bf16* Zrow = ZR + (size_t)(b * T + 128 * n) * 2048;
#pragma unroll
    for (int i = 0; i < 4; ++i) { const int idx = i * 512 + tid, row = idx >> 4, c = idx & 15; const bf16* zr = Zrow + (size_t)row * 2048 + 128 * h + c * 8;
        t.tq[i] = *(const GAS v4u*)zr; t.tk[i] = *(const GAS v4u*)(zr + 512);
        t.tp[i] = *(const GAS v4u*)(PT + (size_t)u * 16384 + row * 128 + c * 8);
        const int p = wid * 4 + i, cb = p >> 3, kg = p & 7; t.tv[i] = *(const GAS v4u*)(Zrow + (size_t)(16 * kg + (lane >> 2)) * 2048 + 1024 + 128 * h + 32 * cb + (lane & 3) * 8); }
}
__device__ __forceinline__ void r3_phase(LAS unsigned char* lds, const bf16* ZR, bf16* PT, const float* TT, bf16* OUT, int opitch, int ocol, int r0, int rstep, int wid, int lane) {
 for (int rr = r0; rr < 256; rr += rstep) {
  { const int bh0 = rr >> 3, c0 = rr & 7, tid0 = wid * 64 + lane;
    if (c0 > 0) {
        const float l2g0 = log2_decay(bh0 & 3), G4 = __builtin_exp2f(512.0f * l2g0);
        float S0[4][8];
#pragma unroll
        for (int i = 0; i < 4; ++i)
#pragma unroll
            for (int j = 0; j < 8; ++j) S0[i][j] = 0.f;
        const float* tt = TT + (size_t)(bh0 * 8) * 16384 + tid0 * 8;
        int cp = 0;
        for (; cp + 1 < c0; cp += 2) {
            f32x4 a0[4], a1[4], b0[4], b1[4];
#pragma unroll
            for (int i = 0; i < 4; ++i) { const float* q = tt + (size_t)cp * 16384 + i * 4096; a0[i] = *(const GAS f32x4*)q; a1[i] = *(const GAS f32x4*)(q + 4); b0[i] = *(const GAS f32x4*)(q + 16384); b1[i] = *(const GAS f32x4*)(q + 16384 + 4); }
#pragma unroll
            for (int i = 0; i < 4; ++i)
#pragma unroll
                for (int j = 0; j < 4; ++j) { S0[i][j] = (S0[i][j] * G4 + a0[i][j]) * G4 + b0[i][j]; S0[i][4 + j] = (S0[i][4 + j] * G4 + a1[i][j]) * G4 + b1[i][j]; }
        }
        if (cp < c0) {
#pragma unroll
            for (int i = 0; i < 4; ++i) { const float* q = tt + (size_t)cp * 16384 + i * 4096; const f32x4 a0 = *(const GAS f32x4*)q, a1 = *(const GAS f32x4*)(q + 4);
#pragma unroll
                for (int j = 0; j < 4; ++j) { S0[i][j] = S0[i][j] * G4 + a0[j]; S0[i][4 + j] = S0[i][4 + j] * G4 + a1[j]; } }
        }
        bf16* pt = (bf16*)PT + (size_t)run_unit(rr, 0) * 16384 + tid0 * 8;
        v4u w[4][4];
#pragma unroll
        for (int k = 0; k < 4; ++k)
#pragma unroll
            for (int i = 0; i < 4; ++i) w[k][i] = *(const GAS v4u*)(pt + (size_t)k * 16384 + i * 4096);
#pragma unroll
        for (int k = 0; k < 4; ++k) { const float gk = __builtin_exp2f((float)(128 * k + 1) * l2g0);
#pragma unroll
            for (int i = 0; i < 4; ++i) { const v4u x = w[k][i]; v4u o;
                o.x = cvtpk(bfl(x.x) + gk * S0[i][0], bfh(x.x) + gk * S0[i][1]); o.y = cvtpk(bfl(x.y) + gk * S0[i][2], bfh(x.y) + gk * S0[i][3]);
                o.z = cvtpk(bfl(x.z) + gk * S0[i][4], bfh(x.z) + gk * S0[i][5]); o.w = cvtpk(bfl(x.w) + gk * S0[i][6], bfh(x.w) + gk * S0[i][7]);
                *(GAS v4u*)(pt + (size_t)k * 16384 + i * 4096) = o; } }
    } }
  for (int kk = 0; kk < 4; ++kk) {
    const int u = run_unit(rr, kk);
    R3Tiles tl; r3_load(tl, ZR, PT, u, wid, lane);
    const int bh_ = u >> 5, tid_ = wid * 64 + lane; v4u gt[4];
#pragma unroll
    for (int i = 0; i < 4; ++i) { const int idx = i * 512 + tid_, row = idx >> 4, c = idx & 15; gt[i] = *(const GAS v4u*)(ZR + (size_t)((bh_ >> 2) * T + 128 * (u & 31) + row) * 2048 + 1536 + 128 * (bh_ & 3) + c * 8); }
    const int bh = u >> 5, n = u & 31, b = bh >> 2, h = bh & 3, rowbase = b * T + 128 * n, tid = wid * 64 + lane;
#pragma unroll
    for (int i = 0; i < 4; ++i) { const int idx = i * 512 + tid, row = idx >> 4, c = idx & 15, off = row * 256 + ((c ^ (row & 15)) << 4);
        *(LAS v4u*)(lds + off) = tl.tq[i]; *(LAS v4u*)(lds + 32768 + off) = tl.tk[i]; *(LAS v4u*)(lds + 65536 + off) = tl.tp[i];
        *(LAS v4u*)(lds + 98304 + (wid * 4 + i) * 1024 + lane * 16) = tl.tv[i]; }
    __syncthreads();
    const LAS unsigned char* imgQ = lds; const LAS unsigned char* imgK = lds + 32768; const LAS unsigned char* imgP = lds + 65536; const lds_cptr imgV = (lds_cptr)(lds + 98304);
    const int eh = wid >> 2, qb = eh ? 3 - (wid & 3) : (wid & 3), r32 = lane & 31, hi = lane >> 5;
    f32x16 acc0 = f32x16{}, acc1 = f32x16{};
    for (int kb = 0; kb <= qb; ++kb) {
        f32x16 S = f32x16{};
#pragma unroll 4
        for (int ds = 0; ds < 8; ++ds) S = RET_MFMA(rmfrag(imgK, 32 * kb + r32, 2 * ds + hi), rmfrag(imgQ, 32 * qb + r32, 2 * ds + hi), S);
        if (kb == qb) {
#pragma unroll
            for (int r = 0; r < 16; ++r) if (crow(r, hi) > r32) S[r] = 0.f;
        }
        v4u w0, w1;
        w0.x = cvtpk(S[0], S[1]); w0.y = cvtpk(S[2], S[3]); w0.z = cvtpk(S[4], S[5]); w0.w = cvtpk(S[6], S[7]);
        w1.x = cvtpk(S[8], S[9]); w1.y = cvtpk(S[10], S[11]); w1.z = cvtpk(S[12], S[13]); w1.w = cvtpk(S[14], S[15]);
        const bf16x8 pa0 = __builtin_bit_cast(bf16x8, w0), pa1 = __builtin_bit_cast(bf16x8, w1);
        acc0 = RET_MFMA(pa0, trfrag(imgV, 2 * eh, 2 * kb, lane), acc0);     acc0 = RET_MFMA(pa1, trfrag(imgV, 2 * eh, 2 * kb + 1, lane), acc0);
        acc1 = RET_MFMA(pa0, trfrag(imgV, 2 * eh + 1, 2 * kb, lane), acc1); acc1 = RET_MFMA(pa1, trfrag(imgV, 2 * eh + 1, 2 * kb + 1, lane), acc1);
    }
#pragma unroll
    for (int ds = 0; ds < 8; ++ds) { const bf16x8 qf = rmfrag(imgQ, 32 * qb + r32, 2 * ds + hi); acc0 = RET_MFMA(qf, rmfrag(imgP, 64 * eh + r32, 2 * ds + hi), acc0); acc1 = RET_MFMA(qf, rmfrag(imgP, 64 * eh + 32 + r32, 2 * ds + hi), acc1); }
    const float l2g = log2_decay(h);
    float ss[16];
#pragma unroll
    for (int r = 0; r < 16; ++r) { const float f = __builtin_exp2f((float)(32 * qb + crow(r, hi)) * l2g); acc0[r] *= f; acc1[r] *= f; ss[r] = acc0[r] * acc0[r] + acc1[r] * acc1[r]; }
#pragma unroll
    for (int r = 0; r < 16; ++r) { float s_ = ss[r]; s_ = dpp_xadd<0xB1>(s_); s_ = dpp_xadd<0x4E>(s_); s_ = dpp_xadd<0x141>(s_); s_ = dpp_xadd<0x140>(s_);
        s_ += __shfl_xor(s_, 16); ss[r] = s_; }
    LAS float* scr = (LAS float*)(lds + R3_SCR);
    if (r32 == 0) {
#pragma unroll
        for (int r = 0; r < 16; ++r) scr[wid * 32 + crow(r, hi)] = ss[r];
    }
    __syncthreads();
    LAS float* stage = (LAS float*)lds;
#pragma unroll
    for (int r = 0; r < 16; ++r) { const int ql = crow(r, hi); const float tot = ss[r] + scr[(7 - wid) * 32 + ql];
        const float rn = __builtin_amdgcn_rsqf(tot * (1.0f / 128.0f) + 1e-6f);
        LAS float* sp = stage + (32 * qb + ql) * 128 + 64 * eh + r32; sp[0] = acc0[r] * rn; sp[32] = acc1[r] * rn; }
    __syncthreads();
#pragma unroll
    for (int i = 0; i < 4; ++i) { const int idx = i * 512 + tid, row = idx >> 4, c = idx & 15;
        const f32x4 y0 = *(const LAS f32x4*)(stage + row * 128 + c * 8), y1 = *(const LAS f32x4*)(stage + row * 128 + c * 8 + 4); const v4u g = gt[i];
        v4u w; w.x = pk2(y0.x * bfl(g.x), y0.y * bfh(g.x)); w.y = pk2(y0.z * bfl(g.y), y0.w * bfh(g.y)); w.z = pk2(y1.x * bfl(g.z), y1.y * bfh(g.z)); w.w = pk2(y1.z * bfl(g.w), y1.w * bfh(g.w));
        *(GAS v4u*)(OUT + (size_t)(rowbase + row) * opitch + ocol + 128 * h + c * 8) = w; }
    __syncthreads();
  }
 }
}
}

struct Args { const float* in[22]; float* out; unsigned char* ws; };
#ifndef TWICE
#define TWICE 0
#endif
#ifndef TWICE_N
#define TWICE_N 2
#endif
__device__ __forceinline__ unsigned char* arg_ptr(int i) { asm volatile("" : "+s"(i)); return ((unsigned char* const*)__builtin_amdgcn_kernarg_segment_ptr())[i]; }
__device__ __forceinline__ const float* arg_in(int i) { return (const float*)arg_ptr(i); }
__device__ __forceinline__ int opaque_i(int v) { asm volatile("" : "+s"(v)); return v; }
#if TWICE
#define REP_BEGIN(k) _Pragma("nounroll") for (int rep_ = 0, reps_ = opaque_i(TWICE == (k) ? TWICE_N : 1); rep_ < ((TWICE == (k)) ? reps_ : 1); ++rep_) {
#define REP_END() }
#else
#define REP_BEGIN(k) {
#define REP_END() }
#endif
__device__ __forceinline__ void skew_delay(int vcu, int ticks) { const unsigned long long t0 = __builtin_amdgcn_s_memrealtime(), w = (unsigned long long)((vcu & 3) * ticks);
    while (__builtin_amdgcn_s_memrealtime() - t0 < w) __builtin_amdgcn_s_sleep(8); }
#ifndef P8_SKEW_TICKS
#define P8_SKEW_TICKS 0
#endif
#ifndef SKEW_TICKS
#define SKEW_TICKS 0
#endif
#define REFRESH_LANE() do { int t_ = threadIdx.x; asm volatile("" : "+v"(t_)); F.tid = t_; F.lane = t_ & 63; } while (0)
__global__ void __launch_bounds__(NWAVES * 64, 2) layer_fwd(Args) {
    extern __shared__ __attribute__((aligned(16))) unsigned char lds[];
    Frame F;
    F.lds = (LAS unsigned char*)lds;
    F.MISC = (volatile LAS unsigned*)(F.lds + MISC_OFF);
    F.tid = threadIdx.x; F.lane = F.tid & 63; F.wave = __builtin_amdgcn_readfirstlane(F.tid >> 6);
    F.G = gridDim.x; { const int bx = blockIdx.x; F.vcu = (F.G % 8 == 0) ? (bx % 8) * (F.G / 8) + bx / 8 : bx; }
    F.ctl = (gu32*)(arg_ptr(23) + WS_CTL);
    for (int u = F.tid; u < (LDS_BYTES - LDSCTL_OFF) / 4; u += NWAVES * 64) ((LAS unsigned*)(F.lds + LDSCTL_OFF))[u] = 0u;
    __syncthreads();
#if BAR_MODE == 1
    XcdBarrier bar = xcd_barrier_post((unsigned*)(F.ctl + CW_BAR), F.MISC + 8);
#elif BAR_MODE == 3
    XcdBarrier bar = xcd_barrier_post((unsigned*)(F.ctl + CW_BAR), F.MISC + 8);
    if (gridDim.y == 0x7fffu) cg::this_grid().sync();
#elif BAR_MODE == 2
    if (blockIdx.x == 0) for (int i = F.tid; i < XCD_BAR_WORDS; i += NWAVES * 64) __hip_atomic_store((unsigned*)(F.ctl + CW_BAR) + i, 0u, __ATOMIC_RELAXED, __HIP_MEMORY_SCOPE_AGENT);
    XcdBarrier bar; bar.bar = (unsigned*)(F.ctl + CW_BAR); bar.x = 0; bar.st = F.MISC + 8;
    { const int id = (int)blockIdx.x * (NWAVES * 64) + F.tid;
      if (id < 5 * 128) __hip_atomic_store((unsigned*)(F.ctl + CW_SEAM) + (id >> 7) * SEAM_BANK + 64 * (id & 127), 0u, __ATOMIC_RELAXED, __HIP_MEMORY_SCOPE_AGENT);
      if (id == 0) __hip_atomic_store((unsigned*)(F.ctl + CW_TMO), 0u, __ATOMIC_RELAXED, __HIP_MEMORY_SCOPE_AGENT);
    }
#endif
#if BAR_MODE == 0
#define GRID_BAR() do { cg::this_grid().sync(); REFRESH_LANE(); } while (0)
#define GRID_BAR0() GRID_BAR()
#elif BAR_MODE == 1
#define GRID_BAR() do { xcd_barrier(bar); REFRESH_LANE(); } while (0)
#define GRID_BAR0() GRID_BAR()
#elif BAR_MODE == 3
#define GRID_BAR() do { xcd_barrier(bar); REFRESH_LANE(); } while (0)
#define GRID_BAR0() GRID_BAR()
#else
#ifndef XBAR_FLAT
#define XBAR_FLAT 0
#endif
#if XBAR_FLAT
#define GRID_BAR() do { xcd_barrier_flat(bar); REFRESH_LANE(); } while (0)
#else
#define GRID_BAR() do { xcd_barrier(bar); REFRESH_LANE(); } while (0)
#endif
#define GRID_BAR0() do { cg::this_grid().sync(); bar = xcd_barrier_post((unsigned*)(F.ctl + CW_BAR), F.MISC + 8); REFRESH_LANE(); } while (0)
#endif

#define P_x    (arg_in(0))
#define P_out  ((float*)arg_ptr(22))
#define P_CS   ((float*)(arg_ptr(23) + WS_CS))
#define P_WIN  ((bf16*)(arg_ptr(23) + WS_WIN))
#define P_WAP  ((bf16*)(arg_ptr(23) + WS_WAP))
#define P_WOUT ((bf16*)(arg_ptr(23) + WS_WOUT))
#define P_WGU  ((bf16*)(arg_ptr(23) + WS_WGU))
#define P_WD   ((bf16*)(arg_ptr(23) + WS_WD))
#define P_XN   ((bf16*)(arg_ptr(23) + WS_XN))
#define P_Y    ((bf16*)(arg_ptr(23) + WS_Y))
#define P_H    ((bf16*)(arg_ptr(23) + WS_H))
#define P_ZQ   ((bf16*)(arg_ptr(23) + WS_ZQ))
#define P_ZR   ((bf16*)(arg_ptr(23) + WS_ZR))
#define P_ZG   ((bf16*)(arg_ptr(23) + WS_ZG))
#define P_AO   ((bf16*)arg_ptr(22))
#define P_TT   ((float*)(arg_ptr(23) + WS_KVT))
#define P_PT   ((bf16*)(arg_ptr(22) + 32 * MiB))
#define P_ACAT ((bf16*)(arg_ptr(22) + 64 * MiB))
#define P_MG   ((bf16*)(arg_ptr(23) + WS_MG))
#define P_RS   ((float*)(arg_ptr(23) + WS_RS))
    LAS float* scr = (LAS float*)(F.lds + RING_OFF + F.wave * 16384);
    const int gw = F.vcu * NWAVES + F.wave, NGW = F.G * NWAVES;

#ifndef PROBE
#define PROBE 0
#endif

#define PROBE_DUMP(buf, ld, c0) do { for (int m_ = gw; m_ < M; m_ += NGW) { const bf16* s_ = (buf) + (size_t)m_ * (ld) + (c0); float* o_ = P_out + (size_t)m_ * D; \
        for (int c_ = F.lane; c_ < D; c_ += 64) o_[c_] = __uint_as_float((unsigned)s_[c_] << 16); } return; } while (0)
    {
        constexpr int I_GU = (D / 64) * (FF / 32), I_DN = (FF / 64) * (D / 32), I_IN = (D / 64) * (DIN / 32), I_PJ = (512 / 64) * (D / 32), I_O = (D / 64) * (D / 32);
        constexpr int NITEMS = 2 * I_GU + I_DN + I_IN + 2 * I_PJ + I_O;
        REP_BEGIN(101)
        for (int it = gw; it < NITEMS; it += NGW) {
            int r = it;
            if (r < I_GU) { transpose_item(arg_in(2), D, FF, P_WGU, 1, scr, r, F.lane, 0, 0, arg_in(1), -1.4426950408889634f); continue; } r -= I_GU;
            if (r < I_GU) { transpose_item(arg_in(3), D, FF, P_WGU, 2, scr, r, F.lane, 0, 0, arg_in(1), -0.6931471805599453f); continue; } r -= I_GU;
            if (r < I_DN) { transpose_item(arg_in(4), FF, D, P_WD, 0, scr, r, F.lane); continue; } r -= I_DN;
            if (r < I_IN) { transpose_item(arg_in(7), D, DIN, P_WIN, 3, scr, r, F.lane, 0, 0, arg_in(6)); continue; } r -= I_IN;
            if (r < I_PJ) { transpose_item(arg_in(13), 512, D, P_WAP, 0, scr, r, F.lane, 1024, 0); continue; } r -= I_PJ;
            if (r < I_PJ) { transpose_item(arg_in(14), 512, D, P_WAP, 0, scr, r, F.lane, 1024, 512); continue; } r -= I_PJ;
            transpose_item(arg_in(15), D, D, P_WOUT, 0, scr, r, F.lane);
        }
        REP_END()
        REP_BEGIN(102)
        for (int idx = F.vcu * (NWAVES * 64) + F.tid; idx < T * 64; idx += F.G * NWAVES * 64) {
            const int t = idx >> 6, i = idx & 63;
            const float e = (i == 63) ? 1.0f : (float)i * (1.0f / 63.0f);
            const float ang = (float)t * (1.0f / powf(10000.0f, e));
            P_CS[2 * idx] = cosf(ang); P_CS[2 * idx + 1] = sinf(ang);
        }
        REP_END()
        REP_BEGIN(103)
        row_phase<false, false, false, true>(F, P_x, nullptr, nullptr, nullptr, nullptr, 0.f, nullptr, P_XN, P_RS);
        REP_END()
    }
    GRID_BAR0();

#define FUSED_GEMM(TWO_, A_, Bt_, K_, base_, out_, xn_, gpost_, gnext_, scale_, inst_) do { \
        _Pragma("nounroll") for (int half_ = 0; half_ < 2; ++half_) { const size_t r0_ = (size_t)half_ * (M / 2); \
            pg8::Gemm g{(A_) + r0_ * (K_), (Bt_), M / 2, D, (K_)}; pg8::StaticOrder S; S.init(M / 2, D, F.G, (int)blockIdx.x); \
            pg8::PanelSumsq st1_{(float*)(arg_ptr(23) + WS_XB + (size_t)(inst_) * XB_BYTES) + r0_ * 4, (unsigned*)(F.ctl + CW_SEAM) + (inst_) * SEAM_BANK + 64 * 64 * half_, (unsigned*)(F.ctl + CW_TMO), 1e-6f}; \
            pg8::PanelSumsq st2_{(float*)(arg_ptr(23) + WS_XB + (size_t)((inst_) + 1) * XB_BYTES) + r0_ * 4, (unsigned*)(F.ctl + CW_SEAM) + ((inst_) + 1) * SEAM_BANK + 64 * 64 * half_, (unsigned*)(F.ctl + CW_TMO), 1e-6f}; \
            pg8::EpiRmsRes<TWO_> E{(base_) + r0_ * D, (out_) + r0_ * D, (xn_) ? (xn_) + r0_ * D : nullptr, D, (gpost_), (gnext_), (scale_), st1_, st2_}; \
            pg8::gemm_phase<pg8::EpiRmsRes<TWO_>, pg8::StaticOrder, false, PG8_SP2>(F.lds + RING_OFF, g, S, E); } } while (0)
    REP_BEGIN(1)
    if (SKEW_TICKS) skew_delay(F.vcu, SKEW_TICKS);
    { pg8::Gemm g{P_XN, P_WGU, M, 2 * FF, D}; pg8::StaticOrder S; S.init(M, 2 * FF, F.G, (int)blockIdx.x);
#if TWICE == 1 && defined(TWICE_NULL_EPI)
      pg8::EpiSwiglu E{P_H, FF, rep_};
#else
      pg8::EpiSwiglu E{P_H, FF, 0};
#endif
      pg8::gemm_phase<pg8::EpiSwiglu, pg8::StaticOrder, PG8_ALIGN, PG8_SP2>(F.lds + RING_OFF, g, S, E); }
    GRID_BAR();
    REP_END()
    REP_BEGIN(2)
    { pg8::Gemm g{P_H, P_WD, M, D, FF, 1}; pg8::StaticOrder S; S.init(M, D, F.G, (int)blockIdx.x);
      pg8::EpiBf16<0> E{P_Y, D, nullptr, 0, 0, 1.f};
      pg8::gemm_phase<pg8::EpiBf16<0>, pg8::StaticOrder, PG8_ALIGN, PG8_SP2>(F.lds + RING_OFF, g, S, E); }
    GRID_BAR();
    REP_END()
    REP_BEGIN(3)
    row_phase<true, true, false, true>(F, nullptr, P_XN, P_RS, P_Y, arg_in(5), 0.5f, nullptr, P_XN, P_RS);
    GRID_BAR();
    REP_END()
#ifdef EXTRA_BARS
    for (int eb_ = 0; eb_ < EXTRA_BARS; ++eb_) GRID_BAR();
#endif
    REP_BEGIN(4)
    if (SKEW_TICKS) skew_delay(F.vcu, SKEW_TICKS);
    { pg8::Gemm g{P_XN, P_WIN, M, DIN, D}; pg8::StaticOrder S; S.init(M, DIN, F.G, (int)blockIdx.x);
      pg8::EpiWin E{P_ZQ, P_ZR, P_ZG, P_CS, attn_body::C2};
      pg8::gemm_phase<pg8::EpiWin, pg8::StaticOrder, PG8_ALIGN, PG8_SP2>(F.lds + RING_OFF, g, S, E); }
    GRID_BAR();
    REP_END()
#if PROBE == 40
    PROBE_DUMP(P_ZQ, 1536, 0);
#elif PROBE == 41
    PROBE_DUMP(P_ZR, 2048, 0);
#elif PROBE == 42
    PROBE_DUMP(P_ZR, 2048, 1024);
#elif PROBE == 43
    PROBE_DUMP(P_ZG, 2048, 0);
#endif
    REP_BEGIN(5)
    {
        REP_BEGIN(51)
        ret::r1_phase(F.lds + RING_OFF, P_ZR, P_PT, P_TT, F.vcu, F.G, F.wave, F.lane);
        REP_END()
        REP_BEGIN(52)
        const float s1_ = wave_sum(arg_in(8)[F.lane] * arg_in(9)[F.lane]), s2_ = wave_sum(arg_in(10)[F.lane] * arg_in(11)[F.lane]);
        const attn_body::AttnTensors AT{(const attn_body::bf16*)P_ZQ, (attn_body::bf16*)P_AO, (attn_body::bf16*)P_ACAT, expf(s1_) - expf(s2_) + 0.2f, 0.8f, arg_in(12)};
        const attn_body::StaticOrder S((int)F.G, (int)blockIdx.x);
        attn_body::attn_phase<attn_body::StaticOrder>((char*)lds + RING_OFF, AT, S);
        REP_END()
    }
    GRID_BAR();
    REP_END()
#if PROBE == 5
    PROBE_DUMP(P_AO, 1024, 0);
#endif
    REP_BEGIN(7)
    ret::r3_phase(F.lds + RING_OFF, P_ZR, P_PT, P_TT, P_ACAT, 1024, 512, F.vcu, F.G, F.wave, F.lane);
    GRID_BAR();
    REP_END()
#if PROBE == 7
    PROBE_DUMP(P_ACAT, 1024, 0);
#endif
    REP_BEGIN(8)
    if (P8_SKEW_TICKS) skew_delay(F.vcu, P8_SKEW_TICKS);
    { pg8::Gemm g{P_ACAT, P_WAP, M, D, D}; pg8::StaticOrder S; S.init(M, D, F.G, (int)blockIdx.x);
      pg8::EpiGateCat E{P_MG, D, P_ZG, 2048};
      pg8::gemm_phase<pg8::EpiGateCat, pg8::StaticOrder, PG8_ALIGN, PG8_SP2>(F.lds + RING_OFF, g, S, E); }
    GRID_BAR();
    REP_END()
#if PROBE == 8
    PROBE_DUMP(P_MG, 1024, 0);
#endif
    REP_BEGIN(9)
    { pg8::Gemm g{P_MG, P_WOUT, M, D, D}; pg8::StaticOrder S; S.init(M, D, F.G, (int)blockIdx.x);
      pg8::EpiBf16<0> E{P_Y, D, nullptr, 0, 0, 1.f};
      pg8::gemm_phase<pg8::EpiBf16<0>, pg8::StaticOrder, PG8_ALIGN, PG8_SP2>(F.lds + RING_OFF, g, S, E); }
    GRID_BAR();
    REP_END()
    {
        constexpr int I_GU = (D / 64) * (FF / 32), I_DN = (FF / 64) * (D / 32);
        for (int it = gw; it < 2 * I_GU + I_DN; it += NGW) {
            int r = it;
            if (r < I_GU) { transpose_item(arg_in(18), D, FF, P_WGU, 1, scr, r, F.lane, 0, 0, arg_in(17), -1.4426950408889634f); continue; } r -= I_GU;
            if (r < I_GU) { transpose_item(arg_in(19), D, FF, P_WGU, 2, scr, r, F.lane, 0, 0, arg_in(17), -0.6931471805599453f); continue; } r -= I_GU;
            transpose_item(arg_in(20), FF, D, P_WD, 0, scr, r, F.lane);
        }
        row_phase<true, true, false, true>(F, nullptr, P_XN, P_RS, P_Y, arg_in(16), 1.0f, nullptr, P_XN, P_RS);
    }
    GRID_BAR();
    if (SKEW_TICKS) skew_delay(F.vcu, SKEW_TICKS);
    { pg8::Gemm g{P_XN, P_WGU, M, 2 * FF, D}; pg8::StaticOrder S; S.init(M, 2 * FF, F.G, (int)blockIdx.x);
      pg8::EpiSwiglu E{P_H, FF, 0};
      pg8::gemm_phase<pg8::EpiSwiglu, pg8::StaticOrder, PG8_ALIGN, PG8_SP2>(F.lds + RING_OFF, g, S, E); }
    GRID_BAR();
    { pg8::Gemm g{P_H, P_WD, M, D, FF, 1}; pg8::StaticOrder S; S.init(M, D, F.G, (int)blockIdx.x);
      pg8::EpiBf16<0> E{P_Y, D, nullptr, 0, 0, 1.f};
      pg8::gemm_phase<pg8::EpiBf16<0>, pg8::StaticOrder, PG8_ALIGN, PG8_SP2>(F.lds + RING_OFF, g, S, E); }
    GRID_BAR();
    row_phase<true, true, true, false>(F, nullptr, P_XN, P_RS, P_Y, arg_in(21), 0.5f, P_out, nullptr, nullptr);
#if BAR_MODE != 0
    if ((__hip_atomic_load((unsigned*)(F.ctl + CW_BAR) + XB_TMO, __ATOMIC_RELAXED, __HIP_MEMORY_SCOPE_AGENT) | __hip_atomic_load((unsigned*)(F.ctl + CW_TMO), __ATOMIC_RELAXED, __HIP_MEMORY_SCOPE_AGENT)) != 0u) {
        const float qn = __builtin_nanf(""); for (int m = gw; m < M; m += NGW) P_out[(size_t)m * D + F.lane] = qn; }
#endif
#undef GRID_BAR
}

extern "C" void kernel_launch(void* const* d_in, const int* in_sizes, int n_in, void* d_out, int out_size, void* d_ws, size_t ws_size, hipStream_t stream) {
    static int grid = 0;
    if (grid == 0) {
        if (n_in != 22 || in_sizes[0] != M * D || out_size != M * D || ws_size < WS_END) { fprintf(stderr, "kernel_launch: built for 22 inputs, x and out of %d floats, >= %zu bytes of workspace; got n_in %d, in0 %d, out %d, ws %zu; nothing launched\n", M * D, (size_t)WS_END, n_in, n_in > 0 ? in_sizes[0] : -1, out_size, ws_size); grid = -1; return; }
        int dev = 0, cus = 0, per_cu = 0;
        if (hipGetDevice(&dev) != hipSuccess || hipDeviceGetAttribute(&cus, hipDeviceAttributeMultiprocessorCount, dev) != hipSuccess) { fprintf(stderr, "kernel_launch: hipGetDevice / hipDeviceGetAttribute failed; nothing launched\n"); grid = -1; return; }
        if (hipFuncSetAttribute((const void*)layer_fwd, hipFuncAttributeMaxDynamicSharedMemorySize, LDS_BYTES) != hipSuccess) { fprintf(stderr, "kernel_launch: hipFuncSetAttribute failed; nothing launched\n"); grid = -1; return; }
        if (hipOccupancyMaxActiveBlocksPerMultiprocessor(&per_cu, (const void*)layer_fwd, NWAVES * 64, LDS_BYTES) != hipSuccess || per_cu < 1)
            fprintf(stderr, "kernel_launch: note: the occupancy query reports %d workgroups per CU\n", per_cu);
        (void)hipGetLastError();
        grid = cus * (per_cu < 1 ? 1 : per_cu); if (grid > 256) grid = 256; grid &= ~7;
        if (grid < 8) { fprintf(stderr, "kernel_launch: needs at least 8 co-resident workgroups; the occupancy query gives %d x %d; nothing launched\n", cus, per_cu); grid = -1; return; }
    }
    if (grid < 0) return;
#if BAR_MODE == 3
    if (hipMemsetAsync((char*)d_ws + WS_CTL, 0, CTL_ZERO_BYTES, stream) != hipSuccess) { fprintf(stderr, "kernel_launch: hipMemsetAsync of the control words failed; nothing launched\n"); return; }
#endif
    Args a{};
    for (int i = 0; i < 22; ++i) a.in[i] = (const float*)d_in[i];
    a.out = (float*)d_out; a.ws = (unsigned char*)d_ws;
    void* kargs[] = {&a};
    const hipError_t le = hipLaunchCooperativeKernel((const void*)layer_fwd, dim3(grid), dim3(NWAVES * 64), kargs, LDS_BYTES, stream);
    if (le != hipSuccess) fprintf(stderr, "kernel_launch: launch failed: %s (grid %d x %d threads, %d B LDS)\n", hipGetErrorName(le), grid, NWAVES * 64, LDS_BYTES);
}
```

```cpp
#define BAR_MODE 2
#include <hip/hip_runtime.h>
#include <hip/hip_bf16.h>
#include <hip/hip_cooperative_groups.h>
namespace cg = cooperative_groups;
#ifndef BAR_MODE
#define BAR_MODE 0
#endif
#include <cstdio>
#include <cstdint>
#include <cmath>
namespace pg8 {
#define PG8_LAS __attribute__((address_space(3)))
typedef unsigned short bf16_t;
typedef short bf16x8 __attribute__((ext_vector_type(8)));
typedef float f32x4 __attribute__((ext_vector_type(4)));
typedef unsigned u32x4 __attribute__((ext_vector_type(4)));
constexpr int BM = 256, BK = 64, HALF = 128, HTB = HALF * BK * 2  , STAGE_BYTES = 8 * HTB, NXCD = 8, WGM = 4;

__host__ __device__ __forceinline__ int lds_byte(int r, int c) { const int st = (r >> 4) * 2 + (c >> 5), rr = r & 15, cc = c & 31, ob = rr * 64 + cc * 2; return st * 1024 + (ob ^ (((ob >> 9) & 1) << 5)); }
__host__ __device__ __forceinline__ void stage_rc(int b, int& R, int& C) { const int st = b / 1024, sb = b % 1024, swz = sb ^ (((sb >> 9) & 1) << 5); R = (st >> 1) * 16 + swz / 64; C = (st & 1) * 32 + (swz % 64) / 2; }
__host__ __device__ __forceinline__ int perm32(int rho) { const int n = rho >> 4, i = rho & 15; return 8 * (i >> 2) + 4 * n + (i & 3); }

struct Unit { int pm, pn; };
struct Gemm { const bf16_t* A; const bf16_t* Bt; int M, N, K; int a_tiled = 0; };

struct StaticOrder {
    int nM, nN, nwg, G, c;
    __host__ __device__ void init(int M, int N, int G_, int c_) { nM = M / BM; nN = N / BM; nwg = nM * nN; G = G_; c = c_; }
    __host__ __device__ bool next(int i, Unit& u) const {
        const long L = (long)i * G + c; if (L >= nwg) return false;
        int wgid = (int)L; { const int q = nwg / NXCD, r = nwg % NXCD, xcd = wgid % NXCD, off = wgid / NXCD; wgid = (xcd < r ? xcd * (q + 1) : r * (q + 1) + (xcd - r) * q) + off; }
        const int nig = WGM * nN, gid = wgid / nig, fm = gid * WGM, gsz = (nM - fm) < WGM ? (nM - fm) : WGM;
        u.pm = fm + ((wgid % nig) % gsz); u.pn = (wgid % nig) / gsz; return true;
    }
    __device__ __forceinline__ void a_ready(const Unit&) const {}
    __device__ __forceinline__ void done(const Unit&) const {}
};

__device__ __forceinline__ unsigned cvt_pk_bf16(float lo, float hi) { unsigned r; asm volatile("v_cvt_pk_bf16_f32 %0, %1, %2" : "=v"(r) : "v"(lo), "v"(hi)); return r; }
typedef float f32x2 __attribute__((ext_vector_type(2)));
__device__ __forceinline__ f32x2 gelu_pk(f32x2 v) {
    const f32x2 av = __builtin_elementwise_abs(v), d = av * 0.2316418882f + 1.0f;
    f32x2 t; t.x = __builtin_amdgcn_rcpf(d.x); t.y = __builtin_amdgcn_rcpf(d.y);
    f32x2 q = t * 0.5307027145f + (-0.7265760135f); q = q * t + 0.7107068705f; q = q * t + (-0.142248368f); q = q * t + 0.127414796f; q = q * t;
    const f32x2 s = (v * v) * (-0.72134752044f);
    f32x2 e; e.x = __builtin_amdgcn_exp2f(s.x); e.y = __builtin_amdgcn_exp2f(s.y);
    const f32x2 m = v * (q * e), r = v - m;
    f32x2 o; o.x = v.x < 0.f ? m.x : r.x; o.y = v.y < 0.f ? m.y : r.y; return o;
}

template <int ACT  > struct EpiBf16 {
    static constexpr bool PERM = true, AFTER_DRAIN = false; static constexpr int MID_T = -1; static_assert(ACT == 0 || ACT == 1, "EpiBf16: ACT is 0 (none) or 1 (gelu_pk)");
    bf16_t* O; int ldc; const float* bias; int split_cols; size_t split_stride; float scale0;
    __device__ __forceinline__ void operator()(const f32x4 (&acc)[2][2][4][2], const Unit& u, int wr, int wc, int fr, int fq) const {
        const int row0 = u.pm * BM + wr * 64 + fr; int colt = u.pn * BM; bf16_t* base = O;
        float sc = 1.f; if (split_cols) { const int t = colt / split_cols; base += (size_t)t * split_stride; colt -= t * split_cols; if (t == 0) sc = scale0; }
        const int col0 = colt + wc * 32 + 8 * fq, bcol0 = u.pn * BM + wc * 32 + 8 * fq;
        f32x4 bv[2][2];
#pragma unroll
        for (int bj = 0; bj < 2; ++bj)
#pragma unroll
            for (int n = 0; n < 2; ++n) bv[bj][n] = bias ? *(const f32x4*)(bias + bcol0 + bj * HALF + 4 * n) : (f32x4){0.f, 0.f, 0.f, 0.f};
#pragma unroll
        for (int ai = 0; ai < 2; ++ai)
#pragma unroll
            for (int m = 0; m < 4; ++m) { bf16_t* rowp = base + (size_t)(row0 + ai * HALF + m * 16) * ldc + col0;
#pragma unroll
                for (int bj = 0; bj < 2; ++bj) { f32x4 v0 = acc[ai][bj][m][0] + bv[bj][0], v1 = acc[ai][bj][m][1] + bv[bj][1];
                    if (ACT == 1) { f32x2 a = gelu_pk((f32x2){v0[0], v0[1]}), b = gelu_pk((f32x2){v0[2], v0[3]}), c = gelu_pk((f32x2){v1[0], v1[1]}), d = gelu_pk((f32x2){v1[2], v1[3]});
                        v0 = (f32x4){a.x, a.y, b.x, b.y}; v1 = (f32x4){c.x, c.y, d.x, d.y}; }
                    v0 = v0 * sc; v1 = v1 * sc; u32x4 w; w.x = cvt_pk_bf16(v0[0], v0[1]); w.y = cvt_pk_bf16(v0[2], v0[3]); w.z = cvt_pk_bf16(v1[0], v1[1]); w.w = cvt_pk_bf16(v1[2], v1[3]);
                    *(u32x4*)(rowp + bj * HALF) = w; } }
    }
};

template <class Epi, class Sched, bool ALIGN_EPI = false, bool SP2 = false>
__device__ __forceinline__ void gemm_phase(PG8_LAS unsigned char* lds, const Gemm g, const Sched& S, const Epi& E) {
    int tid_ = threadIdx.x; asm volatile("" : "+v"(tid_));
    const int tid = tid_, wid = __builtin_amdgcn_readfirstlane(tid >> 6), lane = tid & 63, wr = wid >> 2, wc = wid & 3, fr = lane & 15, fq = lane >> 4;
    const int K = g.K, nt = K / BK;
    unsigned voffA[2], voffB[2];
#pragma unroll
    for (int i = 0; i < 2; ++i) { int R, C; stage_rc(tid * 16 + i * 8192, R, C); const int Rb = Epi::PERM ? ((R & ~31) + perm32(R & 31)) : R;
        voffA[i] = g.a_tiled ? (unsigned)(R * BK + C) * 2u : (unsigned)(R * K + C) * 2u; voffB[i] = (unsigned)(Rb * K + C) * 2u; }
    const size_t kstep = (size_t)(BK * 2);
    const size_t hstep = (size_t)HALF * K * 2;
    const size_t tstep = 2 * hstep;
    const size_t kstepA = g.a_tiled ? (size_t)BM * BK * 2 : kstep, hstepA = g.a_tiled ? (size_t)HALF * BK * 2 : hstep, tstepA = g.a_tiled ? (size_t)nt * BM * BK * 2 : tstep;
    const unsigned ldsw = (unsigned)wid * 1024u;
    const int aoff = lds_byte(wr * 64 + fr, fq * 8), boff = lds_byte(wc * 32 + fr, fq * 8);
#define PG8_SA(b, h) (((b) * 2 + (h)) * HTB)
#define PG8_SB(b, h) ((4 + (b) * 2 + (h)) * HTB)
#define PG8_STAGE(bufoff, gbase, voff) do { _Pragma("unroll") for (int _i = 0; _i < 2; ++_i) \
        __builtin_amdgcn_global_load_lds((const unsigned*)((const char*)(gbase) + (voff)[_i]), (PG8_LAS unsigned*)(lds + (bufoff) + ldsw + _i * 8192), 16, 0, 0); } while (0)
#define PG8_LDA(dst, b, h) do { _Pragma("unroll") for (int m = 0; m < 4; ++m) _Pragma("unroll") for (int k = 0; k < 2; ++k) dst[m][k] = *(const PG8_LAS bf16x8*)(lds + PG8_SA(b, h) + aoff + m * 2048 + k * 1024); } while (0)
#define PG8_LDB(dst, b, h) do { _Pragma("unroll") for (int n = 0; n < 2; ++n) _Pragma("unroll") for (int k = 0; k < 2; ++k) dst[n][k] = *(const PG8_LAS bf16x8*)(lds + PG8_SB(b, h) + boff + n * 2048 + k * 1024); } while (0)
#define PG8_MMA(ai, bj, At, Bt) do { __builtin_amdgcn_s_setprio(1); _Pragma("unroll") for (int m = 0; m < 4; ++m) _Pragma("unroll") for (int n = 0; n < 2; ++n) _Pragma("unroll") for (int k = 0; k < 2; ++k) \
        acc[ai][bj][m][n] = __builtin_amdgcn_mfma_f32_16x16x32_bf16(Bt[n][k], At[m][k], acc[ai][bj][m][n], 0, 0, 0); __builtin_amdgcn_s_setprio(0); } while (0)
#define PG8_WAIT_V(n) asm volatile("s_waitcnt vmcnt(" #n ")" ::: "memory")
#define PG8_WAIT_L(n) asm volatile("s_waitcnt lgkmcnt(" #n ")" ::: "memory")
#define PG8_BAR __builtin_amdgcn_s_barrier()
#define PG8_SCHED __builtin_amdgcn_sched_barrier(0)
    Unit cur, nxt; int ui = 0;
    if (!S.next(0, cur)) return;
    f32x4 acc[2][2][4][2];
#pragma unroll
    for (int a = 0; a < 2; ++a)
#pragma unroll
        for (int b = 0; b < 2; ++b)
#pragma unroll
            for (int m = 0; m < 4; ++m)
#pragma unroll
                for (int n = 0; n < 2; ++n) acc[a][b][m][n] = (f32x4){0.f, 0.f, 0.f, 0.f};
    bf16x8 At[4][2], B0[2][2], B1[2][2];
    const char* cA = (const char*)g.A + (size_t)cur.pm * tstepA; const char* cB = (const char*)g.Bt + (size_t)cur.pn * tstep;
    S.a_ready(cur);
    if constexpr (SP2) {
        PG8_STAGE(PG8_SB(0, 0), cB, voffB); PG8_STAGE(PG8_SB(0, 1), cB + hstep, voffB); PG8_STAGE(PG8_SA(0, 0), cA, voffA); PG8_STAGE(PG8_SA(0, 1), cA + hstepA, voffA);
        if (wr == 1) PG8_BAR;
        PG8_WAIT_V(2); PG8_BAR;
        PG8_STAGE(PG8_SB(1, 0), cB + kstep, voffB); PG8_STAGE(PG8_SA(1, 0), cA + kstepA, voffA); PG8_STAGE(PG8_SB(1, 1), cB + hstep + kstep, voffB);
        PG8_WAIT_V(6); PG8_BAR;
    } else {
        PG8_STAGE(PG8_SB(0, 0), cB, voffB); PG8_STAGE(PG8_SA(0, 0), cA, voffA); PG8_STAGE(PG8_SB(0, 1), cB + hstep, voffB); PG8_STAGE(PG8_SA(0, 1), cA + hstepA, voffA);
        if (wr == 1) PG8_BAR;
        PG8_WAIT_V(4); PG8_BAR;
        PG8_STAGE(PG8_SB(1, 0), cB + kstep, voffB); PG8_STAGE(PG8_SA(1, 0), cA + kstepA, voffA); PG8_STAGE(PG8_SB(1, 1), cB + hstep + kstep, voffB);
        PG8_WAIT_V(6); PG8_BAR;
    }
    for (;;) {
        const bool has_next = S.next(ui + 1, nxt);
        const char* nA = has_next ? (const char*)g.A + (size_t)nxt.pm * tstepA : cA; const char* nB = has_next ? (const char*)g.Bt + (size_t)nxt.pn * tstep : cB;
        for (int t = 0; t < nt; t += 2) {
            const bool last = (t == nt - 2);
            if constexpr (Epi::MID_T >= 0) { if (t == Epi::MID_T) E.mid(acc, cur, wr, wc, fr, fq); }
            const char* a1 = cA + (size_t)(t + 1) * kstepA;
            const char* a2 = last ? nA : cA + (size_t)(t + 2) * kstepA; const char* b2 = last ? nB : cB + (size_t)(t + 2) * kstep;
            const char* a3 = a2 + kstepA; const char* b3 = b2 + kstep;
            if (last && has_next) S.a_ready(nxt);
            if constexpr (SP2) {
            PG8_LDB(B0, 0, 0); PG8_LDB(B1, 0, 1); PG8_SCHED; PG8_LDA(At, 0, 0); PG8_STAGE(PG8_SA(1, 1), a1 + hstepA, voffA);
            PG8_WAIT_V(8); PG8_WAIT_L(0); PG8_BAR; PG8_MMA(0, 0, At, B0); PG8_MMA(0, 1, At, B1); PG8_BAR; PG8_SCHED;
            PG8_LDA(At, 0, 1); PG8_STAGE(PG8_SB(0, 0), b2, voffB); PG8_STAGE(PG8_SB(0, 1), b2 + hstep, voffB); PG8_STAGE(PG8_SA(0, 0), a2, voffA);
            PG8_WAIT_V(8); PG8_WAIT_L(0); PG8_BAR; PG8_MMA(1, 0, At, B0); PG8_MMA(1, 1, At, B1); PG8_BAR; PG8_SCHED;
            PG8_LDB(B0, 1, 0); PG8_LDB(B1, 1, 1); PG8_SCHED; PG8_LDA(At, 1, 0); PG8_STAGE(PG8_SA(0, 1), a2 + hstepA, voffA);
            PG8_WAIT_V(8); PG8_WAIT_L(0); PG8_BAR; PG8_MMA(0, 0, At, B0); PG8_MMA(0, 1, At, B1); PG8_BAR; PG8_SCHED;
            PG8_LDA(At, 1, 1); PG8_STAGE(PG8_SB(1, 0), b3, voffB); PG8_STAGE(PG8_SB(1, 1), b3 + hstep, voffB); PG8_STAGE(PG8_SA(1, 0), a3, voffA);
            PG8_WAIT_V(8); PG8_WAIT_L(0); PG8_BAR; PG8_MMA(1, 0, At, B0); PG8_MMA(1, 1, At, B1); PG8_BAR; PG8_SCHED;
            } else {
            PG8_LDB(B0, 0, 0); PG8_SCHED; PG8_LDA(At, 0, 0); PG8_STAGE(PG8_SA(1, 1), a1 + hstepA, voffA);
            PG8_WAIT_L(8); PG8_BAR; PG8_WAIT_L(0); PG8_MMA(0, 0, At, B0); PG8_BAR; PG8_SCHED;
            PG8_LDB(B1, 0, 1); PG8_STAGE(PG8_SB(0, 0), b2, voffB);
            PG8_BAR; PG8_WAIT_L(0); PG8_MMA(0, 1, At, B1); PG8_BAR;
            PG8_LDA(At, 0, 1); PG8_STAGE(PG8_SA(0, 0), a2, voffA);
            PG8_BAR; PG8_WAIT_L(0); PG8_MMA(1, 0, At, B0); PG8_BAR; PG8_SCHED;
            PG8_STAGE(PG8_SB(0, 1), b2 + hstep, voffB);
            PG8_WAIT_V(6); PG8_BAR; PG8_MMA(1, 1, At, B1); PG8_BAR;
            PG8_LDB(B0, 1, 0); PG8_SCHED; PG8_LDA(At, 1, 0); PG8_STAGE(PG8_SA(0, 1), a2 + hstepA, voffA);
            PG8_WAIT_L(8); PG8_BAR; PG8_WAIT_L(0); PG8_MMA(0, 0, At, B0); PG8_BAR; PG8_SCHED;
            PG8_LDB(B1, 1, 1); PG8_STAGE(PG8_SB(1, 0), b3, voffB);
            PG8_BAR; PG8_WAIT_L(0); PG8_MMA(0, 1, At, B1); PG8_BAR;
            PG8_LDA(At, 1, 1); PG8_STAGE(PG8_SA(1, 0), a3, voffA);
            PG8_BAR; PG8_WAIT_L(0); PG8_MMA(1, 0, At, B0); PG8_BAR; PG8_SCHED;
            PG8_STAGE(PG8_SB(1, 1), b3 + hstep, voffB);
            PG8_WAIT_V(6); PG8_BAR; PG8_MMA(1, 1, At, B1); PG8_BAR;
            }
        }
        if constexpr (ALIGN_EPI) { if (wr == 0) PG8_BAR; }
        if constexpr (!Epi::AFTER_DRAIN) { E(acc, cur, wr, wc, fr, fq); S.done(cur); }
        if (!has_next) break;
#pragma unroll
        for (int a = 0; a < 2; ++a)
#pragma unroll
            for (int b = 0; b < 2; ++b)
#pragma unroll
                for (int m = 0; m < 4; ++m)
#pragma unroll
                    for (int n = 0; n < 2; ++n) acc[a][b][m][n] = (f32x4){0.f, 0.f, 0.f, 0.f};
        cur = nxt; cA = nA; cB = nB; ++ui;
        if constexpr (ALIGN_EPI) { if (wr == 1) PG8_BAR; }
    }
    PG8_WAIT_V(0);
    if constexpr (!ALIGN_EPI) { if (wr == 0) PG8_BAR; }
    PG8_BAR;
    if constexpr (Epi::AFTER_DRAIN) { E.fused(acc, cur, wr, wc, fr, fq, lds, wid, lane); S.done(cur); }
#undef PG8_SA
#undef PG8_SB
#undef PG8_STAGE
#undef PG8_LDA
#undef PG8_LDB
#undef PG8_MMA
#undef PG8_WAIT_V
#undef PG8_WAIT_L
#undef PG8_BAR
#undef PG8_SCHED
}
}

#ifndef PG8_SP2
#define PG8_SP2 true
#endif
#ifndef PG8_ALIGN
#define PG8_ALIGN true
#endif
namespace pg8 {
__device__ __forceinline__ float bf_lo(unsigned w) { return __uint_as_float(w << 16); }
__device__ __forceinline__ float bf_hi(unsigned w) { return __uint_as_float(w & 0xffff0000u); }
__device__ __forceinline__ float sigmoid_f(float v) { return __builtin_amdgcn_rcpf(1.0f + __builtin_amdgcn_exp2f(-1.4426950408889634f * v)); }
__device__ __forceinline__ u32x4 pack8(const f32x4 v0, const f32x4 v1) { u32x4 w; w.x = cvt_pk_bf16(v0[0], v0[1]); w.y = cvt_pk_bf16(v0[2], v0[3]); w.z = cvt_pk_bf16(v1[0], v1[1]); w.w = cvt_pk_bf16(v1[2], v1[3]); return w; }

struct EpiSwiglu {
    static constexpr bool PERM = true, AFTER_DRAIN = false; static constexpr int MID_T = -1;
    bf16_t* H; int ldh; int skip;
    __device__ __forceinline__ void operator()(const f32x4 (&acc)[2][2][4][2], const Unit& u, int wr, int wc, int fr, int fq) const {
        if (skip) return;
        const int r0 = wr * 64 + fr, col0 = u.pn * HALF + wc * 32 + 8 * fq;
        bf16_t* tile = H + ((size_t)u.pm * (ldh / 64) + (col0 >> 6)) * (BM * 64) + (col0 & 63);
#pragma unroll
        for (int ai = 0; ai < 2; ++ai)
#pragma unroll
            for (int m = 0; m < 4; ++m) { bf16_t* rowp = tile + (size_t)(r0 + ai * HALF + m * 16) * 64;
                f32x4 h[2];
#pragma unroll
                for (int n = 0; n < 2; ++n)
#pragma unroll
                    for (int i = 0; i < 4; ++i) { const float g = acc[ai][0][m][n][i], up = acc[ai][1][m][n][i]; h[n][i] = (g * up) * __builtin_amdgcn_rcpf(1.0f + __builtin_amdgcn_exp2f(g)); }
                __builtin_nontemporal_store(pack8(h[0], h[1]), (u32x4*)rowp); }
    }
};

struct EpiWin {
    static constexpr bool PERM = true, AFTER_DRAIN = false; static constexpr int MID_T = -1;
    bf16_t *ZQ, *ZR, *ZG; const float* cs; float c2;
    __device__ __forceinline__ void operator()(const f32x4 (&acc)[2][2][4][2], const Unit& u, int wr, int wc, int fr, int fq) const {
        const int pn = u.pn, row0 = u.pm * BM + wr * 64 + fr;
        bf16_t* base; int ld, colt, mode;
        if (pn < 6) { base = ZQ; ld = 1536; colt = 256 * pn; mode = pn < 2 ? 1 : 0; }
        else if (pn < 14) { base = ZR; ld = 2048; colt = 256 * (pn - 6); mode = pn < 8 ? 2 : pn < 10 ? 3 : pn < 12 ? 0 : 4; }
        else { base = ZG; ld = 2048; colt = 256 * (pn - 14); mode = 5; }
        const int col0 = colt + wc * 32 + 8 * fq;
        if (mode == 2 || mode == 3) {
            f32x4 csv[2][4][2];
#pragma unroll
            for (int ai = 0; ai < 2; ++ai)
#pragma unroll
                for (int m = 0; m < 4; ++m) { const int t = (row0 + ai * HALF + m * 16) & 4095; const f32x4* cp = (const f32x4*)(cs + ((size_t)t * 64 + 16 * wc + 4 * fq) * 2); csv[ai][m][0] = cp[0]; csv[ai][m][1] = cp[1]; }
#pragma unroll
            for (int ai = 0; ai < 2; ++ai)
#pragma unroll
                for (int m = 0; m < 4; ++m) { const int row = row0 + ai * HALF + m * 16; bf16_t* rowp = base + (size_t)row * ld + col0; const int t = row & 4095;
                    const f32x4 cs0 = csv[ai][m][0], cs1 = csv[ai][m][1];
#pragma unroll
                    for (int bj = 0; bj < 2; ++bj) { const f32x4 v0 = acc[ai][bj][m][0], v1 = acc[ai][bj][m][1];
                        float sc = 1.f;
                        if (mode == 3) { const int h = 2 * (pn - 8) + bj; const float l2g = __builtin_log2f(1.0f - __builtin_exp2f(-5.0f - (float)h));
                            sc = 0.08838834764831845f * __builtin_exp2f(-(float)(t & 127) * l2g); }
                        f32x4 o0, o1;
                        o0[0] = (v0[0] * cs0[0] - v0[1] * cs0[1]) * sc; o0[1] = (v0[1] * cs0[0] + v0[0] * cs0[1]) * sc;
                        o0[2] = (v0[2] * cs0[2] - v0[3] * cs0[3]) * sc; o0[3] = (v0[3] * cs0[2] + v0[2] * cs0[3]) * sc;
                        o1[0] = (v1[0] * cs1[0] - v1[1] * cs1[1]) * sc; o1[1] = (v1[1] * cs1[0] + v1[0] * cs1[1]) * sc;
                        o1[2] = (v1[2] * cs1[2] - v1[3] * cs1[3]) * sc; o1[3] = (v1[3] * cs1[2] + v1[2] * cs1[3]) * sc;
                        __builtin_nontemporal_store(pack8(o0, o1), (u32x4*)(rowp + bj * HALF)); } }
            return;
        }
#pragma unroll
        for (int ai = 0; ai < 2; ++ai)
#pragma unroll
            for (int m = 0; m < 4; ++m) { const int row = row0 + ai * HALF + m * 16; bf16_t* rowp = base + (size_t)row * ld + col0;
#pragma unroll
                for (int bj = 0; bj < 2; ++bj) { f32x4 v0 = acc[ai][bj][m][0], v1 = acc[ai][bj][m][1];
                    if (mode == 1) { v0 = v0 * c2; v1 = v1 * c2; }
                    else if (mode == 4) {
#pragma unroll
                        for (int i = 0; i < 4; ++i) { v0[i] = v0[i] * sigmoid_f(v0[i]); v1[i] = v1[i] * sigmoid_f(v1[i]); } }
                    if (mode == 5) continue;
                    __builtin_nontemporal_store(pack8(v0, v1), (u32x4*)(rowp + bj * HALF)); }
                if (mode == 5) {
                    f32x4 r0, r1, s0, s1;
#pragma unroll
                    for (int i = 0; i < 4; ++i) { const float ea0 = __builtin_amdgcn_exp2f(acc[ai][0][m][0][i]); float er0 = __builtin_amdgcn_exp2f(acc[ai][1][m][0][i]);
                        const float ea1 = __builtin_amdgcn_exp2f(acc[ai][0][m][1][i]); float er1 = __builtin_amdgcn_exp2f(acc[ai][1][m][1][i]);
                        er0 = __builtin_fminf(er0, 1.0e18f); er1 = __builtin_fminf(er1, 1.0e18f);
                        s0[i] = __builtin_amdgcn_rcpf(1.0f + er0); s1[i] = __builtin_amdgcn_rcpf(1.0f + er1);
                        r0[i] = (1.0f + er0) * __builtin_amdgcn_rcpf(1.0f + ea0); r1[i] = (1.0f + er1) * __builtin_amdgcn_rcpf(1.0f + ea1); }
                    bf16_t* gp = ZG + (size_t)row * 2048 + 128 * (pn - 14) + wc * 32 + 8 * fq;
                    __builtin_nontemporal_store(pack8(r0, r1), (u32x4*)gp); __builtin_nontemporal_store(pack8(s0, s1), (u32x4*)(gp + 1024)); } }
    }
};

struct EpiGateCat {
    static constexpr bool PERM = true, AFTER_DRAIN = false; static constexpr int MID_T = 8;
    bf16_t* O; int ldo; const bf16_t* gate; int ldg;
    __device__ __forceinline__ void mid(f32x4 (&acc)[2][2][4][2], const Unit& u, int, int, int, int) const {
        int t_ = threadIdx.x; asm volatile("" : "+v"(t_));
        const int wid_ = t_ >> 6, wr = wid_ >> 2, wc = wid_ & 3, fr = t_ & 15, fq = (t_ & 63) >> 4;
        const int row0 = u.pm * BM + wr * 64 + fr, col0 = u.pn * BM + wc * 32 + 8 * fq;
#pragma unroll
        for (int ai = 0; ai < 2; ++ai) { u32x4 g[4][2];
#pragma unroll
            for (int m = 0; m < 4; ++m) { const bf16_t* gp = gate + (size_t)(row0 + ai * HALF + m * 16) * ldg + col0; g[m][0] = *(const u32x4*)gp; g[m][1] = *(const u32x4*)(gp + HALF); }
#pragma unroll
            for (int m = 0; m < 4; ++m)
#pragma unroll
                for (int bj = 0; bj < 2; ++bj) { const u32x4 a = g[m][bj]; f32x4& v0 = acc[ai][bj][m][0]; f32x4& v1 = acc[ai][bj][m][1];
                    v0[0] *= bf_lo(a.x); v0[1] *= bf_hi(a.x); v0[2] *= bf_lo(a.y); v0[3] *= bf_hi(a.y);
                    v1[0] *= bf_lo(a.z); v1[1] *= bf_hi(a.z); v1[2] *= bf_lo(a.w); v1[3] *= bf_hi(a.w); }
            asm volatile("" ::: "memory"); }
    }
    __device__ __forceinline__ void operator()(const f32x4 (&acc)[2][2][4][2], const Unit& u, int wr, int wc, int fr, int fq) const {
        const int row0 = u.pm * BM + wr * 64 + fr, col0 = u.pn * BM + wc * 32 + 8 * fq;
#pragma unroll
        for (int ai = 0; ai < 2; ++ai) { u32x4 g[4][2];
#pragma unroll
            for (int m = 0; m < 4; ++m) { const bf16_t* gp = gate + (size_t)(row0 + ai * HALF + m * 16) * ldg + 1024 + col0; g[m][0] = *(const u32x4*)gp; g[m][1] = *(const u32x4*)(gp + HALF); }
#pragma unroll
            for (int m = 0; m < 4; ++m) { const size_t row = (size_t)(row0 + ai * HALF + m * 16);
#pragma unroll
                for (int bj = 0; bj < 2; ++bj) { const int c = col0 + bj * HALF; const u32x4 a = g[m][bj];
                    f32x4 v0 = acc[ai][bj][m][0], v1 = acc[ai][bj][m][1];
                    v0[0] *= bf_lo(a.x); v0[1] *= bf_hi(a.x); v0[2] *= bf_lo(a.y); v0[3] *= bf_hi(a.y);
                    v1[0] *= bf_lo(a.z); v1[1] *= bf_hi(a.z); v1[2] *= bf_lo(a.w); v1[3] *= bf_hi(a.w);
                    *(u32x4*)(O + row * ldo + c) = pack8(v0, v1); } }
            asm volatile("" ::: "memory"); }
    }
};

struct PanelSumsq {
    float* xbuf;
    unsigned* cnt;
    unsigned* tmo;
    float eps;
    __device__ __forceinline__ bool run(const f32x4 (&v)[2][2][4][2], const Unit& u, int wr, int wc, int fr, int fq, PG8_LAS unsigned char* lds, int wid, int lane) const {
        PG8_LAS float* P = (PG8_LAS float*)lds;
        PG8_LAS float* S = (PG8_LAS float*)(lds + 8192);
        PG8_LAS unsigned* flag = (PG8_LAS unsigned*)(lds + 8192 + 2048);
#pragma unroll
        for (int ai = 0; ai < 2; ++ai)
#pragma unroll
            for (int m = 0; m < 4; ++m) {
                float q = 0.f;
#pragma unroll
                for (int bj = 0; bj < 2; ++bj)
#pragma unroll
                    for (int n = 0; n < 2; ++n) { const f32x4 x = v[ai][bj][m][n]; q += (x[0] * x[0] + x[1] * x[1]) + (x[2] * x[2] + x[3] * x[3]); }
                q += __shfl_xor(q, 16); q += __shfl_xor(q, 32);
                if (fq == 0) P[(ai * HALF + wr * 64 + m * 16 + fr) * 4 + wc] = q;
            }
        asm volatile("s_waitcnt lgkmcnt(0)" ::: "memory"); __builtin_amdgcn_s_barrier(); asm volatile("" ::: "memory");
        const int row = wid * 32 + (lane & 31);
        if (lane < 32) {
            const float t = (P[row * 4 + 0] + P[row * 4 + 1]) + (P[row * 4 + 2] + P[row * 4 + 3]);
            __hip_atomic_store((unsigned*)xbuf + ((size_t)(u.pm * BM + row) * 4 + u.pn), __float_as_uint(t), __ATOMIC_RELAXED, __HIP_MEMORY_SCOPE_AGENT);
        }
        asm volatile("s_waitcnt vmcnt(0)" ::: "memory");
        if (lane == 0) __hip_atomic_fetch_add(cnt + 64 * u.pm, 1u, __ATOMIC_RELAXED, __HIP_MEMORY_SCOPE_AGENT);
        if (wid == 0) {
            bool dead = false; const unsigned long long t0 = __builtin_amdgcn_s_memrealtime();
            for (;;) {
                if ((unsigned)__builtin_amdgcn_readfirstlane(__hip_atomic_load(cnt + 64 * u.pm, __ATOMIC_RELAXED, __HIP_MEMORY_SCOPE_AGENT)) >= 32u) break;
                if (__builtin_amdgcn_s_memrealtime() - t0 > 2000000ull) { if (lane == 0) __hip_atomic_store(tmo, 1u, __ATOMIC_RELAXED, __HIP_MEMORY_SCOPE_AGENT); dead = true; break; }
                __builtin_amdgcn_s_sleep(2);
            }
            __builtin_amdgcn_fence(__ATOMIC_ACQUIRE, "agent");
            if (lane == 0) flag[0] = dead ? 1u : 0u;
        }
        asm volatile("s_waitcnt vmcnt(0) lgkmcnt(0)" ::: "memory"); __builtin_amdgcn_s_barrier(); asm volatile("" ::: "memory");
        const bool bad = flag[0] != 0u;
        if (lane < 32) {
            const unsigned* slot = (const unsigned*)xbuf + (size_t)(u.pm * BM + row) * 4; float tot = 0.f;
#pragma unroll
            for (int t = 0; t < 4; ++t) tot += __uint_as_float(__hip_atomic_load(slot + t, __ATOMIC_RELAXED, __HIP_MEMORY_SCOPE_AGENT));
            S[row] = 1.0f / sqrtf(tot * (1.0f / 1024.0f) + eps);
        }
        asm volatile("s_waitcnt lgkmcnt(0)" ::: "memory"); __builtin_amdgcn_s_barrier(); asm volatile("" ::: "memory");
        return bad;
    }
};
template <bool TWO> struct EpiRmsRes {
    static constexpr bool PERM = false, AFTER_DRAIN = true; static constexpr int MID_T = -1;
    const float* base; float* out; bf16_t* xn; int ldc; const float* gpost; const float* gnext; float scale; PanelSumsq st1, st2;
    __device__ __forceinline__ void fused(f32x4 (&acc)[2][2][4][2], const Unit& u, int wr, int wc, int fr, int fq, PG8_LAS unsigned char* lds, int wid, int lane) const {
        typedef unsigned u32x2v __attribute__((ext_vector_type(2)));
        const PG8_LAS float* S = (const PG8_LAS float*)(lds + 8192);
        const int col0 = u.pn * BM + wc * 32 + 4 * fq;
        (void)st1.run(acc, u, wr, wc, fr, fq, lds, wid, lane);
#pragma unroll
        for (int ai = 0; ai < 2; ++ai)
#pragma unroll
            for (int m = 0; m < 4; ++m) { const int r = ai * HALF + wr * 64 + m * 16 + fr; const float sr = S[r] * scale; const size_t off = (size_t)(u.pm * BM + r) * ldc + col0;
#pragma unroll
                for (int bj = 0; bj < 2; ++bj)
#pragma unroll
                    for (int n = 0; n < 2; ++n) { const f32x4 bs = *(const f32x4*)(base + off + bj * HALF + n * 16), g = *(const f32x4*)(gpost + col0 + bj * HALF + n * 16);
                        const f32x4 x1 = bs + acc[ai][bj][m][n] * sr * g; acc[ai][bj][m][n] = x1; if (!TWO) *(f32x4*)(out + off + bj * HALF + n * 16) = x1; }
                asm volatile("" : "+v"(acc[ai][0][m][0]), "+v"(acc[ai][0][m][1]), "+v"(acc[ai][1][m][0]), "+v"(acc[ai][1][m][1]));
                asm volatile("" ::: "memory"); }
        if (TWO) {
            (void)st2.run(acc, u, wr, wc, fr, fq, lds, wid, lane);
#pragma unroll
            for (int ai = 0; ai < 2; ++ai)
#pragma unroll
                for (int m = 0; m < 4; ++m) { const int r = ai * HALF + wr * 64 + m * 16 + fr; const float sr = S[r]; const size_t off = (size_t)(u.pm * BM + r) * ldc + col0;
#pragma unroll
                    for (int bj = 0; bj < 2; ++bj)
#pragma unroll
                        for (int n = 0; n < 2; ++n) { const f32x4 x1 = acc[ai][bj][m][n], g = *(const f32x4*)(gnext + col0 + bj * HALF + n * 16);
                            *(f32x4*)(out + off + bj * HALF + n * 16) = x1;
                            const f32x4 o = x1 * sr * g; u32x2v w; w.x = cvt_pk_bf16(o[0], o[1]); w.y = cvt_pk_bf16(o[2], o[3]); *(u32x2v*)(xn + off + bj * HALF + n * 16) = w; }
                    asm volatile("" ::: "memory"); }
        }
    }
};
}
#include <hip/hip_bf16.h>
#include <cmath>
namespace attn_body {
using bf16=__hip_bfloat16;
using bf16x8=__attribute__((ext_vector_type(8)))short;
using s16x4=__attribute__((ext_vector_type(4)))short;
using f32x16=__attribute__((ext_vector_type(16)))float;
using u32x4=__attribute__((ext_vector_type(4)))unsigned;
constexpr int BATCH=8,SEQ=4096,D=64,DM=1536,OPITCH=512,DAPITCH=1024;
constexpr int NW=8,QBLK=32,QB=QBLK*NW,KVBLK=64,NQB=SEQ/QB;
constexpr int ATTN_PITCH=DM, ATTN_UNIT_ROWS=QB;
__device__ __forceinline__ int crow(int r,int hi){return (r&3)+8*(r>>2)+4*hi;}
#define SBAR() __builtin_amdgcn_sched_barrier(0)
__device__ __forceinline__ void cmask(f32x16&p0,f32x16&p1,int jb,int qrel,int hi){
  const float NEG=-INFINITY; int kb=64*jb+4*hi;
  #pragma unroll
  for(int r=0;r<16;++r){int kv=kb+(r&3)+8*(r>>2); if(kv>qrel)p0[r]=NEG; if(kv+32>qrel)p1[r]=NEG;}
}

constexpr int NSLOT=3, SLOTB=8192;
constexpr int LDS_K=0, LDS_V=NSLOT*SLOTB, LDS_WS=LDS_V+NSLOT*2*SLOTB, LDS_OST=LDS_WS+NW*64*4, LDS_BYTES=LDS_OST+NW*4096;
constexpr float C2=0.125f*1.4426950408889634f;
__device__ __forceinline__ void glds16(const void*gsrc,unsigned lds_dst){unsigned keep;
  asm volatile("s_mov_b32 %0, m0\n\ts_mov_b32 m0, %2\n\ts_nop 0\n\tglobal_load_lds_dwordx4 %1, off\n\ts_mov_b32 m0, %0":"=&s"(keep):"v"(gsrc),"s"(lds_dst):"memory");}
__device__ __forceinline__ float max3f(float a,float b,float c){float r;asm("v_max3_f32 %0, %1, %2, %3":"=v"(r):"v"(a),"v"(b),"v"(c));return r;}
__device__ __forceinline__ float max2f(float a,float b){float r;asm("v_max_f32_e32 %0, %1, %2":"=v"(r):"v"(a),"v"(b));return r;}
__device__ __forceinline__ float fadd_s(float a,float b){float r;asm("v_add_f32_e32 %0, %1, %2":"=v"(r):"v"(a),"v"(b));return r;}
__device__ __forceinline__ float fsub_s(float a,float b){float r;asm("v_sub_f32_e32 %0, %1, %2":"=v"(r):"v"(a),"v"(b));return r;}
typedef float f32x2_t __attribute__((ext_vector_type(2))); typedef __bf16 bf16x2_t __attribute__((ext_vector_type(2)));
__device__ __forceinline__ unsigned cvtpk_s(float lo,float hi){f32x2_t v={lo,hi};bf16x2_t b=__builtin_convertvector(v,bf16x2_t);return __builtin_bit_cast(unsigned,b);}
#define WAIT_BAR(N) asm volatile("s_waitcnt vmcnt(" #N ") lgkmcnt(0)\n\ts_barrier":::"memory")

__device__ __forceinline__ void qkt(f32x16&p0,f32x16&p1,const char*Kslot,const bf16x8*qr,int r32,int hi){
  const char*kb=Kslot+hi*1024+r32*16;
  #pragma unroll
  for(int d0=0;d0<4;++d0){
    const bf16x8 b0=*reinterpret_cast<const bf16x8*>(kb+d0*2048);
    const bf16x8 b1=*reinterpret_cast<const bf16x8*>(kb+d0*2048+512);
    if(d0==0){p0=__builtin_amdgcn_mfma_f32_32x32x16_bf16(b0,qr[0],f32x16{},0,0,0);p1=__builtin_amdgcn_mfma_f32_32x32x16_bf16(b1,qr[0],f32x16{},0,0,0);}
    else{p0=__builtin_amdgcn_mfma_f32_32x32x16_bf16(b0,qr[d0],p0,0,0,0);p1=__builtin_amdgcn_mfma_f32_32x32x16_bf16(b1,qr[d0],p1,0,0,0);}}
}
typedef __attribute__((address_space(3))) const char* lds_cptr;
typedef short v4i16_t __attribute__((ext_vector_type(4)));
__device__ __forceinline__ void kload8(bf16x8*kf,lds_cptr kp){
  kf[0]=*(const __attribute__((address_space(3))) bf16x8*)(kp);      kf[1]=*(const __attribute__((address_space(3))) bf16x8*)(kp+512);
  kf[2]=*(const __attribute__((address_space(3))) bf16x8*)(kp+2048); kf[3]=*(const __attribute__((address_space(3))) bf16x8*)(kp+2560);
  kf[4]=*(const __attribute__((address_space(3))) bf16x8*)(kp+4096); kf[5]=*(const __attribute__((address_space(3))) bf16x8*)(kp+4608);
  kf[6]=*(const __attribute__((address_space(3))) bf16x8*)(kp+6144); kf[7]=*(const __attribute__((address_space(3))) bf16x8*)(kp+6656);
}
__device__ __forceinline__ void kload2(bf16x8*kf,lds_cptr kp,int j){ kf[2*j]=*(const __attribute__((address_space(3))) bf16x8*)(kp+j*2048); kf[2*j+1]=*(const __attribute__((address_space(3))) bf16x8*)(kp+j*2048+512); }
__device__ __forceinline__ s16x4 vtr(lds_cptr p){ return __builtin_bit_cast(s16x4,__builtin_amdgcn_ds_read_tr16_b64_v4i16((__attribute__((address_space(3))) v4i16_t*)p)); }
__device__ __forceinline__ float rowmax(const f32x16&p0,const f32x16&p1){
  float a=max3f(p0[0],p0[1],p1[0]),b=max3f(p0[2],p0[3],p1[1]);a=max3f(a,p1[2],p1[3]);
  #pragma unroll
  for(int r=4;r<16;r+=4){a=max3f(a,p0[r],p0[r+1]);b=max3f(b,p0[r+2],p0[r+3]);a=max3f(a,p1[r],p1[r+1]);b=max3f(b,p1[r+2],p1[r+3]);}
  const float m=max2f(a,b);
  auto rr=__builtin_amdgcn_permlane32_swap(__float_as_uint(m),__float_as_uint(m),false,false);
  return max2f(__uint_as_float(rr[0]),__uint_as_float(rr[1]));
}
__device__ __forceinline__ void pv(f32x16*o,int vb,bf16x8 pa0,bf16x8 pa1,bf16x8 pa2,bf16x8 pa3){
  #pragma unroll
  for(int d0=0;d0<4;++d0){s16x4 lo[4],hi[4];
    #pragma unroll
    for(int ks=0;ks<4;++ks){
      asm volatile("ds_read_b64_tr_b16 %0,%1 offset:%c2":"=&v"(lo[ks]):"v"(vb),"i"(d0*4096+ks*1024):"memory");
      asm volatile("ds_read_b64_tr_b16 %0,%1 offset:%c2":"=&v"(hi[ks]):"v"(vb),"i"(d0*4096+ks*1024+512):"memory");}
    asm volatile("s_waitcnt lgkmcnt(0)":::"memory");SBAR();
    #define PK(k) (bf16x8){lo[k][0],lo[k][1],lo[k][2],lo[k][3],hi[k][0],hi[k][1],hi[k][2],hi[k][3]}
    o[d0]=__builtin_amdgcn_mfma_f32_32x32x16_bf16(pa0,PK(0),o[d0],0,0,0);
    o[d0]=__builtin_amdgcn_mfma_f32_32x32x16_bf16(pa1,PK(1),o[d0],0,0,0);
    o[d0]=__builtin_amdgcn_mfma_f32_32x32x16_bf16(pa2,PK(2),o[d0],0,0,0);
    o[d0]=__builtin_amdgcn_mfma_f32_32x32x16_bf16(pa3,PK(3),o[d0],0,0,0);
    #undef PK
  }
}

#ifndef ATTN_STORE16
#define ATTN_STORE16(p,v) (*(u32x4*)(p)=(v))
#endif
template<int THRL> __device__ __forceinline__ void attn_unit(int b,int h,int qb,const bf16*Q,const bf16*__restrict__ K,const bf16*__restrict__ V,bf16*O,char*shm,const bool cmb,const float cmb_lam,const float cmb_scale,const float*cmb_g,const bf16*O1,bf16*DAo){
  int tid_=threadIdx.x; asm volatile("":"+v"(tid_)); const int tid=tid_,lane=tid&63,r32=lane&31,hi=lane>>5; const int wid=__builtin_amdgcn_readfirstlane(tid>>6);
  const long rowbase=(long)b*SEQ; const int q0=qb*QB;
  const bf16*Qw=Q+(rowbase+q0+wid*QBLK)*DM+h*D;
  const bf16*Kh=K+rowbase*DM+h*D,*Vh=V+rowbase*DM+h*D;
  const unsigned lds0=(unsigned)(uintptr_t)shm;
  float*wsf=(float*)(shm+LDS_WS)+wid*64;
  const bf16*ksrc=Kh+(long)lane*DM+wid*8;
  const bf16*vsrc=Vh+(long)(16*(wid&3)+(lane>>2))*DM+(wid>>2)*32+(lane&3)*8;
  const unsigned kdst=lds0+LDS_K+wid*1024, vdst=lds0+LDS_V+wid*1024;
  #define DMA_K(t,slot) glds16(ksrc+(long)(t)*KVBLK*DM,(unsigned)__builtin_amdgcn_readfirstlane(kdst+(slot)))
  #define DMA_V(t,slot) do{ glds16(vsrc+(long)(t)*KVBLK*DM,(unsigned)__builtin_amdgcn_readfirstlane(vdst+2*(slot))); glds16(vsrc+64+(long)(t)*KVBLK*DM,(unsigned)__builtin_amdgcn_readfirstlane(vdst+2*(slot)+8192)); }while(0)
  const int vb0=(int)(lds0+LDS_V)+((lane>>4)&1)*32+(lane&3)*8+(4*hi+((lane&15)>>2))*64;
  const char*Kbase=shm+LDS_K; bf16x8 kf[8];
  const lds_cptr shm3=(lds_cptr)shm; const lds_cptr kp0=shm3+LDS_K+hi*1024+r32*16; const lds_cptr vp0=shm3+LDS_V+((lane>>4)&1)*32+(lane&3)*8+(4*hi+((lane&15)>>2))*64;
  const int NT=(q0+QB)/KVBLK;
  DMA_K(0,0);DMA_V(0,0);DMA_K(1,SLOTB);
  bf16x8 qr[4];
  #pragma unroll
  for(int d0=0;d0<4;++d0)qr[d0]=*reinterpret_cast<const bf16x8*>(&Qw[(long)r32*DM+d0*16+hi*8]);
  float mhat=0.f,l_reg=0.f;f32x16 o[4];o[0]=f32x16{};o[1]=f32x16{};o[2]=f32x16{};o[3]=f32x16{};
  const int qrel=wid*QBLK+r32;
  #define CMASK(P0,P1,t) do{int jb_=(t)-(NT-4); if(jb_>=0)cmask(P0,P1,jb_,qrel,hi);}while(0)
  bool resc=false;
  #define START(P0,P1) do{ const float rm=rowmax(P0,P1); resc=false; mhat=rm; \
    _Pragma("unroll") for(int r=0;r<16;++r)P0[r]=__builtin_amdgcn_exp2f(P0[r]-mhat); }while(0)
  #define RESC() do{ if(resc){ asm volatile("s_waitcnt lgkmcnt(0)":::"memory"); \
      _Pragma("unroll") for(int d_=0;d_<4;++d_) _Pragma("unroll") for(int r=0;r<16;++r)o[d_][r]*=wsf[crow(r,hi)]; } }while(0)
  f32x16 pA0,pA1,pB0,pB1;
  int sl_prev=0,sl_cur=0,sl_next=SLOTB;
  #define ROT() do{sl_prev=sl_cur;sl_cur=sl_next;sl_next=(sl_next==(NSLOT-1)*SLOTB)?0:sl_next+SLOTB;}while(0)
  DMA_K(2,2*SLOTB);
  WAIT_BAR(3);
  qkt(pA0,pA1,Kbase,qr,r32,hi);asm volatile("s_nop 15\n\ts_nop 7":"+v"(pA0),"+v"(pA1));CMASK(pA0,pA1,0);
  START(pA0,pA1);
  _Pragma("unroll") for(int r=0;r<16;++r)pA1[r]=__builtin_amdgcn_exp2f(pA1[r]-mhat);
  WAIT_BAR(0);
  DMA_K(3,0);DMA_V(1,SLOTB);
  ROT();
  kload8(kf,kp0+sl_cur);
  WAIT_BAR(3);
  s16x4 vlo[8],vhi[8]; u32x4 pw0,pw1,pw2,pw3;
  #define PKW(P,B) cvtpk_s(P[B],P[B+1])
  #define PAF(k) __builtin_bit_cast(bf16x8,pw##k)
  #define VFR(i) (bf16x8){vlo[i][0],vlo[i][1],vlo[i][2],vlo[i][3],vhi[i][0],vhi[i][1],vhi[i][2],vhi[i][3]}
  #define PIN(x) asm volatile("":"+v"(x))
  #define MX3(a,b,c) __builtin_fmaxf(__builtin_fmaxf((a),(b)),(c))
  #define GAPA(MF,A0,A1,A2,A3,W0,W1,PW) do{ MF; sacc+=A0; sacc+=A1; sacc+=A2; sacc+=A3; PIN(sacc); W0; W1; PIN(PW); SBAR(); }while(0)
  #define EX(v) __builtin_amdgcn_exp2f((v)-mhat)
  #define FIDX(k) ((((k)&3)<<2)+((k)>>2))
  #define VRD(k) do{ vlo[(k)&7]=vtr(vp_+FIDX(k)*1024); vhi[(k)&7]=vtr(vp_+FIDX(k)*1024+512); }while(0)
  #define GAPB(k,PK_,X,B) do{ o[(k)&3]=__builtin_amdgcn_mfma_f32_32x32x16_bf16(PK_,VFR((k)&7),o[(k)&3],0,0,0); X[B]=EX(X[B]); X[B+1]=EX(X[B+1]); PIN(X); SBAR(); }while(0)
  #define KRD(G,j) do{ if(G){ kload2(kf,kp0+sl_next,j); SBAR(); } }while(0)
  #define QK(a,b,c) __builtin_amdgcn_mfma_f32_32x32x16_bf16(a,b,c,0,0,0)
  #define STEP(C0,C1,P0,P1,t,GK,GV,GL) do{ SBAR(); \
    const lds_cptr vp_=vp0+2*sl_prev; \
    float sacc=(P0[0]+P0[1]); \
    GAPA(C0=QK(kf[0],qr[0],f32x16{}), P0[2],P0[3],P0[4],P0[5],     pw0[0]=PKW(P0,0), pw0[1]=PKW(P0,2), pw0); \
    GAPA(C1=QK(kf[1],qr[0],f32x16{}), P0[6],P0[7],P0[8],P0[9],     pw0[2]=PKW(P0,4), pw0[3]=PKW(P0,6), pw0); \
    GAPA(C0=QK(kf[2],qr[1],C0),       P0[10],P0[11],P0[12],P0[13], pw1[0]=PKW(P0,8), pw1[1]=PKW(P0,10), pw1); \
    GAPA(C1=QK(kf[3],qr[1],C1),       P0[14],P0[15],P1[0],P1[1],   pw1[2]=PKW(P0,12),pw1[3]=PKW(P0,14), pw1); \
    VRD(0); SBAR(); GAPA(C0=QK(kf[4],qr[2],C0), P1[2],P1[3],P1[4],P1[5],     pw2[0]=PKW(P1,0), pw2[1]=PKW(P1,2), pw2); \
    VRD(1); SBAR(); GAPA(C1=QK(kf[5],qr[2],C1), P1[6],P1[7],P1[8],P1[9],     pw2[2]=PKW(P1,4), pw2[3]=PKW(P1,6), pw2); \
    VRD(2); SBAR(); GAPA(C0=QK(kf[6],qr[3],C0), P1[10],P1[11],P1[12],P1[13], pw3[0]=PKW(P1,8), pw3[1]=PKW(P1,10), pw3); \
    VRD(3); SBAR(); GAPA(C1=QK(kf[7],qr[3],C1), P1[14],P1[15],0.f,0.f,       pw3[2]=PKW(P1,12),pw3[3]=PKW(P1,14), pw3); \
    l_reg+=sacc; \
    if(GK){DMA_K((t)+3,sl_cur);} if(GV){DMA_V((t)+1,sl_next);} \
    CMASK(C0,C1,t); \
    { float a=MX3(C0[0],C0[1],C1[0]),b=MX3(C0[2],C0[3],C1[1]); a=MX3(a,C1[2],C1[3]); \
      _Pragma("unroll") for(int r=4;r<16;r+=4){a=MX3(a,C0[r],C0[r+1]);b=MX3(b,C0[r+2],C0[r+3]);a=MX3(a,C1[r],C1[r+1]);b=MX3(b,C1[r+2],C1[r+3]);} \
      float rm=__builtin_fmaxf(a,b); { auto rr=__builtin_amdgcn_permlane32_swap(__float_as_uint(rm),__float_as_uint(rm),false,false); rm=__builtin_fmaxf(__uint_as_float(rr[0]),__uint_as_float(rr[1])); } \
      rm-=mhat; resc=false; \
      if(__builtin_expect(__any(rm>(float)THRL),0)){ const float dl=__builtin_fmaxf(rm,0.f); mhat+=dl; \
        const float f=__builtin_amdgcn_exp2f(-dl); l_reg*=f; if(hi==0)wsf[r32]=f; resc=true; } } \
    SBAR(); \
    GAPB(0,PAF(0),C0,0);   VRD(4);  SBAR(); \
    GAPB(1,PAF(0),C0,2);   VRD(5);  SBAR(); \
    GAPB(2,PAF(0),C0,4);   VRD(6);  SBAR(); \
    GAPB(3,PAF(0),C0,6);   VRD(7);  SBAR(); KRD(GL,0); \
    GAPB(4,PAF(1),C0,8);   VRD(8);  SBAR(); \
    GAPB(5,PAF(1),C0,10);  VRD(9);  SBAR(); \
    GAPB(6,PAF(1),C0,12);  VRD(10); SBAR(); KRD(GL,1); \
    GAPB(7,PAF(1),C0,14);  VRD(11); SBAR(); \
    GAPB(8,PAF(2),C1,0);   VRD(12); SBAR(); \
    GAPB(9,PAF(2),C1,2);   VRD(13); SBAR(); KRD(GL,2); \
    GAPB(10,PAF(2),C1,4);  VRD(14); SBAR(); \
    GAPB(11,PAF(2),C1,6);  VRD(15); SBAR(); \
    GAPB(12,PAF(3),C1,8);  KRD(GL,3); \
    GAPB(13,PAF(3),C1,10); \
    GAPB(14,PAF(3),C1,12); \
    GAPB(15,PAF(3),C1,14); \
    }while(0)
  int t=1;
  #undef CMASK
  #define CMASK(P0,P1,t) do{}while(0)
  for(;t+5<NT;t+=2){
    STEP(pB0,pB1,pA0,pA1,t,true,true,true);     WAIT_BAR(3); RESC(); ROT();
    STEP(pA0,pA1,pB0,pB1,t+1,true,true,true);   WAIT_BAR(3); RESC(); ROT();
  }
  #undef CMASK
  #define CMASK(P0,P1,t) do{int jb_=(t)-(NT-4); if(jb_>=0)cmask(P0,P1,jb_,qrel,hi);}while(0)
  #define ENDW(tt) do{ if((tt)+3<NT){WAIT_BAR(3);} else if((tt)+2<NT){WAIT_BAR(2);} else {WAIT_BAR(0);} }while(0)
  for(;t+1<NT;t+=2){
    STEP(pB0,pB1,pA0,pA1,t,(t+3<NT),(t+1<NT),(t+1<NT));       ENDW(t);   RESC(); ROT();
    STEP(pA0,pA1,pB0,pB1,t+1,(t+4<NT),(t+2<NT),(t+2<NT));     ENDW(t+1); RESC(); ROT();
  }
  STEP(pB0,pB1,pA0,pA1,NT-1,false,false,false); RESC();
  { float sacc=pB0[0]+pB0[1]; _Pragma("unroll") for(int r=2;r<16;++r)sacc+=pB0[r]; _Pragma("unroll") for(int r=0;r<16;++r)sacc+=pB1[r]; l_reg+=sacc;
    pw0=(u32x4){PKW(pB0,0),PKW(pB0,2),PKW(pB0,4),PKW(pB0,6)};pw1=(u32x4){PKW(pB0,8),PKW(pB0,10),PKW(pB0,12),PKW(pB0,14)};pw2=(u32x4){PKW(pB1,0),PKW(pB1,2),PKW(pB1,4),PKW(pB1,6)};pw3=(u32x4){PKW(pB1,8),PKW(pB1,10),PKW(pB1,12),PKW(pB1,14)};
    SBAR(); pv(o,vb0+2*sl_cur,PAF(0),PAF(1),PAF(2),PAF(3)); }
  #undef PKW
  #undef PAF
  #undef VFR
  #undef PIN
  #undef MX3
  #undef GAPA
  #undef GAPB
  #undef EX
  #undef VRD
  #undef KRD
  #undef STEP
  #undef FIDX
  #undef QK
  #undef ENDW
  {auto rr=__builtin_amdgcn_permlane32_swap(__float_as_uint(l_reg),__float_as_uint(l_reg),false,false);l_reg=__uint_as_float(rr[0])+__uint_as_float(rr[1]);}
  if(hi==0)wsf[32+r32]=l_reg;asm volatile("s_waitcnt lgkmcnt(0)":::"memory");
  float rli[16];
  #pragma unroll
  for(int r=0;r<16;++r)rli[r]=__builtin_amdgcn_rcpf(wsf[32+crow(r,hi)]);
  bf16*Ow=O+(rowbase+q0+wid*QBLK)*OPITCH+h*D;
  { bf16*stg=(bf16*)(shm+LDS_OST)+wid*2048;
    float dv[2][4][8];
    #pragma unroll
    for(int hp=0;hp<2;++hp){
      #pragma unroll
      for(int r=0;r<16;++r){const int orow=crow(r,hi);
        #pragma unroll
        for(int d0=0;d0<2;++d0)stg[orow*64+d0*32+r32]=__float2bfloat16(o[2*hp+d0][r]*rli[r]);}
      asm volatile("s_waitcnt lgkmcnt(0)":::"memory");
      if(!cmb){
        #pragma unroll
        for(int i=0;i<4;++i){const int row=i*8+(lane>>3),ch=lane&7; const u32x4 v=*(const u32x4*)(stg+row*64+ch*8); ATTN_STORE16(Ow+(long)row*OPITCH+hp*64+ch*8,v);}
      } else {
        const bf16*O1w=O1+(rowbase+q0+wid*QBLK)*OPITCH; const float lam=cmb_lam;
        #pragma unroll
        for(int i=0;i<4;++i){const int row=i*8+(lane>>3),ch=lane&7; const u32x4 v=*(const u32x4*)(stg+row*64+ch*8); const u32x4 a=*(const u32x4*)(O1w+(long)row*OPITCH+hp*64+ch*8);
          #define BL(w) __uint_as_float((w)<<16)
          #define BH(w) __uint_as_float((w)&0xffff0000u)
          dv[hp][i][0]=BL(a.x)-lam*BL(v.x); dv[hp][i][1]=BH(a.x)-lam*BH(v.x); dv[hp][i][2]=BL(a.y)-lam*BL(v.y); dv[hp][i][3]=BH(a.y)-lam*BH(v.y);
          dv[hp][i][4]=BL(a.z)-lam*BL(v.z); dv[hp][i][5]=BH(a.z)-lam*BH(v.z); dv[hp][i][6]=BL(a.w)-lam*BL(v.w); dv[hp][i][7]=BH(a.w)-lam*BH(v.w);
          #undef BL
          #undef BH
        }
      }
      asm volatile("s_waitcnt lgkmcnt(0)":::"memory"); }
    if(cmb){ bf16*Dw=DAo+(rowbase+q0+wid*QBLK)*DAPITCH; const int ch=lane&7;
      #pragma unroll
      for(int i=0;i<4;++i){ const int row=i*8+(lane>>3); float ss=0.f;
        #pragma unroll
        for(int hp=0;hp<2;++hp)
          #pragma unroll
          for(int j=0;j<8;++j)ss+=dv[hp][i][j]*dv[hp][i][j];
        ss+=__shfl_xor(ss,1); ss+=__shfl_xor(ss,2); ss+=__shfl_xor(ss,4);
        const float rn=cmb_scale*__builtin_amdgcn_rsqf(ss*(1.0f/128.0f)+1e-5f);
        #pragma unroll
        for(int hp=0;hp<2;++hp){ const float*gp=cmb_g+hp*64+ch*8; u32x4 w;
          w.x=cvtpk_s(dv[hp][i][0]*rn*gp[0],dv[hp][i][1]*rn*gp[1]); w.y=cvtpk_s(dv[hp][i][2]*rn*gp[2],dv[hp][i][3]*rn*gp[3]);
          w.z=cvtpk_s(dv[hp][i][4]*rn*gp[4],dv[hp][i][5]*rn*gp[5]); w.w=cvtpk_s(dv[hp][i][6]*rn*gp[6],dv[hp][i][7]*rn*gp[7]);
          *(u32x4*)(Dw+(long)row*DAPITCH+hp*64+ch*8)=w; } } } }
  asm volatile("s_waitcnt lgkmcnt(0)\n\ts_barrier":::"memory");
  #undef DMA_K
  #undef DMA_V
  #undef CMASK
  #undef START
  #undef RESC
  #undef ROT
}
constexpr int ATTN_LDS_BYTES=LDS_BYTES;
struct AttnUnit { int b; int m; int qb; };
struct StaticOrder {
  int vcu, G;
  __device__ __forceinline__ explicit StaticOrder(int grid,int block):vcu((grid%8==0)?((block%8)*(grid/8)+block/8):block),G(grid){}
  __device__ __forceinline__ bool next(int i,AttnUnit&u)const{ const int p=vcu+(i>>2)*G; if(p>=256)return false; const int s=p&7, bh=p>>3; u.b=bh>>2; u.m=2*(bh&3)+(i&1); u.qb=(i&2)?s:15-s; return true; }
  __device__ __forceinline__ void a_ready(const AttnUnit&)const{}
  __device__ __forceinline__ void done(const AttnUnit&)const{}
};
struct AttnTensors { const bf16* ZQ; bf16* O; bf16* DA; float lam; float scale; const float* g; };
template<class Sched,int THRL=8> __device__ __forceinline__ void attn_phase(char*lds,const AttnTensors&T,const Sched&S){
  AttnUnit u;
  for(int i=0;S.next(i,u);++i){ S.a_ready(u); const int head=u.m>>1;
    attn_unit<THRL>(u.b,0,u.qb,T.ZQ+64*u.m,T.ZQ+512+64*u.m,T.ZQ+1024+128*head,T.O+128*head,lds,(u.m&1)!=0,T.lam,T.scale,T.g,T.O+128*head,T.DA+128*head); S.done(u); }
}
#undef SBAR
#undef WAIT_BAR
}
constexpr int NWAVES = 8;
constexpr int BATCH = 8, T = 4096, D = 1024, FF = 2816, DIN = 5632;
constexpr int M = BATCH * T;
constexpr size_t MiB = 1u << 20;
constexpr size_t WS_CTL = 0, CTL_ZERO_BYTES = 1 * MiB;
constexpr size_t WS_CS = 1 * MiB;
constexpr size_t WS_WIN = 4 * MiB, WS_WAP = 15 * MiB, WS_WRP = 16 * MiB, WS_WOUT = 17 * MiB;
constexpr size_t WS_XN = 20 * MiB;
constexpr size_t WS_Y = 84 * MiB;
constexpr size_t WS_R0 = 148 * MiB;
constexpr size_t WS_H = WS_R0, WS_WGU = WS_R0 + 176 * MiB, WS_WD = WS_R0 + 188 * MiB;
constexpr size_t WS_ZQ = WS_R0, WS_ZR = WS_R0 + 96 * MiB, WS_ZG = WS_R0 + 224 * MiB;
constexpr size_t WS_PT = WS_ZQ, WS_ACAT = WS_ZQ + 32 * MiB;
constexpr size_t WS_MG = WS_ZR;
constexpr size_t WS_AO = WS_XN, WS_KVT = WS_Y;
constexpr size_t WS_XB = 500 * MiB, XB_BYTES = (size_t)M * 4 * 4;
constexpr size_t WS_RS = 503 * MiB;
constexpr size_t WS_END = 504 * MiB;
static_assert(WS_WD + (size_t)D * FF * 2 <= WS_R0 + 352 * MiB && WS_ZG + (size_t)M * 2048 * 2 == WS_R0 + 352 * MiB && WS_R0 + 352 * MiB == WS_XB && WS_XB + 5 * XB_BYTES <= WS_END, "d_ws map");
static_assert(WS_WIN + (size_t)DIN * D * 2 <= WS_WAP && WS_WOUT + (size_t)D * D * 2 <= WS_XN && WS_XN + (size_t)M * D * 2 == WS_Y && WS_Y + (size_t)M * D * 2 == WS_R0, "d_ws map");
constexpr int CW_TMO = 0;
constexpr int CW_SEAM = 16384, SEAM_BANK = 128 * 64;
constexpr int CW_SCAN = 8192;
constexpr int CW_BAR = 4096;
constexpr int RING_OFF = 0, RING_BYTES = 131072;
constexpr int LDSCTL_OFF = RING_BYTES, MISC_OFF = LDSCTL_OFF + 320;
constexpr int LDS_BYTES = 147456;
static_assert(MISC_OFF + 128 <= LDS_BYTES, "LDS map");
#define GAS __attribute__((address_space(1)))
#define LAS __attribute__((address_space(3)))
typedef unsigned short bf16;
typedef unsigned v4u __attribute__((ext_vector_type(4)));
typedef float f32x4 __attribute__((ext_vector_type(4)));
typedef short bf16x8 __attribute__((ext_vector_type(8)));
typedef GAS unsigned gu32;
typedef GAS unsigned long long gu64;
#define RLX_AGENT __ATOMIC_RELAXED, __HIP_MEMORY_SCOPE_AGENT
#define LDS_WAIT() asm volatile("s_waitcnt lgkmcnt(0)" ::: "memory")
#define VM_WAIT() asm volatile("s_waitcnt vmcnt(0)" ::: "memory")
__device__ __forceinline__ unsigned long long rt() { return __builtin_amdgcn_s_memrealtime(); }
typedef float f32x2v __attribute__((ext_vector_type(2))); typedef __bf16 bf16x2v __attribute__((ext_vector_type(2)));
__device__ __forceinline__ unsigned pk2(float lo, float hi) { const f32x2v v = {lo, hi}; return __builtin_bit_cast(unsigned, __builtin_convertvector(v, bf16x2v)); }
__device__ __forceinline__ unsigned f2bf(float f) { return pk2(f, 0.f) & 0xffffu; }

#define XB_TMO      128
#define XB_XCNT(j)  (256  + 64 * (j))
#define XB_XSUB(j)  (1280 + 64 * (j))
#define XB_XGEN(j)  (2304 + 64 * (j))
#define XB_TOP      3328
#define XB_TOPGEN   3392
#define XCD_BAR_WORDS 3456
#define XB_SPIN_CAP (1u << 18)

__device__ __forceinline__ unsigned xb_ld(unsigned* p)              { return __hip_atomic_load(p, __ATOMIC_RELAXED, __HIP_MEMORY_SCOPE_AGENT); }
__device__ __forceinline__ unsigned xb_add(unsigned* p, unsigned v) { return __hip_atomic_fetch_add(p, v, __ATOMIC_RELAXED, __HIP_MEMORY_SCOPE_AGENT); }
__device__ __forceinline__ unsigned xb_xcc_id() { return (unsigned)__builtin_amdgcn_s_getreg((3 << 11) | 20) & 0xFu; }
#define XB_SPIN(cond, bar) do { unsigned _sp = 0; while (cond) { __builtin_amdgcn_s_sleep(1); \
    if ((++_sp & 255u) == 0u) { if (xb_ld(&(bar)[XB_TMO])) break; if (_sp > XB_SPIN_CAP) { atomicAdd(&(bar)[XB_TMO], 1u); break; } } } } while (0)

struct XcdBarrier {
    unsigned* bar; unsigned x;
    volatile LAS unsigned* st;
};

__device__ __forceinline__ XcdBarrier xcd_barrier_post(unsigned* bar, volatile LAS unsigned* st) {
    XcdBarrier b; b.bar = bar; b.x = xb_xcc_id(); b.st = st;
    if (threadIdx.x == 0) (void)xb_add(&bar[XB_XCNT(b.x)], 1u);
    return b;
}
__device__ __forceinline__ void xcd_barrier_complete(unsigned* bar, unsigned x, unsigned& nloc, unsigned& nx) {
    const unsigned G = gridDim.x * gridDim.y * gridDim.z;
    unsigned sum, cnt, mine, sp = 0u;
    for (;;) {
        sum = 0u; cnt = 0u; mine = 0u;
#pragma unroll
        for (unsigned j = 0; j < 16; ++j) { const unsigned c = xb_ld(&bar[XB_XCNT(j)]); sum += c; cnt += (c > 0u) ? 1u : 0u; mine = (j == x) ? c : mine; }
        if (sum == G) break;
        __builtin_amdgcn_s_sleep(1);
        if ((++sp & 255u) == 0u) { if (xb_ld(&bar[XB_TMO])) break; if (sp > XB_SPIN_CAP) { atomicAdd(&bar[XB_TMO], 1u); break; } }
    }
    nloc = mine > 0u ? mine : 1u; nx = cnt > 0u ? cnt : 1u;
}

__device__ __forceinline__ void xcd_barrier(const XcdBarrier& b) {
    asm volatile("s_waitcnt vmcnt(0)" ::: "memory");
    __syncthreads();
    if (threadIdx.x == 0) {
        unsigned* bar = b.bar;
        __builtin_amdgcn_s_waitcnt(0);
        unsigned nloc = b.st[0], nx = b.st[1];
        if (nloc == 0u) { xcd_barrier_complete(bar, b.x, nloc, nx); b.st[0] = nloc; b.st[1] = nx; }
        const unsigned old = xb_add(&bar[XB_XSUB(b.x)], 1u);
        const unsigned gen = old / nloc;
        if (old + 1u == (gen + 1u) * nloc) {
            __builtin_amdgcn_fence(__ATOMIC_RELEASE, "agent");
            asm volatile("s_waitcnt vmcnt(0)" ::: "memory");
            const unsigned og = xb_add(&bar[XB_TOP], 1u);
            const unsigned tg = og / nx;
            if (og + 1u == (tg + 1u) * nx) xb_add(&bar[XB_TOPGEN], 1u);
            else XB_SPIN(xb_ld(&bar[XB_TOPGEN]) == tg, bar);
            __builtin_amdgcn_fence(__ATOMIC_ACQUIRE, "agent");
            xb_add(&bar[XB_XGEN(b.x)], 1u);
            asm volatile("s_waitcnt vmcnt(0)" ::: "memory");
        } else {
            XB_SPIN(xb_ld(&bar[XB_XGEN(b.x)]) == gen, bar);
            __builtin_amdgcn_fence(__ATOMIC_ACQUIRE, "agent");
            asm volatile("s_waitcnt vmcnt(0)" ::: "memory");
        }
    }
    __syncthreads();
}
struct Frame {
    LAS unsigned char* lds;
    volatile LAS unsigned* MISC;
    gu32* ctl;
    int tid, lane, wave;
    int vcu, G;
};

template <int CTRL> __device__ __forceinline__ float dpp_xadd(float v) { return v + __builtin_bit_cast(float, __builtin_amdgcn_update_dpp(0, __builtin_bit_cast(int, v), CTRL, 0xF, 0xF, false)); }
__device__ __forceinline__ float wave_sum(float v) {
    v = dpp_xadd<0xB1>(v); v = dpp_xadd<0x4E>(v); v = dpp_xadd<0x141>(v); v = dpp_xadd<0x140>(v);
    const int iv = __builtin_bit_cast(int, v);
    const float r0 = __builtin_bit_cast(float, __builtin_amdgcn_readlane(iv, 0)), r1 = __builtin_bit_cast(float, __builtin_amdgcn_readlane(iv, 16));
    const float r2 = __builtin_bit_cast(float, __builtin_amdgcn_readlane(iv, 32)), r3 = __builtin_bit_cast(float, __builtin_amdgcn_readlane(iv, 48));
    return (r0 + r1) + (r2 + r3);
}
__device__ __forceinline__ float bfl(unsigned w) { return __uint_as_float(w << 16); }
__device__ __forceinline__ float bfh(unsigned w) { return __uint_as_float(w & 0xffff0000u); }

__device__ __forceinline__ void transpose_item(const float* W, int K, int N, bf16* WT, int mode, LAS float* scr, int item, int lane, int ldw = 0, int koff = 0, const float* gk = nullptr, float wscale = 1.0f) {
    if (ldw == 0) ldw = K;
    const int nblk = N / 32, kb = item / nblk, nb = item % nblk, k0 = 64 * kb, n0 = 32 * nb;
    int rbase = (mode == 0) ? n0 : (256 * (n0 >> 7) + (n0 & 127) + (mode == 2 ? 128 : 0));
    if (mode == 3) rbase = (n0 < 3584) ? n0 : (n0 < 4608) ? (3584 + 256 * ((n0 - 3584) >> 7) + ((n0 - 3584) & 127)) : (3584 + 256 * ((n0 - 4608) >> 7) + 128 + ((n0 - 4608) & 127));
    const float gl = (gk ? gk[k0 + lane] : 1.0f) * ((mode == 3 && n0 >= 3584) ? -1.4426950408889634f : wscale);
#pragma unroll 8
    for (int i = 0; i < 32; ++i) { const int kk = 2 * i + (lane >> 5); const float gv = __shfl(gl, kk); scr[kk * 33 + (lane & 31)] = W[(size_t)(k0 + kk) * N + n0 + (lane & 31)] * gv; }
    LDS_WAIT(); asm volatile("" ::: "memory");
    const int c = lane & 7;
#pragma unroll
    for (int j = 0; j < 4; ++j) { const int n = (lane >> 3) + 8 * j; const LAS float* s = scr + (8 * c) * 33 + n;
        v4u o; o.x = pk2(s[0 * 33], s[1 * 33]); o.y = pk2(s[2 * 33], s[3 * 33]); o.z = pk2(s[4 * 33], s[5 * 33]); o.w = pk2(s[6 * 33], s[7 * 33]);
        *(GAS v4u*)(WT + (size_t)(rbase + n) * ldw + koff + k0 + 8 * c) = o; }
    LDS_WAIT(); asm volatile("" ::: "memory");
}

template <bool SRC_XN, bool HAS_Y, bool OUT_F32, bool OUT_XN>
__device__ __forceinline__ void row_phase(Frame& F, const float* xin, const bf16* xn_in, const float* rs_in, const bf16* y, const float* gpost, float scale, float* xout, bf16* xn_out, float* rs_out) {
    constexpr int NR = 2;
    const int gw = F.vcu * NWAVES + F.wave, NGW = F.G * NWAVES;
    f32x4 gp[4];
#pragma unroll
    for (int j = 0; j < 4; ++j) gp[j] = HAS_Y ? *(const f32x4*)(gpost + 256 * j + 4 * F.lane) : (f32x4){0.f, 0.f, 0.f, 0.f};
    for (int m0 = gw; m0 < M; m0 += NR * NGW) {
        f32x4 v[NR][4]; unsigned long long yw[NR][4]; float rsv[NR];
#pragma unroll
        for (int q = 0; q < NR; ++q) { const int m = (m0 + q * NGW < M) ? m0 + q * NGW : m0;
            if (SRC_XN) { const GAS unsigned long long* xr = (const GAS unsigned long long*)(xn_in + (size_t)m * D) + F.lane; rsv[q] = rs_in[m];
#pragma unroll
                for (int j = 0; j < 4; ++j) { const unsigned long long w = xr[64 * j]; const unsigned lo = (unsigned)w, hi = (unsigned)(w >> 32); v[q][j] = (f32x4){bfl(lo), bfh(lo), bfl(hi), bfh(hi)}; }
            } else { const GAS f32x4* xr = (const GAS f32x4*)(xin + (size_t)m * D) + F.lane; rsv[q] = 1.f;
#pragma unroll
                for (int j = 0; j < 4; ++j) v[q][j] = xr[64 * j]; }
            if (HAS_Y) { const GAS unsigned long long* yr = (const GAS unsigned long long*)(y + (size_t)m * D) + F.lane;
#pragma unroll
                for (int j = 0; j < 4; ++j) yw[q][j] = yr[64 * j]; } }
#pragma unroll
        for (int q = 0; q < NR; ++q) { const int m = (m0 + q * NGW < M) ? m0 + q * NGW : m0;
            if (SRC_XN) {
#pragma unroll
                for (int j = 0; j < 4; ++j) v[q][j] = v[q][j] * rsv[q]; }
            if (HAS_Y) {
                f32x4 yv[4]; float s = 0.f;
#pragma unroll
                for (int j = 0; j < 4; ++j) { const unsigned lo = (unsigned)yw[q][j], hi = (unsigned)(yw[q][j] >> 32);
                    yv[j] = (f32x4){bfl(lo), bfh(lo), bfl(hi), bfh(hi)}; s += (yv[j].x * yv[j].x + yv[j].y * yv[j].y) + (yv[j].z * yv[j].z + yv[j].w * yv[j].w); }
                const float ry = scale * __builtin_amdgcn_rsqf(wave_sum(s) * (1.f / D) + 1e-6f);
#pragma unroll
                for (int j = 0; j < 4; ++j) v[q][j] = v[q][j] + yv[j] * ry * gp[j];
            }
            if (OUT_F32) { GAS f32x4* xo = (GAS f32x4*)(xout + (size_t)m * D) + F.lane;
#pragma unroll
                for (int j = 0; j < 4; ++j) xo[64 * j] = v[q][j]; }
            if (OUT_XN) {
                float s2 = 0.f;
#pragma unroll
                for (int j = 0; j < 4; ++j) s2 += (v[q][j].x * v[q][j].x + v[q][j].y * v[q][j].y) + (v[q][j].z * v[q][j].z + v[q][j].w * v[q][j].w);
                const float ms = wave_sum(s2) * (1.f / D) + 1e-6f, rx = __builtin_amdgcn_rsqf(ms), rt = ms * rx;
                GAS unsigned long long* o8 = (GAS unsigned long long*)(xn_out + (size_t)m * D) + F.lane;
#pragma unroll
                for (int j = 0; j < 4; ++j) { const f32x4 o = v[q][j] * rx; o8[64 * j] = (unsigned long long)pk2(o.x, o.y) | ((unsigned long long)pk2(o.z, o.w) << 32); }
                if (rs_out && F.lane == 0) rs_out[m] = rt;
            } }
    }
}

namespace ret {
typedef short bf16x8 __attribute__((ext_vector_type(8)));
typedef short s16x4 __attribute__((ext_vector_type(4)));
typedef float f32x16 __attribute__((ext_vector_type(16)));
typedef __attribute__((address_space(3))) const char* lds_cptr;
#define RET_MFMA(a, b, c) __builtin_amdgcn_mfma_f32_32x32x16_bf16(a, b, c, 0, 0, 0)
__device__ __forceinline__ int crow(int r, int hi) { return (r & 3) + 8 * (r >> 2) + 4 * hi; }
__device__ __forceinline__ s16x4 vtr(lds_cptr p) { return __builtin_bit_cast(s16x4, __builtin_amdgcn_ds_read_tr16_b64_v4i16((__attribute__((address_space(3))) s16x4*)p)); }
typedef float f32x2_t __attribute__((ext_vector_type(2))); typedef __bf16 bf16x2_t __attribute__((ext_vector_type(2)));
__device__ __forceinline__ unsigned cvtpk(float lo, float hi) { f32x2_t v = {lo, hi}; bf16x2_t b = __builtin_convertvector(v, bf16x2_t); return __builtin_bit_cast(unsigned, b); }
__device__ __forceinline__ bf16x8 trfrag(lds_cptr img, int cb, int kg, int lane) {
    lds_cptr p = img + (cb * 8 + kg) * 1024 + ((lane >> 4) & 1) * 32 + (lane & 3) * 8 + (4 * (lane >> 5) + ((lane & 15) >> 2)) * 64;
    const s16x4 lo = vtr(p), h = vtr(p + 512);
    return (bf16x8){lo[0], lo[1], lo[2], lo[3], h[0], h[1], h[2], h[3]};
}
__device__ __forceinline__ void load_tr_image(LAS unsigned char* img, const bf16* src, int pitch, int wid, int lane) {
#pragma unroll
    for (int i = 0; i < 4; ++i) { const int p = wid * 4 + i, cb = p >> 3, kg = p & 7, row = 16 * kg + (lane >> 2), col = 32 * cb + (lane & 3) * 8;
        const v4u v = *(const GAS v4u*)(src + (size_t)row * pitch + col); *(LAS v4u*)(img + p * 1024 + lane * 16) = v; }
}
__device__ __forceinline__ float log2_decay(int h) { return __builtin_log2f(1.0f - __builtin_exp2f(-5.0f - (float)h)); }

__device__ __forceinline__ int run_unit(int r, int k) { return (r >> 3) * 32 + 4 * (r & 7) + k; }
__device__ __forceinline__ void r1_load(v4u (&t)[8], const bf16* ZR, int u, int wid, int lane) {
    const int bh = u >> 5, n = u & 31, b = bh >> 2, h = bh & 3;
    const bf16* Zrow = ZR + (size_t)(b * T + 128 * n) * 2048;
#pragma unroll
    for (int i = 0; i < 4; ++i) { const int p = wid * 4 + i, cb = p >> 3, kg = p & 7; const bf16* zr = Zrow + (size_t)(16 * kg + (lane >> 2)) * 2048 + 128 * h + 32 * cb + (lane & 3) * 8;
        t[i] = *(const GAS v4u*)(zr + 1024); t[4 + i] = *(const GAS v4u*)(zr + 512); }
}
__device__ __forceinline__ void r1_phase(LAS unsigned char* lds, const bf16* ZR, bf16* PTL, float* TT, int r0, int rstep, int wid, int lane) {
    const lds_cptr imgV = (lds_cptr)lds, imgK = (lds_cptr)(lds + 32768);
    const int eblk = wid & 3, dh = wid >> 2, r32 = lane & 31, hi = lane >> 5;
    for (int r = r0; r < 256; r += rstep) {
        const float l2g = log2_decay((r >> 3) & 3), g1 = __builtin_exp2f(l2g), gC = __builtin_exp2f(128.0f * l2g), gc1 = __builtin_exp2f(127.0f * l2g);
        v4u t[8];
        r1_load(t, ZR, run_unit(r, 0), wid, lane);
        f32x16 L0 = f32x16{}, L1 = f32x16{};
#pragma unroll
        for (int k = 0; k < 4; ++k) {
            const int u = run_unit(r, k);
#pragma unroll
            for (int i = 0; i < 4; ++i) { *(LAS v4u*)(lds + (wid * 4 + i) * 1024 + lane * 16) = t[i]; *(LAS v4u*)(lds + 32768 + (wid * 4 + i) * 1024 + lane * 16) = t[4 + i]; }
            __syncthreads();
            if (k < 3) r1_load(t, ZR, u + 1, wid, lane);
            f32x16 acc0 = f32x16{}, acc1 = f32x16{};
#pragma unroll
            for (int kg = 0; kg < 8; ++kg) { const bf16x8 a = trfrag(imgV, eblk, kg, lane), b0 = trfrag(imgK, 2 * dh, kg, lane), b1 = trfrag(imgK, 2 * dh + 1, kg, lane);
                acc0 = RET_MFMA(a, b0, acc0); acc1 = RET_MFMA(a, b1, acc1); }
            bf16* out = PTL + (size_t)u * 16384 + 64 * dh + r32;
#pragma unroll
            for (int q = 0; q < 16; ++q) { const int e = 32 * eblk + crow(q, hi); out[e * 128] = (bf16)f2bf(L0[q] * g1); out[e * 128 + 32] = (bf16)f2bf(L1[q] * g1);
                L0[q] = L0[q] * gC + acc0[q] * gc1; L1[q] = L1[q] * gC + acc1[q] * gc1; }
            __syncthreads();
        }
        float* tt = TT + (size_t)r * 16384 + 64 * dh + r32;
#pragma unroll
        for (int q = 0; q < 16; ++q) { const int e = 32 * eblk + crow(q, hi); tt[e * 128] = L0[q]; tt[e * 128 + 32] = L1[q]; }
    }
}

__device__ __forceinline__ bf16x8 rmfrag(const LAS unsigned char* img, int row, int c) { return *(const LAS bf16x8*)(img + row * 256 + ((c ^ (row & 15)) << 4)); }
constexpr int R3_SCR = 131072 + 1024;
struct R3Tiles { v4u tq[4], tk[4], tp[4], tv[4]; };
__device__ __forceinline__ void r3_load(R3Tiles& t, const bf16* ZR, const bf16* PT, int u, int wid, int lane) {
    const int bh = u >> 5, n = u & 31, b = bh >> 2, h = bh & 3, tid = wid * 64 + lane;
    const bf16* Zrow = ZR + (size_t)(b * T + 128 * n) * 2048;
#pragma unroll
    for (int i = 0; i < 4; ++i) { const int idx = i * 512 + tid, row = idx >> 4, c = idx & 15; const bf16* zr = Zrow + (size_t)row * 2048 + 128 * h + c * 8;
        t.tq[i] = *(const GAS v4u*)zr; t.tk[i] = *(const GAS v4u*)(zr + 512);
        t.tp[i] = *(const GAS v4u*)(PT + (size_t)u * 16384 + row * 128 + c * 8);
        const int p = wid * 4 + i, cb = p >> 3, kg = p & 7; t.tv[i] = *(const GAS v4u*)(Zrow + (size_t)(16 * kg + (lane >> 2)) * 2048 + 1024 + 128 * h + 32 * cb + (lane & 3) * 8); }
}
__device__ __forceinline__ void r3_phase(LAS unsigned char* lds, const bf16* ZR, bf16* PT, const float* TT, bf16* OUT, int opitch, int ocol, int r0, int rstep, int wid, int lane) {
 for (int rr = r0; rr < 256; rr += rstep) {
  { const int bh0 = rr >> 3, c0 = rr & 7, tid0 = wid * 64 + lane;
    if (c0 > 0) {
        const float l2g0 = log2_decay(bh0 & 3), G4 = __builtin_exp2f(512.0f * l2g0);
        float S0[4][8];
#pragma unroll
        for (int i = 0; i < 4; ++i)
#pragma unroll
            for (int j = 0; j < 8; ++j) S0[i][j] = 0.f;
        const float* tt = TT + (size_t)(bh0 * 8) * 16384 + tid0 * 8;
        int cp = 0;
        for (; cp + 1 < c0; cp += 2) {
            f32x4 a0[4], a1[4], b0[4], b1[4];
#pragma unroll
            for (int i = 0; i < 4; ++i) { const float* q = tt + (size_t)cp * 16384 + i * 4096; a0[i] = *(const GAS f32x4*)q; a1[i] = *(const GAS f32x4*)(q + 4); b0[i] = *(const GAS f32x4*)(q + 16384); b1[i] = *(const GAS f32x4*)(q + 16384 + 4); }
#pragma unroll
            for (int i = 0; i < 4; ++i)
#pragma unroll
                for (int j = 0; j < 4; ++j) { S0[i][j] = (S0[i][j] * G4 + a0[i][j]) * G4 + b0[i][j]; S0[i][4 + j] = (S0[i][4 + j] * G4 + a1[i][j]) * G4 + b1[i][j]; }
        }
        if (cp < c0) {
#pragma unroll
            for (int i = 0; i < 4; ++i) { const float* q = tt + (size_t)cp * 16384 + i * 4096; const f32x4 a0 = *(const GAS f32x4*)q, a1 = *(const GAS f32x4*)(q + 4);
#pragma unroll
                for (int j = 0; j < 4; ++j) { S0[i][j] = S0[i][j] * G4 + a0[j]; S0[i][4 + j] = S0[i][4 + j] * G4 + a1[j]; } }
        }
        bf16* pt = (bf16*)PT + (size_t)run_unit(rr, 0) * 16384 + tid0 * 8;
        v4u w[4][4];
#pragma unroll
        for (int k = 0; k < 4; ++k)
#pragma unroll
            for (int i = 0; i < 4; ++i) w[k][i] = *(const GAS v4u*)(pt + (size_t)k * 16384 + i * 4096);
#pragma unroll
        for (int k = 0; k < 4; ++k) { const float gk = __builtin_exp2f((float)(128 * k + 1) * l2g0);
#pragma unroll
            for (int i = 0; i < 4; ++i) { const v4u x = w[k][i]; v4u o;
                o.x = cvtpk(bfl(x.x) + gk * S0[i][0], bfh(x.x) + gk * S0[i][1]); o.y = cvtpk(bfl(x.y) + gk * S0[i][2], bfh(x.y) + gk * S0[i][3]);
                o.z = cvtpk(bfl(x.z) + gk * S0[i][4], bfh(x.z) + gk * S0[i][5]); o.w = cvtpk(bfl(x.w) + gk * S0[i][6], bfh(x.w) + gk * S0[i][7]);
                *(GAS v4u*)(pt + (size_t)k * 16384 + i * 4096) = o; } }
    } }
  for (int kk = 0; kk < 4; ++kk) {
    const int u = run_unit(rr, kk);
    R3Tiles tl; r3_load(tl, ZR, PT, u, wid, lane);
    const int bh_ = u >> 5, tid_ = wid * 64 + lane; v4u gt[4];
#pragma unroll
    for (int i = 0; i < 4; ++i) { const int idx = i * 512 + tid_, row = idx >> 4, c = idx & 15; gt[i] = *(const GAS v4u*)(ZR + (size_t)((bh_ >> 2) * T + 128 * (u & 31) + row) * 2048 + 1536 + 128 * (bh_ & 3) + c * 8); }
    const int bh = u >> 5, n = u & 31, b = bh >> 2, h = bh & 3, rowbase = b * T + 128 * n, tid = wid * 64 + lane;
#pragma unroll
    for (int i = 0; i < 4; ++i) { const int idx = i * 512 + tid, row = idx >> 4, c = idx & 15, off = row * 256 + ((c ^ (row & 15)) << 4);
        *(LAS v4u*)(lds + off) = tl.tq[i]; *(LAS v4u*)(lds + 32768 + off) = tl.tk[i]; *(LAS v4u*)(lds + 65536 + off) = tl.tp[i];
        *(LAS v4u*)(lds + 98304 + (wid * 4 + i) * 1024 + lane * 16) = tl.tv[i]; }
    __syncthreads();
    const LAS unsigned char* imgQ = lds; const LAS unsigned char* imgK = lds + 32768; const LAS unsigned char* imgP = lds + 65536; const lds_cptr imgV = (lds_cptr)(lds + 98304);
    const int eh = wid >> 2, qb = eh ? 3 - (wid & 3) : (wid & 3), r32 = lane & 31, hi = lane >> 5;
    f32x16 acc0 = f32x16{}, acc1 = f32x16{};
    for (int kb = 0; kb <= qb; ++kb) {
        f32x16 S = f32x16{};
#pragma unroll 4
        for (int ds = 0; ds < 8; ++ds) S = RET_MFMA(rmfrag(imgK, 32 * kb + r32, 2 * ds + hi), rmfrag(imgQ, 32 * qb + r32, 2 * ds + hi), S);
        if (kb == qb) {
#pragma unroll
            for (int r = 0; r < 16; ++r) if (crow(r, hi) > r32) S[r] = 0.f;
        }
        v4u w0, w1;
        w0.x = cvtpk(S[0], S[1]); w0.y = cvtpk(S[2], S[3]); w0.z = cvtpk(S[4], S[5]); w0.w = cvtpk(S[6], S[7]);
        w1.x = cvtpk(S[8], S[9]); w1.y = cvtpk(S[10], S[11]); w1.z = cvtpk(S[12], S[13]); w1.w = cvtpk(S[14], S[15]);
        const bf16x8 pa0 = __builtin_bit_cast(bf16x8, w0), pa1 = __builtin_bit_cast(bf16x8, w1);
        acc0 = RET_MFMA(pa0, trfrag(imgV, 2 * eh, 2 * kb, lane), acc0);     acc0 = RET_MFMA(pa1, trfrag(imgV, 2 * eh, 2 * kb + 1, lane), acc0);
        acc1 = RET_MFMA(pa0, trfrag(imgV, 2 * eh + 1, 2 * kb, lane), acc1); acc1 = RET_MFMA(pa1, trfrag(imgV, 2 * eh + 1, 2 * kb + 1, lane), acc1);
    }
#pragma unroll
    for (int ds = 0; ds < 8; ++ds) { const bf16x8 qf = rmfrag(imgQ, 32 * qb + r32, 2 * ds + hi); acc0 = RET_MFMA(qf, rmfrag(imgP, 64 * eh + r32, 2 * ds + hi), acc0); acc1 = RET_MFMA(qf, rmfrag(imgP, 64 * eh + 32 + r32, 2 * ds + hi), acc1); }
    const float l2g = log2_decay(h);
    float ss[16];
#pragma unroll
    for (int r = 0; r < 16; ++r) { const float f = __builtin_exp2f((float)(32 * qb + crow(r, hi)) * l2g); acc0[r] *= f; acc1[r] *= f; ss[r] = acc0[r] * acc0[r] + acc1[r] * acc1[r]; }
#pragma unroll
    for (int r = 0; r < 16; ++r) { float s_ = ss[r]; s_ = dpp_xadd<0xB1>(s_); s_ = dpp_xadd<0x4E>(s_); s_ = dpp_xadd<0x141>(s_); s_ = dpp_xadd<0x140>(s_);
        s_ += __shfl_xor(s_, 16); ss[r] = s_; }
    LAS float* scr = (LAS float*)(lds + R3_SCR);
    if (r32 == 0) {
#pragma unroll
        for (int r = 0; r < 16; ++r) scr[wid * 32 + crow(r, hi)] = ss[r];
    }
    __syncthreads();
    LAS float* stage = (LAS float*)lds;
#pragma unroll
    for (int r = 0; r < 16; ++r) { const int ql = crow(r, hi); const float tot = ss[r] + scr[(7 - wid) * 32 + ql];
        const float rn = __builtin_amdgcn_rsqf(tot * (1.0f / 128.0f) + 1e-6f);
        LAS float* sp = stage + (32 * qb + ql) * 128 + 64 * eh + r32; sp[0] = acc0[r] * rn; sp[32] = acc1[r] * rn; }
    __syncthreads();
#pragma unroll
    for (int i = 0; i < 4; ++i) { const int idx = i * 512 + tid, row = idx >> 4, c = idx & 15;
        const f32x4 y0 = *(const LAS f32x4*)(stage + row * 128 + c * 8), y1 = *(const LAS f32x4*)(stage + row * 128 + c * 8 + 4); const v4u g = gt[i];
        v4u w; w.x = pk2(y0.x * bfl(g.x), y0.y * bfh(g.x)); w.y = pk2(y0.z * bfl(g.y), y0.w * bfh(g.y)); w.z = pk2(y1.x * bfl(g.z), y1.y * bfh(g.z)); w.w = pk2(y1.z * bfl(g.w), y1.w * bfh(g.w));
        *(GAS v4u*)(OUT + (size_t)(rowbase + row) * opitch + ocol + 128 * h + c * 8) = w; }
    __syncthreads();
  }
 }
}
}

struct Args { const float* in[22]; float* out; unsigned char* ws; };
#ifndef TWICE
#define TWICE 0
#endif
#ifndef TWICE_N
#define TWICE_N 2
#endif
__device__ __forceinline__ unsigned char* arg_ptr(int i) { asm volatile("" : "+s"(i)); return ((unsigned char* const*)__builtin_amdgcn_kernarg_segment_ptr())[i]; }
__device__ __forceinline__ const float* arg_in(int i) { return (const float*)arg_ptr(i); }
__device__ __forceinline__ int opaque_i(int v) { asm volatile("" : "+s"(v)); return v; }
#if TWICE
#define REP_BEGIN(k) _Pragma("nounroll") for (int rep_ = 0, reps_ = opaque_i(TWICE == (k) ? TWICE_N : 1); rep_ < ((TWICE == (k)) ? reps_ : 1); ++rep_) {
#define REP_END() }
#else
#define REP_BEGIN(k) {
#define REP_END() }
#endif
__device__ __forceinline__ void skew_delay(int vcu, int ticks) { const unsigned long long t0 = __builtin_amdgcn_s_memrealtime(), w = (unsigned long long)((vcu & 3) * ticks);
    while (__builtin_amdgcn_s_memrealtime() - t0 < w) __builtin_amdgcn_s_sleep(8); }
#ifndef P8_SKEW_TICKS
#define P8_SKEW_TICKS 0
#endif
#ifndef SKEW_TICKS
#define SKEW_TICKS 0
#endif
#define REFRESH_LANE() do { int t_ = threadIdx.x; asm volatile("" : "+v"(t_)); F.tid = t_; F.lane = t_ & 63; } while (0)
__global__ void __launch_bounds__(NWAVES * 64, 2) layer_fwd(Args) {
    extern __shared__ __attribute__((aligned(16))) unsigned char lds[];
    Frame F;
    F.lds = (LAS unsigned char*)lds;
    F.MISC = (volatile LAS unsigned*)(F.lds + MISC_OFF);
    F.tid = threadIdx.x; F.lane = F.tid & 63; F.wave = __builtin_amdgcn_readfirstlane(F.tid >> 6);
    F.G = gridDim.x; { const int bx = blockIdx.x; F.vcu = (F.G % 8 == 0) ? (bx % 8) * (F.G / 8) + bx / 8 : bx; }
    F.ctl = (gu32*)(arg_ptr(23) + WS_CTL);
    for (int u = F.tid; u < (LDS_BYTES - LDSCTL_OFF) / 4; u += NWAVES * 64) ((LAS unsigned*)(F.lds + LDSCTL_OFF))[u] = 0u;
    __syncthreads();
#if BAR_MODE == 1
    XcdBarrier bar = xcd_barrier_post((unsigned*)(F.ctl + CW_BAR), F.MISC + 8);
#elif BAR_MODE == 3
    XcdBarrier bar = xcd_barrier_post((unsigned*)(F.ctl + CW_BAR), F.MISC + 8);
    if (gridDim.y == 0x7fffu) cg::this_grid().sync();
#elif BAR_MODE == 2
    if (blockIdx.x == 0) for (int i = F.tid; i < XCD_BAR_WORDS; i += NWAVES * 64) __hip_atomic_store((unsigned*)(F.ctl + CW_BAR) + i, 0u, __ATOMIC_RELAXED, __HIP_MEMORY_SCOPE_AGENT);
    XcdBarrier bar; bar.bar = (unsigned*)(F.ctl + CW_BAR); bar.x = 0; bar.st = F.MISC + 8;
    { const int id = (int)blockIdx.x * (NWAVES * 64) + F.tid;
      if (id < 5 * 128) __hip_atomic_store((unsigned*)(F.ctl + CW_SEAM) + (id >> 7) * SEAM_BANK + 64 * (id & 127), 0u, __ATOMIC_RELAXED, __HIP_MEMORY_SCOPE_AGENT);
      if (id == 0) __hip_atomic_store((unsigned*)(F.ctl + CW_TMO), 0u, __ATOMIC_RELAXED, __HIP_MEMORY_SCOPE_AGENT);
    }
#endif
#if BAR_MODE == 0
#define GRID_BAR() do { cg::this_grid().sync(); REFRESH_LANE(); } while (0)
#define GRID_BAR0() GRID_BAR()
#elif BAR_MODE == 1
#define GRID_BAR() do { xcd_barrier(bar); REFRESH_LANE(); } while (0)
#define GRID_BAR0() GRID_BAR()
#elif BAR_MODE == 3
#define GRID_BAR() do { xcd_barrier(bar); REFRESH_LANE(); } while (0)
#define GRID_BAR0() GRID_BAR()
#else
#ifndef XBAR_FLAT
#define XBAR_FLAT 0
#endif
#if XBAR_FLAT
#define GRID_BAR() do { xcd_barrier_flat(bar); REFRESH_LANE(); } while (0)
#else
#define GRID_BAR() do { xcd_barrier(bar); REFRESH_LANE(); } while (0)
#endif
#define GRID_BAR0() do { cg::this_grid().sync(); bar = xcd_barrier_post((unsigned*)(F.ctl + CW_BAR), F.MISC + 8); REFRESH_LANE(); } while (0)
#endif

#define P_x    (arg_in(0))
#define P_out  ((float*)arg_ptr(22))
#define P_CS   ((float*)(arg_ptr(23) + WS_CS))
#define P_WIN  ((bf16*)(arg_ptr(23) + WS_WIN))
#define P_WAP  ((bf16*)(arg_ptr(23) + WS_WAP))
#define P_WOUT ((bf16*)(arg_ptr(23) + WS_WOUT))
#define P_WGU  ((bf16*)(arg_ptr(23) + WS_WGU))
#define P_WD   ((bf16*)(arg_ptr(23) + WS_WD))
#define P_XN   ((bf16*)(arg_ptr(23) + WS_XN))
#define P_Y    ((bf16*)(arg_ptr(23) + WS_Y))
#define P_H    ((bf16*)(arg_ptr(23) + WS_H))
#define P_ZQ   ((bf16*)(arg_ptr(23) + WS_ZQ))
#define P_ZR   ((bf16*)(arg_ptr(23) + WS_ZR))
#define P_ZG   ((bf16*)(arg_ptr(23) + WS_ZG))
#define P_AO   ((bf16*)arg_ptr(22))
#define P_TT   ((float*)(arg_ptr(23) + WS_KVT))
#define P_PT   ((bf16*)(arg_ptr(22) + 32 * MiB))
#define P_ACAT ((bf16*)(arg_ptr(22) + 64 * MiB))
#define P_MG   ((bf16*)(arg_ptr(23) + WS_MG))
#define P_RS   ((float*)(arg_ptr(23) + WS_RS))
    LAS float* scr = (LAS float*)(F.lds + RING_OFF + F.wave * 16384);
    const int gw = F.vcu * NWAVES + F.wave, NGW = F.G * NWAVES;

#ifndef PROBE
#define PROBE 0
#endif

#define PROBE_DUMP(buf, ld, c0) do { for (int m_ = gw; m_ < M; m_ += NGW) { const bf16* s_ = (buf) + (size_t)m_ * (ld) + (c0); float* o_ = P_out + (size_t)m_ * D; \
        for (int c_ = F.lane; c_ < D; c_ += 64) o_[c_] = __uint_as_float((unsigned)s_[c_] << 16); } return; } while (0)
    {
        constexpr int I_GU = (D / 64) * (FF / 32), I_DN = (FF / 64) * (D / 32), I_IN = (D / 64) * (DIN / 32), I_PJ = (512 / 64) * (D / 32), I_O = (D / 64) * (D / 32);
        constexpr int NITEMS = 2 * I_GU + I_DN + I_IN + 2 * I_PJ + I_O;
        REP_BEGIN(101)
        for (int it = gw; it < NITEMS; it += NGW) {
            int r = it;
            if (r < I_GU) { transpose_item(arg_in(2), D, FF, P_WGU, 1, scr, r, F.lane, 0, 0, arg_in(1), -1.4426950408889634f); continue; } r -= I_GU;
            if (r < I_GU) { transpose_item(arg_in(3), D, FF, P_WGU, 2, scr, r, F.lane, 0, 0, arg_in(1), -0.6931471805599453f); continue; } r -= I_GU;
            if (r < I_DN) { transpose_item(arg_in(4), FF, D, P_WD, 0, scr, r, F.lane); continue; } r -= I_DN;
            if (r < I_IN) { transpose_item(arg_in(7), D, DIN, P_WIN, 3, scr, r, F.lane, 0, 0, arg_in(6)); continue; } r -= I_IN;
            if (r < I_PJ) { transpose_item(arg_in(13), 512, D, P_WAP, 0, scr, r, F.lane, 1024, 0); continue; } r -= I_PJ;
            if (r < I_PJ) { transpose_item(arg_in(14), 512, D, P_WAP, 0, scr, r, F.lane, 1024, 512); continue; } r -= I_PJ;
            transpose_item(arg_in(15), D, D, P_WOUT, 0, scr, r, F.lane);
        }
        REP_END()
        REP_BEGIN(102)
        for (int idx = F.vcu * (NWAVES * 64) + F.tid; idx < T * 64; idx += F.G * NWAVES * 64) {
            const int t = idx >> 6, i = idx & 63;
            const float e = (i == 63) ? 1.0f : (float)i * (1.0f / 63.0f);
            const float ang = (float)t * (1.0f / powf(10000.0f, e));
            P_CS[2 * idx] = cosf(ang); P_CS[2 * idx + 1] = sinf(ang);
        }
        REP_END()
        REP_BEGIN(103)
        row_phase<false, false, false, true>(F, P_x, nullptr, nullptr, nullptr, nullptr, 0.f, nullptr, P_XN, P_RS);
        REP_END()
    }
    GRID_BAR0();

#define FUSED_GEMM(TWO_, A_, Bt_, K_, base_, out_, xn_, gpost_, gnext_, scale_, inst_) do { \
        _Pragma("nounroll") for (int half_ = 0; half_ < 2; ++half_) { const size_t r0_ = (size_t)half_ * (M / 2); \
            pg8::Gemm g{(A_) + r0_ * (K_), (Bt_), M / 2, D, (K_)}; pg8::StaticOrder S; S.init(M / 2, D, F.G, (int)blockIdx.x); \
            pg8::PanelSumsq st1_{(float*)(arg_ptr(23) + WS_XB + (size_t)(inst_) * XB_BYTES) + r0_ * 4, (unsigned*)(F.ctl + CW_SEAM) + (inst_) * SEAM_BANK + 64 * 64 * half_, (unsigned*)(F.ctl + CW_TMO), 1e-6f}; \
            pg8::PanelSumsq st2_{(float*)(arg_ptr(23) + WS_XB + (size_t)((inst_) + 1) * XB_BYTES) + r0_ * 4, (unsigned*)(F.ctl + CW_SEAM) + ((inst_) + 1) * SEAM_BANK + 64 * 64 * half_, (unsigned*)(F.ctl + CW_TMO), 1e-6f}; \
            pg8::EpiRmsRes<TWO_> E{(base_) + r0_ * D, (out_) + r0_ * D, (xn_) ? (xn_) + r0_ * D : nullptr, D, (gpost_), (gnext_), (scale_), st1_, st2_}; \
            pg8::gemm_phase<pg8::EpiRmsRes<TWO_>, pg8::StaticOrder, false, PG8_SP2>(F.lds + RING_OFF, g, S, E); } } while (0)
    REP_BEGIN(1)
    if (SKEW_TICKS) skew_delay(F.vcu, SKEW_TICKS);
    { pg8::Gemm g{P_XN, P_WGU, M, 2 * FF, D}; pg8::StaticOrder S; S.init(M, 2 * FF, F.G, (int)blockIdx.x);
#if TWICE == 1 && defined(TWICE_NULL_EPI)
      pg8::EpiSwiglu E{P_H, FF, rep_};
#else
      pg8::EpiSwiglu E{P_H, FF, 0};
#endif
      pg8::gemm_phase<pg8::EpiSwiglu, pg8::StaticOrder, PG8_ALIGN, PG8_SP2>(F.lds + RING_OFF, g, S, E); }
    GRID_BAR();
    REP_END()
    REP_BEGIN(2)
    { pg8::Gemm g{P_H, P_WD, M, D, FF, 1}; pg8::StaticOrder S; S.init(M, D, F.G, (int)blockIdx.x);
      pg8::EpiBf16<0> E{P_Y, D, nullptr, 0, 0, 1.f};
      pg8::gemm_phase<pg8::EpiBf16<0>, pg8::StaticOrder, PG8_ALIGN, PG8_SP2>(F.lds + RING_OFF, g, S, E); }
    GRID_BAR();
    REP_END()
    REP_BEGIN(3)
    row_phase<true, true, false, true>(F, nullptr, P_XN, P_RS, P_Y, arg_in(5), 0.5f, nullptr, P_XN, P_RS);
    GRID_BAR();
    REP_END()
#ifdef EXTRA_BARS
    for (int eb_ = 0; eb_ < EXTRA_BARS; ++eb_) GRID_BAR();
#endif
    REP_BEGIN(4)
    if (SKEW_TICKS) skew_delay(F.vcu, SKEW_TICKS);
    { pg8::Gemm g{P_XN, P_WIN, M, DIN, D}; pg8::StaticOrder S; S.init(M, DIN, F.G, (int)blockIdx.x);
      pg8::EpiWin E{P_ZQ, P_ZR, P_ZG, P_CS, attn_body::C2};
      pg8::gemm_phase<pg8::EpiWin, pg8::StaticOrder, PG8_ALIGN, PG8_SP2>(F.lds + RING_OFF, g, S, E); }
    GRID_BAR();
    REP_END()
#if PROBE == 40
    PROBE_DUMP(P_ZQ, 1536, 0);
#elif PROBE == 41
    PROBE_DUMP(P_ZR, 2048, 0);
#elif PROBE == 42
    PROBE_DUMP(P_ZR, 2048, 1024);
#elif PROBE == 43
    PROBE_DUMP(P_ZG, 2048, 0);
#endif
    REP_BEGIN(5)
    {
        REP_BEGIN(51)
        ret::r1_phase(F.lds + RING_OFF, P_ZR, P_PT, P_TT, F.vcu, F.G, F.wave, F.lane);
        REP_END()
        REP_BEGIN(52)
        const float s1_ = wave_sum(arg_in(8)[F.lane] * arg_in(9)[F.lane]), s2_ = wave_sum(arg_in(10)[F.lane] * arg_in(11)[F.lane]);
        const attn_body::AttnTensors AT{(const attn_body::bf16*)P_ZQ, (attn_body::bf16*)P_AO, (attn_body::bf16*)P_ACAT, expf(s1_) - expf(s2_) + 0.2f, 0.8f, arg_in(12)};
        const attn_body::StaticOrder S((int)F.G, (int)blockIdx.x);
        attn_body::attn_phase<attn_body::StaticOrder>((char*)lds + RING_OFF, AT, S);
        REP_END()
    }
    GRID_BAR();
    REP_END()
#if PROBE == 5
    PROBE_DUMP(P_AO, 1024, 0);
#endif
    REP_BEGIN(7)
    ret::r3_phase(F.lds + RING_OFF, P_ZR, P_PT, P_TT, P_ACAT, 1024, 512, F.vcu, F.G, F.wave, F.lane);
    GRID_BAR();
    REP_END()
#if PROBE == 7
    PROBE_DUMP(P_ACAT, 1024, 0);
#endif
    REP_BEGIN(8)
    if (P8_SKEW_TICKS) skew_delay(F.vcu, P8_SKEW_TICKS);
    { pg8::Gemm g{P_ACAT, P_WAP, M, D, D}; pg8::StaticOrder S; S.init(M, D, F.G, (int)blockIdx.x);
      pg8::EpiGateCat E{P_MG, D, P_ZG, 2048};
      pg8::gemm_phase<pg8::EpiGateCat, pg8::StaticOrder, PG8_ALIGN, PG8_SP2>(F.lds + RING_OFF, g, S, E); }
    GRID_BAR();
    REP_END()
#if PROBE == 8
    PROBE_DUMP(P_MG, 1024, 0);
#endif
    REP_BEGIN(9)
    { pg8::Gemm g{P_MG, P_WOUT, M, D, D}; pg8::StaticOrder S; S.init(M, D, F.G, (int)blockIdx.x);
      pg8::EpiBf16<0> E{P_Y, D, nullptr, 0, 0, 1.f};
      pg8::gemm_phase<pg8::EpiBf16<0>, pg8::StaticOrder, PG8_ALIGN, PG8_SP2>(F.lds + RING_OFF, g, S, E); }
    GRID_BAR();
    REP_END()
    {
        constexpr int I_GU = (D / 64) * (FF / 32), I_DN = (FF / 64) * (D / 32);
        for (int it = gw; it < 2 * I_GU + I_DN; it += NGW) {
            int r = it;
            if (r < I_GU) { transpose_item(arg_in(18), D, FF, P_WGU, 1, scr, r, F.lane, 0, 0, arg_in(17), -1.4426950408889634f); continue; } r -= I_GU;
            if (r < I_GU) { transpose_item(arg_in(19), D, FF, P_WGU, 2, scr, r, F.lane, 0, 0, arg_in(17), -0.6931471805599453f); continue; } r -= I_GU;
            transpose_item(arg_in(20), FF, D, P_WD, 0, scr, r, F.lane);
        }
        row_phase<true, true, false, true>(F, nullptr, P_XN, P_RS, P_Y, arg_in(16), 1.0f, nullptr, P_XN, P_RS);
    }
    GRID_BAR();
    if (SKEW_TICKS) skew_delay(F.vcu, SKEW_TICKS);
    { pg8::Gemm g{P_XN, P_WGU, M, 2 * FF, D}; pg8::StaticOrder S; S.init(M, 2 * FF, F.G, (int)blockIdx.x);
      pg8::EpiSwiglu E{P_H, FF, 0};
      pg8::gemm_phase<pg8::EpiSwiglu, pg8::StaticOrder, PG8_ALIGN, PG8_SP2>(F.lds + RING_OFF, g, S, E); }
    GRID_BAR();
    { pg8::Gemm g{P_H, P_WD, M, D, FF, 1}; pg8::StaticOrder S; S.init(M, D, F.G, (int)blockIdx.x);
      pg8::EpiBf16<0> E{P_Y, D, nullptr, 0, 0, 1.f};
      pg8::gemm_phase<pg8::EpiBf16<0>, pg8::StaticOrder, PG8_ALIGN, PG8_SP2>(F.lds + RING_OFF, g, S, E); }
    GRID_BAR();
    row_phase<true, true, true, false>(F, nullptr, P_XN, P_RS, P_Y, arg_in(21), 0.5f, P_out, nullptr, nullptr);
#if BAR_MODE != 0
    if ((__hip_atomic_load((unsigned*)(F.ctl + CW_BAR) + XB_TMO, __ATOMIC_RELAXED, __HIP_MEMORY_SCOPE_AGENT) | __hip_atomic_load((unsigned*)(F.ctl + CW_TMO), __ATOMIC_RELAXED, __HIP_MEMORY_SCOPE_AGENT)) != 0u) {
        const float qn = __builtin_nanf(""); for (int m = gw; m < M; m += NGW) P_out[(size_t)m * D + F.lane] = qn; }
#endif
#undef GRID_BAR
}

extern "C" void kernel_launch(void* const* d_in, const int* in_sizes, int n_in, void* d_out, int out_size, void* d_ws, size_t ws_size, hipStream_t stream) {
    static int grid = 0;
    if (grid == 0) {
        if (n_in != 22 || in_sizes[0] != M * D || out_size != M * D || ws_size < WS_END) { fprintf(stderr, "kernel_launch: built for 22 inputs, x and out of %d floats, >= %zu bytes of workspace; got n_in %d, in0 %d, out %d, ws %zu; nothing launched\n", M * D, (size_t)WS_END, n_in, n_in > 0 ? in_sizes[0] : -1, out_size, ws_size); grid = -1; return; }
        int dev = 0, cus = 0, per_cu = 0;
        if (hipGetDevice(&dev) != hipSuccess || hipDeviceGetAttribute(&cus, hipDeviceAttributeMultiprocessorCount, dev) != hipSuccess) { fprintf(stderr, "kernel_launch: hipGetDevice / hipDeviceGetAttribute failed; nothing launched\n"); grid = -1; return; }
        if (hipFuncSetAttribute((const void*)layer_fwd, hipFuncAttributeMaxDynamicSharedMemorySize, LDS_BYTES) != hipSuccess) { fprintf(stderr, "kernel_launch: hipFuncSetAttribute failed; nothing launched\n"); grid = -1; return; }
        if (hipOccupancyMaxActiveBlocksPerMultiprocessor(&per_cu, (const void*)layer_fwd, NWAVES * 64, LDS_BYTES) != hipSuccess || per_cu < 1)
            fprintf(stderr, "kernel_launch: note: the occupancy query reports %d workgroups per CU\n", per_cu);
        (void)hipGetLastError();
        grid = cus * (per_cu < 1 ? 1 : per_cu); if (grid > 256) grid = 256; grid &= ~7;
        if (grid < 8) { fprintf(stderr, "kernel_launch: needs at least 8 co-resident workgroups; the occupancy query gives %d x %d; nothing launched\n", cus, per_cu); grid = -1; return; }
    }
    if (grid < 0) return;
#if BAR_MODE == 3
    if (hipMemsetAsync((char*)d_ws + WS_CTL, 0, CTL_ZERO_BYTES, stream) != hipSuccess) { fprintf(stderr, "kernel_launch: hipMemsetAsync of the control words failed; nothing launched\n"); return; }
#endif
    Args a{};
    for (int i = 0; i < 22; ++i) a.in[i] = (const float*)d_in[i];
    a.out = (float*)d_out; a.ws = (unsigned char*)d_ws;
    void* kargs[] = {&a};
    const hipError_t le = hipLaunchCooperativeKernel((const void*)layer_fwd, dim3(grid), dim3(NWAVES * 64), kargs, LDS_BYTES, stream);
    if (le != hipSuccess) fprintf(stderr, "kernel_launch: launch failed: %s (grid %d x %d threads, %d B LDS)\n", hipGetErrorName(le), grid, NWAVES * 64, LDS_BYTES);
}
```
